# Optimizing an MI355X kernel written in HIP

```python
import math
import jax, jax.numpy as jnp
from jax import lax
import numpy as np

D_MODEL = 1024
BATCH = 32
SEQ = 2048
DEPTH = 1

CHUNK = 64
Q_BLOCK = 128
A_HEADS = 8
A_HEAD_DIM = 64
A_WIDTH = A_HEADS * A_HEAD_DIM
IDX_HEADS = 4
IDX_DIM = 64
TOPK_MAX = 256
REL_BUCKETS = 32
REL_MAX_DIST = 128
SSM_GROUPS = 16
SSM_GROUP_CH = 16
SSM_WIDTH = SSM_GROUPS * SSM_GROUP_CH
SSM_STATE = 64
DT_MIN = 0.001
DT_MAX = 0.1
MEM_TOKENS = 256
MEM_HEADS = 4
MEM_HEAD_DIM = 64
MEM_WIDTH = MEM_HEADS * MEM_HEAD_DIM
N_BRANCHES = 3
FFN_DIM = 2816
NORM_EPS = 1e-6
IN_SPLITS = (A_WIDTH, A_HEAD_DIM, A_HEAD_DIM, IDX_HEADS * IDX_DIM, IDX_DIM, IDX_HEADS,
             SSM_WIDTH, MEM_WIDTH, N_BRANCHES * D_MODEL)
W_IN_COLS = (A_WIDTH + 2 * A_HEAD_DIM + IDX_HEADS * IDX_DIM + IDX_DIM + IDX_HEADS
             + SSM_WIDTH + MEM_WIDTH + N_BRANCHES * D_MODEL)

kernel_name = 'hybrid_dsa_s5_memory_macaron_block'


def rms_norm(x, g):
    xf = x.astype(jnp.float32)
    y = xf * lax.rsqrt(jnp.mean(xf * xf, axis=-1, keepdims=True) + NORM_EPS)
    return (y * g.astype(jnp.float32)).astype(x.dtype)


def swiglu_ffn(h, w_in, w_out):
    gate, up = jnp.split(h @ w_in, 2, axis=-1)
    return (jax.nn.silu(gate) * up) @ w_out


def t5_bucket(rel):
    half = REL_BUCKETS // 2
    max_exact = half // 2
    n = jnp.abs(rel)
    nf = jnp.maximum(n, 1).astype(jnp.float32)
    large = max_exact + (jnp.log(nf / max_exact) / math.log(REL_MAX_DIST / max_exact)
                         * (half - max_exact)).astype(jnp.int32)
    large = jnp.minimum(large, half - 1)
    return jnp.where(rel > 0, half, 0) + jnp.where(n < max_exact, n, large)


def indexed_sparse_attention(q, k, v, q_idx, k_idx, w_idx, rel_bias):
    b_, s_ = q.shape[0], q.shape[1]
    topk = min(TOPK_MAX, s_ // 4)
    nblk = s_ // Q_BLOCK
    key_pos = jnp.arange(s_, dtype=jnp.int32)
    scale = A_HEAD_DIM ** -0.5
    idx_scale = IDX_DIM ** -0.5
    head_w_scale = IDX_HEADS ** -0.5

    def to_blocks(a):
        return a.reshape((b_, nblk, Q_BLOCK) + a.shape[2:]).swapaxes(0, 1)

    def block(args):
        qb, qib, wb, start = args
        t = start + jnp.arange(Q_BLOCK, dtype=jnp.int32)
        limit = (t // CHUNK + 1) * CHUNK
        rel = jax.nn.relu(jnp.einsum('bqhd,bsd->bqhs', qib, k_idx).astype(jnp.float32) * idx_scale)
        score = jnp.einsum('bqhs,bqh->bqs', rel, wb.astype(jnp.float32) * head_w_scale)
        score = jnp.where(key_pos[None, None, :] < limit[None, :, None], score, -jnp.inf)
        _, sel = lax.top_k(score, topk)
        valid = sel < limit[None, :, None]
        flat = sel.reshape(b_, Q_BLOCK * topk, 1)
        k_sel = jnp.take_along_axis(k, flat, axis=1).reshape(b_, Q_BLOCK, topk, A_HEAD_DIM)
        v_sel = jnp.take_along_axis(v, flat, axis=1).reshape(b_, Q_BLOCK, topk, A_HEAD_DIM)
        bias = rel_bias[t5_bucket(sel - t[None, :, None])]
        logits = (jnp.einsum('bqhd,bqkd->bqhk', qb, k_sel).astype(jnp.float32) * scale
                  + jnp.transpose(bias, (0, 1, 3, 2)).astype(jnp.float32))
        logits = jnp.where(valid[:, :, None, :], logits, -jnp.inf)
        p = jax.nn.softmax(logits, axis=-1).astype(v_sel.dtype)
        return jnp.einsum('bqhk,bqkd->bqhd', p, v_sel)

    starts = jnp.arange(nblk, dtype=jnp.int32) * Q_BLOCK
    out = lax.map(block, (to_blocks(q), to_blocks(q_idx), to_blocks(w_idx), starts))
    return out.swapaxes(0, 1).reshape(b_, s_, A_WIDTH)


def _complex_affine_combine(e1, e2):
    a1r, a1i, b1r, b1i = e1
    a2r, a2i, b2r, b2i = e2
    return (a2r * a1r - a2i * a1i,
            a2r * a1i + a2i * a1r,
            a2r * b1r - a2i * b1i + b2r,
            a2r * b1i + a2i * b1r + b2i)


def s5_layer(u, lam_re, lam_im, log_dt, b_re, b_im, c_re, c_im, d):
    b_, s_ = u.shape[0], u.shape[1]
    f32 = jnp.float32
    uf = u.astype(f32).reshape(b_, s_, SSM_GROUPS, SSM_GROUP_CH)
    lr, li = lam_re.astype(f32), lam_im.astype(f32)
    dt = jnp.exp(log_dt.astype(f32))[:, None]
    mag = jnp.exp(lr * dt)
    ar, ai = mag * jnp.cos(li * dt), mag * jnp.sin(li * dt)
    den = lr * lr + li * li
    fr = ((ar - 1.0) * lr + ai * li) / den
    fi = (ai * lr - (ar - 1.0) * li) / den
    br, bi = b_re.astype(f32), b_im.astype(f32)
    bbr = fr[..., None] * br - fi[..., None] * bi
    bbi = fr[..., None] * bi + fi[..., None] * br
    bur = jnp.einsum('bsgc,gpc->bsgp', uf, bbr)
    bui = jnp.einsum('bsgc,gpc->bsgp', uf, bbi)
    elems = (jnp.broadcast_to(ar, bur.shape), jnp.broadcast_to(ai, bur.shape), bur, bui)
    _, _, xr, xi = lax.associative_scan(_complex_affine_combine, elems, axis=1)
    y = (jnp.einsum('bsgp,gcp->bsgc', xr, c_re.astype(f32))
         - jnp.einsum('bsgp,gcp->bsgc', xi, c_im.astype(f32))
         + d.astype(f32).reshape(SSM_GROUPS, SSM_GROUP_CH) * uf)
    return y.reshape(b_, s_, SSM_WIDTH).astype(u.dtype)


def memory_attention(q, k, v):
    logits = jnp.einsum('bshd,bmhd->bhsm', q, k).astype(jnp.float32) * (MEM_HEAD_DIM ** -0.5)
    p = jax.nn.softmax(logits, axis=-1).astype(v.dtype)
    out = jnp.einsum('bhsm,bmhd->bshd', p, v)
    return out.reshape(q.shape[0], q.shape[1], MEM_WIDTH)


def setup_inputs(seed: int = 0) -> dict:
    key = jax.random.key(seed)
    ks = jax.random.split(key, 32)
    f32 = jnp.float32
    L = DEPTH

    def nrm(k, shape, scale):
        return jax.random.normal(k, shape, f32) * scale

    def gain(k, shape):
        return 1.0 + 0.02 * jax.random.normal(k, shape, f32)

    n = jnp.arange(SSM_STATE, dtype=f32)
    return {
        'x': nrm(ks[0], (BATCH, SEQ, D_MODEL), 1.0),
        'mem': nrm(ks[1], (BATCH, MEM_TOKENS, D_MODEL), 1.0),
        'ffn1_norm': gain(ks[2], (L, D_MODEL)),
        'ffn1_w_in': nrm(ks[3], (L, D_MODEL, 2 * FFN_DIM), D_MODEL ** -0.5),
        'ffn1_w_out': nrm(ks[4], (L, FFN_DIM, D_MODEL), FFN_DIM ** -0.5),
        'mix_norm': gain(ks[5], (L, D_MODEL)),
        'w_in': nrm(ks[6], (L, D_MODEL, W_IN_COLS), D_MODEL ** -0.5),
        'a_q_gain': gain(ks[7], (L, A_HEAD_DIM)),
        'a_k_gain': gain(ks[8], (L, A_HEAD_DIM)),
        'rel_bias': nrm(ks[9], (REL_BUCKETS, A_HEADS), 0.5),
        'w_o_a': nrm(ks[10], (L, A_WIDTH, D_MODEL), A_WIDTH ** -0.5),
        'ssm_lambda_re': -0.5 + nrm(ks[11], (L, SSM_GROUPS, SSM_STATE), 0.01),
        'ssm_lambda_im': math.pi * n + nrm(ks[12], (L, SSM_GROUPS, SSM_STATE), 0.01),
        'ssm_log_dt': jax.random.uniform(ks[13], (L, SSM_GROUPS), f32,
                                         minval=math.log(DT_MIN), maxval=math.log(DT_MAX)),
        'ssm_b_re': nrm(ks[14], (L, SSM_GROUPS, SSM_STATE, SSM_GROUP_CH), (2 * SSM_GROUP_CH) ** -0.5),
        'ssm_b_im': nrm(ks[15], (L, SSM_GROUPS, SSM_STATE, SSM_GROUP_CH), (2 * SSM_GROUP_CH) ** -0.5),
        'ssm_c_re': nrm(ks[16], (L, SSM_GROUPS, SSM_GROUP_CH, SSM_STATE), SSM_STATE ** -0.5),
        'ssm_c_im': nrm(ks[17], (L, SSM_GROUPS, SSM_GROUP_CH, SSM_STATE), SSM_STATE ** -0.5),
        'ssm_d': nrm(ks[18], (L, SSM_WIDTH), 1.0),
        'w_glu': nrm(ks[19], (L, SSM_WIDTH, 2 * D_MODEL), SSM_WIDTH ** -0.5),
        'mem_norm': gain(ks[20], (L, D_MODEL)),
        'w_mem_kv': nrm(ks[21], (L, D_MODEL, 2 * MEM_WIDTH), D_MODEL ** -0.5),
        'm_q_gain': gain(ks[22], (L, MEM_HEAD_DIM)),
        'm_k_gain': gain(ks[23], (L, MEM_HEAD_DIM)),
        'w_o_m': nrm(ks[24], (L, MEM_WIDTH, D_MODEL), MEM_WIDTH ** -0.5),
        'w_out': nrm(ks[25], (L, D_MODEL, D_MODEL), D_MODEL ** -0.5),
        'ffn2_norm': gain(ks[26], (L, D_MODEL)),
        'ffn2_w_in': nrm(ks[27], (L, D_MODEL, 2 * FFN_DIM), D_MODEL ** -0.5),
        'ffn2_w_out': nrm(ks[28], (L, FFN_DIM, D_MODEL), FFN_DIM ** -0.5),
        'final_norm': gain(ks[29], (L, D_MODEL)),
    }


def reference(x, mem, ffn1_norm, ffn1_w_in, ffn1_w_out, mix_norm, w_in, a_q_gain, a_k_gain,
              rel_bias, w_o_a, ssm_lambda_re, ssm_lambda_im, ssm_log_dt, ssm_b_re, ssm_b_im,
              ssm_c_re, ssm_c_im, ssm_d, w_glu, mem_norm, w_mem_kv, m_q_gain, m_k_gain, w_o_m,
              w_out, ffn2_norm, ffn2_w_in, ffn2_w_out, final_norm):
    b_, s_ = x.shape[0], x.shape[1]
    offsets = [sum(IN_SPLITS[:i + 1]) for i in range(len(IN_SPLITS) - 1)]
    for l in range(DEPTH):
        x = x + 0.5 * swiglu_ffn(rms_norm(x, ffn1_norm[l]), ffn1_w_in[l], ffn1_w_out[l])
        h = rms_norm(x, mix_norm[l])
        q_a, k_a, v_a, q_i, k_i, w_i, u_s, q_m, gates = jnp.split(h @ w_in[l], offsets, axis=-1)
        q_a = rms_norm(q_a.reshape(b_, s_, A_HEADS, A_HEAD_DIM), a_q_gain[l])
        k_a = rms_norm(k_a, a_k_gain[l])
        o_a = indexed_sparse_attention(q_a, k_a, v_a, q_i.reshape(b_, s_, IDX_HEADS, IDX_DIM),
                                       k_i, w_i, rel_bias) @ w_o_a[l]
        y_s = jax.nn.gelu(s5_layer(u_s, ssm_lambda_re[l], ssm_lambda_im[l], ssm_log_dt[l],
                                   ssm_b_re[l], ssm_b_im[l], ssm_c_re[l], ssm_c_im[l], ssm_d[l]))
        glu_a, glu_b = jnp.split(y_s @ w_glu[l], 2, axis=-1)
        o_b = glu_a * jax.nn.sigmoid(glu_b)
        mem_kv = rms_norm(mem, mem_norm[l]) @ w_mem_kv[l]
        m_k, m_v = jnp.split(mem_kv, 2, axis=-1)
        m_k = rms_norm(m_k.reshape(b_, MEM_TOKENS, MEM_HEADS, MEM_HEAD_DIM), m_k_gain[l])
        m_v = m_v.reshape(b_, MEM_TOKENS, MEM_HEADS, MEM_HEAD_DIM)
        q_m = rms_norm(q_m.reshape(b_, s_, MEM_HEADS, MEM_HEAD_DIM), m_q_gain[l])
        o_m = memory_attention(q_m, m_k, m_v) @ w_o_m[l]
        g = jax.nn.sigmoid(gates.reshape(b_, s_, N_BRANCHES, D_MODEL))
        merged = g[:, :, 0] * o_a + g[:, :, 1] * o_b + g[:, :, 2] * o_m
        x = x + merged @ w_out[l]
        x = x + 0.5 * swiglu_ffn(rms_norm(x, ffn2_norm[l]), ffn2_w_in[l], ffn2_w_out[l])
        x = rms_norm(x, final_norm[l])
    return x
```

```cpp
#define MK_N_LAUNCHES 1
#include <hip/hip_runtime.h>
#include <cstdio>
#include <cstdint>

#define GAS __attribute__((address_space(1)))
#define LAS __attribute__((address_space(3)))
typedef _Float16 h16;
typedef _Float16 h16x8 __attribute__((ext_vector_type(8)));
typedef _Float16 h16x4 __attribute__((ext_vector_type(4)));
typedef _Float16 h16x2 __attribute__((ext_vector_type(2)));
typedef float f32x2 __attribute__((ext_vector_type(2)));
typedef float f32x4 __attribute__((ext_vector_type(4)));
typedef float f32x16 __attribute__((ext_vector_type(16)));
typedef unsigned u32x4 __attribute__((ext_vector_type(4)));
typedef unsigned u32x2 __attribute__((ext_vector_type(2)));

constexpr int BATCH = 32, SEQ = 2048, DM = 1024, MTOK = BATCH * SEQ, FFN = 2816;
constexpr int NWIN = 4608;
constexpr int MEMT = 256;
constexpr float NORM_EPS = 1e-6f;
constexpr float LOG2E = 1.4426950408889634f;

__device__ __forceinline__ unsigned pk2h(float lo, float hi) { f32x2 v = {lo, hi}; h16x2 p = __builtin_convertvector(v, h16x2); return __builtin_bit_cast(unsigned, p); }
__device__ __forceinline__ u32x4 pk8h(f32x4 a, f32x4 b) { u32x4 w; w.x = pk2h(a[0], a[1]); w.y = pk2h(a[2], a[3]); w.z = pk2h(b[0], b[1]); w.w = pk2h(b[2], b[3]); return w; }
__device__ __forceinline__ void unpk8h(u32x4 w, f32x4& a, f32x4& b) {
    h16x8 h = __builtin_bit_cast(h16x8, w);
    a = (f32x4){(float)h[0], (float)h[1], (float)h[2], (float)h[3]}; b = (f32x4){(float)h[4], (float)h[5], (float)h[6], (float)h[7]};
}
__device__ __forceinline__ float fast_sigmoid(float x) { return __builtin_amdgcn_rcpf(1.0f + __builtin_amdgcn_exp2f(-x * LOG2E)); }

namespace pg8 {
constexpr int BM = 256, BK = 64, HALF = 128, HTB = HALF * BK * 2  , STAGE_BYTES = 8 * HTB, NXCD = 8, WGM = 8;

__host__ __device__ __forceinline__ int lds_byte(int r, int c) { const int st = (r >> 4) * 2 + (c >> 5), rr = r & 15, cc = c & 31, ob = rr * 64 + cc * 2; return st * 1024 + (ob ^ (((ob >> 9) & 1) << 5)); }
__host__ __device__ __forceinline__ void stage_rc(int b, int& R, int& C) { const int st = b / 1024, sb = b % 1024, swz = sb ^ (((sb >> 9) & 1) << 5); R = (st >> 1) * 16 + swz / 64; C = (st & 1) * 32 + (swz % 64) / 2; }

struct Unit { int pm, pn; };
struct Gemm { const h16* A; const h16* Bt; int K, lda, ldb; };

struct StaticOrder {
    int nM, nN, nwg, G, c;
    __host__ __device__ void init(int M, int N, int G_, int c_) { nM = M / BM; nN = N / BM; nwg = nM * nN; G = G_; c = c_; }
    __host__ __device__ bool next(int i, Unit& u) const {
        const long L = (long)i * G + c; if (L >= nwg) return false;
        int wgid = (int)L; { const int q = nwg / NXCD, r = nwg % NXCD, xcd = wgid % NXCD, off = wgid / NXCD; wgid = (xcd < r ? xcd * (q + 1) : r * (q + 1) + (xcd - r) * q) + off; }
        const int nig = WGM * nN, gid = wgid / nig, fm = gid * WGM, gsz = (nM - fm) < WGM ? (nM - fm) : WGM;
        u.pm = fm + ((wgid % nig) % gsz); u.pn = (wgid % nig) / gsz; return true;
    }
};
struct DiagOrder {
    int tm, tn, ng, G, c;
    __host__ __device__ void init(int ng_, int tm_, int tn_, int G_, int c_) { ng = ng_; tm = tm_; tn = tn_; G = G_; c = c_; }
    __host__ __device__ bool next(int i, Unit& u) const {
        const long L = (long)i * G + c; if (L >= (long)ng * tm * tn) return false;
        const int per = tm * tn, g = (int)L / per, r = (int)L % per;
        u.pm = g * tm + r / tn; u.pn = g * tn + r % tn; return true;
    }
};

template <class Epi, class Sched, bool ALIGN_EPI = false, bool SP2 = false>
__device__ __forceinline__ void gemm_phase(LAS unsigned char* lds, const Gemm g, const Sched& S, const Epi& E) {
    const int tid = threadIdx.x, wid = __builtin_amdgcn_readfirstlane(tid >> 6), lane = tid & 63, wr = wid >> 2, wc = wid & 3, fr = lane & 15, fq = lane >> 4;
    const int K = g.K, nt = K / BK;
    unsigned voffA[2], voffB[2];
#pragma unroll
    for (int i = 0; i < 2; ++i) { int R, C; stage_rc(tid * 16 + i * 8192, R, C);
        voffA[i] = (unsigned)(R * g.lda + C) * 2u; voffB[i] = (unsigned)(R * g.ldb + C) * 2u; }
    const size_t kstep = (size_t)(BK * 2);
    const size_t hstepA = (size_t)HALF * g.lda * 2, hstepB = (size_t)HALF * g.ldb * 2;
    const size_t tstepA = 2 * hstepA, tstepB = 2 * hstepB;
    const unsigned ldsw = (unsigned)wid * 1024u;
    const int aoff = lds_byte(wr * 64 + fr, fq * 8), boff = lds_byte(wc * 32 + fr, fq * 8);
#define PG8_SA(b, h) (((b) * 2 + (h)) * HTB)
#define PG8_SB(b, h) ((4 + (b) * 2 + (h)) * HTB)
#define PG8_STAGE(bufoff, gbase, voff) do { _Pragma("unroll") for (int _i = 0; _i < 2; ++_i) \
        __builtin_amdgcn_global_load_lds((const unsigned*)((const char*)(gbase) + (voff)[_i]), (LAS unsigned*)(lds + (bufoff) + ldsw + _i * 8192), 16, 0, 0); } while (0)
#define PG8_LDA(dst, b, h) do { _Pragma("unroll") for (int m = 0; m < 4; ++m) _Pragma("unroll") for (int k = 0; k < 2; ++k) dst[m][k] = *(const LAS h16x8*)(lds + PG8_SA(b, h) + aoff + m * 2048 + k * 1024); } while (0)
#define PG8_LDB(dst, b, h) do { _Pragma("unroll") for (int n = 0; n < 2; ++n) _Pragma("unroll") for (int k = 0; k < 2; ++k) dst[n][k] = *(const LAS h16x8*)(lds + PG8_SB(b, h) + boff + n * 2048 + k * 1024); } while (0)
#define PG8_MMA(ai, bj, At, Bt) do { __builtin_amdgcn_s_setprio(1); _Pragma("unroll") for (int m = 0; m < 4; ++m) _Pragma("unroll") for (int n = 0; n < 2; ++n) _Pragma("unroll") for (int k = 0; k < 2; ++k) \
        acc[ai][bj][m][n] = __builtin_amdgcn_mfma_f32_16x16x32_f16(Bt[n][k], At[m][k], acc[ai][bj][m][n], 0, 0, 0); __builtin_amdgcn_s_setprio(0); } while (0)
#define PG8_WAIT_V(n) asm volatile("s_waitcnt vmcnt(" #n ")" ::: "memory")
#define PG8_WAIT_L(n) asm volatile("s_waitcnt lgkmcnt(" #n ")" ::: "memory")
#define PG8_BAR __builtin_amdgcn_s_barrier()
#define PG8_SCHED __builtin_amdgcn_sched_barrier(0)
    Unit cur, nxt; int ui = 0;
    if (!S.next(0, cur)) return;
    f32x4 acc[2][2][4][2];
#pragma unroll
    for (int a = 0; a < 2; ++a)
#pragma unroll
        for (int b = 0; b < 2; ++b)
#pragma unroll
            for (int m = 0; m < 4; ++m)
#pragma unroll
                for (int n = 0; n < 2; ++n) acc[a][b][m][n] = (f32x4){0.f, 0.f, 0.f, 0.f};
    h16x8 At[4][2], B0[2][2], B1[2][2];
    const char* cA = (const char*)g.A + (size_t)cur.pm * tstepA; const char* cB = (const char*)g.Bt + (size_t)cur.pn * tstepB;
    if constexpr (SP2) {
        PG8_STAGE(PG8_SB(0, 0), cB, voffB); PG8_STAGE(PG8_SB(0, 1), cB + hstepB, voffB); PG8_STAGE(PG8_SA(0, 0), cA, voffA); PG8_STAGE(PG8_SA(0, 1), cA + hstepA, voffA);
        if (wr == 1) PG8_BAR;
        PG8_WAIT_V(2); PG8_BAR;
        PG8_STAGE(PG8_SB(1, 0), cB + kstep, voffB); PG8_STAGE(PG8_SA(1, 0), cA + kstep, voffA); PG8_STAGE(PG8_SB(1, 1), cB + hstepB + kstep, voffB);
        PG8_WAIT_V(6); PG8_BAR;
    } else {
        PG8_STAGE(PG8_SB(0, 0), cB, voffB); PG8_STAGE(PG8_SA(0, 0), cA, voffA); PG8_STAGE(PG8_SB(0, 1), cB + hstepB, voffB); PG8_STAGE(PG8_SA(0, 1), cA + hstepA, voffA);
        if (wr == 1) PG8_BAR;
        PG8_WAIT_V(4); PG8_BAR;
        PG8_STAGE(PG8_SB(1, 0), cB + kstep, voffB); PG8_STAGE(PG8_SA(1, 0), cA + kstep, voffA); PG8_STAGE(PG8_SB(1, 1), cB + hstepB + kstep, voffB);
        PG8_WAIT_V(6); PG8_BAR;
    }
    for (;;) {
        const bool has_next = S.next(ui + 1, nxt);
        const char* nA = has_next ? (const char*)g.A + (size_t)nxt.pm * tstepA : cA; const char* nB = has_next ? (const char*)g.Bt + (size_t)nxt.pn * tstepB : cB;
        for (int t = 0; t < nt; t += 2) {
            const bool last = (t == nt - 2);
            const char* a1 = cA + (size_t)(t + 1) * kstep;
            const char* a2 = last ? nA : cA + (size_t)(t + 2) * kstep; const char* b2 = last ? nB : cB + (size_t)(t + 2) * kstep;
            const char* a3 = a2 + kstep; const char* b3 = b2 + kstep;
            if constexpr (SP2) {
            PG8_LDB(B0, 0, 0); PG8_LDB(B1, 0, 1); PG8_SCHED; PG8_LDA(At, 0, 0); PG8_STAGE(PG8_SA(1, 1), a1 + hstepA, voffA);
            PG8_WAIT_V(8); PG8_WAIT_L(0); PG8_BAR; PG8_MMA(0, 0, At, B0); PG8_MMA(0, 1, At, B1); PG8_BAR; PG8_SCHED;
            PG8_LDA(At, 0, 1); PG8_STAGE(PG8_SB(0, 0), b2, voffB); PG8_STAGE(PG8_SB(0, 1), b2 + hstepB, voffB); PG8_STAGE(PG8_SA(0, 0), a2, voffA);
            PG8_WAIT_V(8); PG8_WAIT_L(0); PG8_BAR; PG8_MMA(1, 0, At, B0); PG8_MMA(1, 1, At, B1); PG8_BAR; PG8_SCHED;
            PG8_LDB(B0, 1, 0); PG8_LDB(B1, 1, 1); PG8_SCHED; PG8_LDA(At, 1, 0); PG8_STAGE(PG8_SA(0, 1), a2 + hstepA, voffA);
            PG8_WAIT_V(8); PG8_WAIT_L(0); PG8_BAR; PG8_MMA(0, 0, At, B0); PG8_MMA(0, 1, At, B1); PG8_BAR; PG8_SCHED;
            PG8_LDA(At, 1, 1); PG8_STAGE(PG8_SB(1, 0), b3, voffB); PG8_STAGE(PG8_SB(1, 1), b3 + hstepB, voffB); PG8_STAGE(PG8_SA(1, 0), a3, voffA);
            PG8_WAIT_V(8); PG8_WAIT_L(0); PG8_BAR; PG8_MMA(1, 0, At, B0); PG8_MMA(1, 1, At, B1); PG8_BAR; PG8_SCHED;
            } else {
            PG8_LDB(B0, 0, 0); PG8_SCHED; PG8_LDA(At, 0, 0); PG8_STAGE(PG8_SA(1, 1), a1 + hstepA, voffA);
            PG8_WAIT_L(8); PG8_BAR; PG8_WAIT_L(0); PG8_MMA(0, 0, At, B0); PG8_BAR; PG8_SCHED;
            PG8_LDB(B1, 0, 1); PG8_STAGE(PG8_SB(0, 0), b2, voffB);
            PG8_BAR; PG8_WAIT_L(0); PG8_MMA(0, 1, At, B1); PG8_BAR;
            PG8_LDA(At, 0, 1); PG8_STAGE(PG8_SA(0, 0), a2, voffA);
            PG8_BAR; PG8_WAIT_L(0); PG8_MMA(1, 0, At, B0); PG8_BAR; PG8_SCHED;
            PG8_STAGE(PG8_SB(0, 1), b2 + hstepB, voffB);
            PG8_WAIT_V(6); PG8_BAR; PG8_MMA(1, 1, At, B1); PG8_BAR;
            PG8_LDB(B0, 1, 0); PG8_SCHED; PG8_LDA(At, 1, 0); PG8_STAGE(PG8_SA(0, 1), a2 + hstepA, voffA);
            PG8_WAIT_L(8); PG8_BAR; PG8_WAIT_L(0); PG8_MMA(0, 0, At, B0); PG8_BAR; PG8_SCHED;
            PG8_LDB(B1, 1, 1); PG8_STAGE(PG8_SB(1, 0), b3, voffB);
            PG8_BAR; PG8_WAIT_L(0); PG8_MMA(0, 1, At, B1); PG8_BAR;
            PG8_LDA(At, 1, 1); PG8_STAGE(PG8_SA(1, 0), a3, voffA);
            PG8_BAR; PG8_WAIT_L(0); PG8_MMA(1, 0, At, B0); PG8_BAR; PG8_SCHED;
            PG8_STAGE(PG8_SB(1, 1), b3 + hstepB, voffB);
            PG8_WAIT_V(6); PG8_BAR; PG8_MMA(1, 1, At, B1); PG8_BAR;
            }
        }
        if constexpr (ALIGN_EPI) { if (wr == 0) PG8_BAR; }
        if constexpr (!Epi::AFTER_DRAIN) { E(acc, cur, wr, wc, fr, fq); }
        if (!has_next) break;
#pragma unroll
        for (int a = 0; a < 2; ++a)
#pragma unroll
            for (int b = 0; b < 2; ++b)
#pragma unroll
                for (int m = 0; m < 4; ++m)
#pragma unroll
                    for (int n = 0; n < 2; ++n) acc[a][b][m][n] = (f32x4){0.f, 0.f, 0.f, 0.f};
        cur = nxt; cA = nA; cB = nB; ++ui;
        if constexpr (ALIGN_EPI) { if (wr == 1) PG8_BAR; }
    }
    PG8_WAIT_V(0);
    if constexpr (!ALIGN_EPI) { if (wr == 0) PG8_BAR; }
    PG8_BAR;
    if constexpr (Epi::AFTER_DRAIN) { E.fused(acc, cur, wr, wc, fr, fq, lds); }
#undef PG8_SA
#undef PG8_SB
#undef PG8_STAGE
#undef PG8_LDA
#undef PG8_LDB
#undef PG8_MMA
#undef PG8_WAIT_V
#undef PG8_WAIT_L
#undef PG8_BAR
#undef PG8_SCHED
}
}
namespace epi {
using pg8::Unit;
typedef f32x4 Acc[2][2][4][2];

__device__ __forceinline__ float quad16(float s) { s += __shfl_xor(s, 16); s += __shfl_xor(s, 32); return s; }

__device__ __forceinline__ float rstd_from_ssq(const float* ssq, int r) {
    const f32x4* p = (const f32x4*)(ssq + (size_t)r * 16); const f32x4 a = p[0], b = p[1], c = p[2], d = p[3];
    const float s = ((a[0] + a[1]) + (a[2] + a[3])) + ((b[0] + b[1]) + (b[2] + b[3])) + ((c[0] + c[1]) + (c[2] + c[3])) + ((d[0] + d[1]) + (d[2] + d[3]));
    return 1.0f / sqrtf(s * (1.0f / DM) + NORM_EPS);
}
__device__ __forceinline__ float rstd_from_ssq_q(const float* ssq, int r, int fq) {
    const f32x4 a = ((const f32x4*)(ssq + (size_t)r * 16))[fq];
    const float s = quad16((a[0] + a[1]) + (a[2] + a[3]));
    return 1.0f / sqrtf(s * (1.0f / DM) + NORM_EPS);
}
template <int SRC  > struct EpiSwiglu {
    static constexpr bool AFTER_DRAIN = false;
    h16* H; const float* rsrc;
    __device__ __forceinline__ void operator()(const Acc& acc, const Unit& u, int wr, int wc, int fr, int fq) const {
        const int row0 = u.pm * 256 + wr * 64 + fr, col = u.pn * 128 + wc * 32 + fq * 8;
#pragma unroll
        for (int ai = 0; ai < 2; ++ai)
#pragma unroll
            for (int m = 0; m < 4; ++m) {
                const int r = row0 + ai * 128 + m * 16; const float rs = SRC == 0 ? rsrc[r] : rstd_from_ssq_q(rsrc, r, fq);
                f32x4 o[2];
#pragma unroll
                for (int n = 0; n < 2; ++n)
#pragma unroll
                    for (int j = 0; j < 4; ++j) { const float g = acc[ai][0][m][n][j] * rs, up = acc[ai][1][m][n][j] * rs; o[n][j] = g * fast_sigmoid(g) * up; }
                *(u32x4*)(H + (size_t)r * FFN + col) = pk8h(o[0], o[1]);
            }
    }
};

struct EpiResid {
    static constexpr bool AFTER_DRAIN = false;
    const float* base; float* out; h16* outh; float* ssq; float alpha;
    __device__ __forceinline__ void operator()(const Acc& acc, const Unit& u, int wr, int wc, int fr, int fq) const {
        const int row0 = u.pm * 256 + wr * 64 + fr, col0 = u.pn * 256 + wc * 32 + fq * 8;
#pragma unroll
        for (int ai = 0; ai < 2; ++ai)
#pragma unroll
            for (int m = 0; m < 4; ++m) {
                const int r = row0 + ai * 128 + m * 16; float sq = 0.f;
#pragma unroll
                for (int bj = 0; bj < 2; ++bj) {
                    const size_t off = (size_t)r * DM + col0 + bj * 128;
                    const f32x4 b0 = *(const f32x4*)(base + off), b1 = *(const f32x4*)(base + off + 4);
                    const f32x4 v0 = b0 + alpha * acc[ai][bj][m][0], v1 = b1 + alpha * acc[ai][bj][m][1];
                    *(f32x4*)(out + off) = v0; *(f32x4*)(out + off + 4) = v1;
                    if (outh) *(u32x4*)(outh + off) = pk8h(v0, v1);
                    sq += (v0[0] * v0[0] + v0[1] * v0[1]) + (v0[2] * v0[2] + v0[3] * v0[3]) + (v1[0] * v1[0] + v1[1] * v1[1]) + (v1[2] * v1[2] + v1[3] * v1[3]);
                }
                sq = quad16(sq);
                if (fq == 0) ssq[(size_t)r * 16 + u.pn * 4 + wc] = sq;
            }
    }
};

__device__ __forceinline__ void head_norm_store(const Acc& acc, int ai, int m, float rs, const float* gain, float oscale, h16* dst  , int fq) {
    float sq = 0.f;
#pragma unroll
    for (int bj = 0; bj < 2; ++bj)
#pragma unroll
        for (int n = 0; n < 2; ++n)
#pragma unroll
            for (int j = 0; j < 4; ++j) { const float v = acc[ai][bj][m][n][j] * rs; sq += v * v; }
    sq = quad16(sq);
    const float r = oscale / sqrtf(sq * (1.0f / 64.0f) + NORM_EPS);
#pragma unroll
    for (int bj = 0; bj < 2; ++bj) {
        const f32x4 g0 = *(const f32x4*)(gain + 32 * bj + 8 * fq), g1 = *(const f32x4*)(gain + 32 * bj + 8 * fq + 4);
        const f32x4 v0 = acc[ai][bj][m][0] * (rs * r) * g0, v1 = acc[ai][bj][m][1] * (rs * r) * g1;
        *(u32x4*)(dst + 32 * bj + 8 * fq) = pk8h(v0, v1);
    }
}

struct EpiWin {
    static constexpr bool AFTER_DRAIN = false;
    const float* ssq;
    const float *gq, *gk, *gmq;
    h16 *qa, *ka, *va, *qidx, *kidx, *acat, *qm, *gates; float* widx;
    __device__ __forceinline__ void operator()(const Acc& acc, const Unit& u, int wr, int wc, int fr, int fq) const {
        const int row0 = u.pm * 256 + wr * 64 + fr; const int pn = u.pn;
        float rs[2][4];
#pragma unroll
        for (int ai = 0; ai < 2; ++ai)
#pragma unroll
            for (int m = 0; m < 4; ++m) rs[ai][m] = rstd_from_ssq_q(ssq, row0 + ai * 128 + m * 16, fq);
        if (pn < 2) {
#pragma unroll
            for (int ai = 0; ai < 2; ++ai)
#pragma unroll
                for (int m = 0; m < 4; ++m) { const int r = row0 + ai * 128 + m * 16;
                    head_norm_store(acc, ai, m, rs[ai][m], gq, 0.125f * LOG2E, qa + (size_t)r * 512 + (4 * pn + wc) * 64, fq); }
        } else if (pn == 2) {
            if (wc == 0) {
#pragma unroll
                for (int ai = 0; ai < 2; ++ai)
#pragma unroll
                    for (int m = 0; m < 4; ++m) { const int r = row0 + ai * 128 + m * 16; head_norm_store(acc, ai, m, rs[ai][m], gk, 1.0f, ka + (size_t)r * 64, fq); }
            } else if (wc == 1) {
#pragma unroll
                for (int ai = 0; ai < 2; ++ai)
#pragma unroll
                    for (int m = 0; m < 4; ++m) { const int r = row0 + ai * 128 + m * 16;
#pragma unroll
                        for (int bj = 0; bj < 2; ++bj) *(u32x4*)(va + (size_t)r * 64 + 32 * bj + 8 * fq) = pk8h(acc[ai][bj][m][0] * rs[ai][m], acc[ai][bj][m][1] * rs[ai][m]); }
            } else if (wc == 2) {
#pragma unroll
                for (int ai = 0; ai < 2; ++ai)
#pragma unroll
                    for (int m = 0; m < 4; ++m) { const int r = row0 + ai * 128 + m * 16;
#pragma unroll
                        for (int bj = 0; bj < 2; ++bj) *(u32x4*)(kidx + (size_t)r * 64 + 32 * bj + 8 * fq) = pk8h(acc[ai][bj][m][0] * rs[ai][m], acc[ai][bj][m][1] * rs[ai][m]); }
            } else {
                if (fq == 0) {
#pragma unroll
                    for (int ai = 0; ai < 2; ++ai)
#pragma unroll
                        for (int m = 0; m < 4; ++m) { const int r = row0 + ai * 128 + m * 16; *(f32x4*)(widx + (size_t)r * 4) = acc[ai][0][m][0] * (rs[ai][m] * 0.0625f); }
                }
            }
        } else if (pn == 3) {
#pragma unroll
            for (int ai = 0; ai < 2; ++ai)
#pragma unroll
                for (int m = 0; m < 4; ++m) { const int r = row0 + ai * 128 + m * 16;
#pragma unroll
                    for (int bj = 0; bj < 2; ++bj) *(u32x4*)(qidx + (size_t)r * 256 + 128 * bj + 32 * wc + 8 * fq) = pk8h(acc[ai][bj][m][0] * rs[ai][m], acc[ai][bj][m][1] * rs[ai][m]); }
        } else if (pn == 4) {
#pragma unroll
            for (int ai = 0; ai < 2; ++ai)
#pragma unroll
                for (int m = 0; m < 4; ++m) { const int r = row0 + ai * 128 + m * 16; const int bc = r >> 6, s = r & 63;
#pragma unroll
                    for (int bj = 0; bj < 2; ++bj) { const int col = 128 * bj + 32 * wc + 8 * fq, g = col >> 4, c0 = col & 15;
                        *(u32x4*)(acat + ((size_t)g * 1024 + bc) * 1280 + 16 * s + c0) = pk8h(acc[ai][bj][m][0] * rs[ai][m], acc[ai][bj][m][1] * rs[ai][m]); } }
        } else if (pn == 5) {
#pragma unroll
            for (int ai = 0; ai < 2; ++ai)
#pragma unroll
                for (int m = 0; m < 4; ++m) { const int r = row0 + ai * 128 + m * 16;
                    head_norm_store(acc, ai, m, rs[ai][m], gmq, 0.125f * LOG2E, qm + (size_t)r * 256 + wc * 64, fq); }
        } else {
#pragma unroll
            for (int ai = 0; ai < 2; ++ai)
#pragma unroll
                for (int m = 0; m < 4; ++m) { const int r = row0 + ai * 128 + m * 16;
#pragma unroll
                    for (int bj = 0; bj < 2; ++bj) { f32x4 v0 = acc[ai][bj][m][0] * rs[ai][m], v1 = acc[ai][bj][m][1] * rs[ai][m];
#pragma unroll
                        for (int j = 0; j < 4; ++j) { v0[j] = fast_sigmoid(v0[j]); v1[j] = fast_sigmoid(v1[j]); }
                        *(u32x4*)(gates + (size_t)r * 3072 + (pn - 6) * 256 + 128 * bj + 32 * wc + 8 * fq) = pk8h(v0, v1); } }
        }
    }
};

struct EpiMemKV {
    static constexpr bool AFTER_DRAIN = false;
    const float* gmk; h16* mk; h16* mvT;
    __device__ __forceinline__ void operator()(const Acc& acc, const Unit& u, int wr, int wc, int fr, int fq) const {
        const int row0 = u.pm * 256 + wr * 64 + fr;
        if (u.pn == 0) {
#pragma unroll
            for (int ai = 0; ai < 2; ++ai)
#pragma unroll
                for (int m = 0; m < 4; ++m) { const int r = row0 + ai * 128 + m * 16; head_norm_store(acc, ai, m, 1.0f, gmk, 1.0f, mk + (size_t)r * 256 + wc * 64, fq); }
        } else {
#pragma unroll
            for (int ai = 0; ai < 2; ++ai)
#pragma unroll
                for (int m = 0; m < 4; ++m) { const int r = row0 + ai * 128 + m * 16; const int b = r >> 8, kv = r & 255;
                    h16* dst = mvT + ((size_t)(b * 4 + wc) * 64) * MEMT + kv;
#pragma unroll
                    for (int bj = 0; bj < 2; ++bj)
#pragma unroll
                        for (int n = 0; n < 2; ++n)
#pragma unroll
                            for (int j = 0; j < 4; ++j) dst[(size_t)(32 * bj + 8 * fq + 4 * n + j) * MEMT] = (h16)acc[ai][bj][m][n][j]; }
        }
    }
};

struct EpiGlu {
    static constexpr bool AFTER_DRAIN = false;
    h16* ob;
    __device__ __forceinline__ void operator()(const Acc& acc, const Unit& u, int wr, int wc, int fr, int fq) const {
        const int row0 = u.pm * 256 + wr * 64 + fr, col = u.pn * 128 + wc * 32 + fq * 8;
#pragma unroll
        for (int ai = 0; ai < 2; ++ai)
#pragma unroll
            for (int m = 0; m < 4; ++m) { const int r = row0 + ai * 128 + m * 16; f32x4 o[2];
#pragma unroll
                for (int n = 0; n < 2; ++n)
#pragma unroll
                    for (int j = 0; j < 4; ++j) o[n][j] = acc[ai][0][m][n][j] * fast_sigmoid(acc[ai][1][m][n][j]);
                *(u32x4*)(ob + (size_t)r * DM + col) = pk8h(o[0], o[1]); }
    }
};

template <int MODE> struct EpiMerge {
    static constexpr bool AFTER_DRAIN = false;
    const h16* gates; const h16* ob; h16* merged;
    __device__ __forceinline__ void operator()(const Acc& acc, const Unit& u, int wr, int wc, int fr, int fq) const {
        const int row0 = u.pm * 256 + wr * 64 + fr, col0 = u.pn * 256 + wc * 32 + fq * 8;
#pragma unroll
        for (int ai = 0; ai < 2; ++ai)
#pragma unroll
            for (int m = 0; m < 4; ++m) { const int r = row0 + ai * 128 + m * 16;
#pragma unroll
                for (int bj = 0; bj < 2; ++bj) { const int col = col0 + bj * 128;
                    f32x4 ga0, ga1, t0, t1;
                    if (MODE == 0) { f32x4 gb0, gb1, o0, o1;
                        unpk8h(*(const u32x4*)(gates + (size_t)r * 3072 + col), ga0, ga1); unpk8h(*(const u32x4*)(gates + (size_t)r * 3072 + 1024 + col), gb0, gb1);
                        unpk8h(*(const u32x4*)(ob + (size_t)r * DM + col), o0, o1);
                        t0 = ga0 * acc[ai][bj][m][0] + gb0 * o0; t1 = ga1 * acc[ai][bj][m][1] + gb1 * o1;
                    } else {
                        unpk8h(*(const u32x4*)(gates + (size_t)r * 3072 + 2048 + col), ga0, ga1); unpk8h(*(const u32x4*)(merged + (size_t)r * DM + col), t0, t1);
                        t0 = t0 + ga0 * acc[ai][bj][m][0]; t1 = t1 + ga1 * acc[ai][bj][m][1];
                    }
                    *(u32x4*)(merged + (size_t)r * DM + col) = pk8h(t0, t1); } }
    }
};

struct EpiS5Main {
    static constexpr bool AFTER_DRAIN = false;
    const float* logdt; h16* ys;
    __device__ __forceinline__ void operator()(const Acc& acc, const Unit& u, int wr, int wc, int fr, int fq) const {
        const int g = u.pm >> 2, pmm = u.pm & 3, pnn = u.pn & 3; const float dt = __expf(logdt[g]);
        const int row0 = pmm * 256 + wr * 64 + fr;
#pragma unroll
        for (int ai = 0; ai < 2; ++ai)
#pragma unroll
            for (int m = 0; m < 4; ++m) { const int bc = row0 + ai * 128 + m * 16;
#pragma unroll
                for (int bj = 0; bj < 2; ++bj) { const int tc = pnn * 256 + 128 * bj + 32 * wc + 8 * fq, t = tc >> 4, c0 = tc & 15;
                    f32x4 v[2];
#pragma unroll
                    for (int n = 0; n < 2; ++n)
#pragma unroll
                        for (int j = 0; j < 4; ++j) { const float y = acc[ai][bj][m][n][j] * dt; const float z = 1.5957691216f * (y + 0.044715f * y * y * y); v[n][j] = y * fast_sigmoid(z); }
                    *(u32x4*)(ys + ((size_t)bc * 64 + t) * 256 + 16 * g + c0) = pk8h(v[0], v[1]); } }
    }
};

struct EpiS5State {
    static constexpr bool AFTER_DRAIN = true;
    const float* logdt; const float* a64;
    h16* acat;
    __device__ __forceinline__ void fused(const Acc& acc, const Unit& u, int wr, int wc, int fr, int fq, LAS unsigned char* lds) const {
        const int g = u.pn, pmm = u.pm & 3; const float dt = __expf(logdt[g]);
        LAS float* sb = (LAS float*)lds;
#pragma unroll
        for (int ai = 0; ai < 2; ++ai)
#pragma unroll
            for (int m = 0; m < 4; ++m) { const int r = ai * 128 + wr * 64 + m * 16 + fr;
                *(LAS f32x4*)(sb + r * 132 + 32 * wc + 8 * fq) = acc[ai][0][m][0] * dt; *(LAS f32x4*)(sb + r * 132 + 32 * wc + 8 * fq + 4) = acc[ai][0][m][1] * dt; }
        __syncthreads();
        const int tid = threadIdx.x, bl = tid >> 6, p = tid & 63;
        const float ar = a64[(g * 64 + p) * 2], ai_ = a64[(g * 64 + p) * 2 + 1];
        float xr = 0.f, xi = 0.f;
        h16* dst = acat + ((size_t)g * 1024 + (size_t)(pmm * 8 + bl) * 32) * 1280;
        for (int ch = 0; ch < 32; ++ch) {
            dst[(size_t)ch * 1280 + 1024 + p] = (h16)xr; dst[(size_t)ch * 1280 + 1088 + p] = (h16)xi;
            dst[(size_t)ch * 1280 + 1152 + p] = (h16)0.f; dst[(size_t)ch * 1280 + 1216 + p] = (h16)0.f;
            const float sr = sb[(bl * 32 + ch) * 132 + p], si = sb[(bl * 32 + ch) * 132 + 64 + p];
            const float nr = ar * xr - ai_ * xi + sr, ni = ar * xi + ai_ * xr + si; xr = nr; xi = ni;
        }
        __syncthreads();
    }
};
}
namespace pro {
#define LDS_WAIT() asm volatile("s_waitcnt lgkmcnt(0)" ::: "memory")

__device__ __forceinline__ float wave_sum(float v) {
#pragma unroll
    for (int o = 1; o < 64; o <<= 1) v += __shfl_xor(v, o);
    return v;
}

__device__ __forceinline__ void tr_item(const float* W, int ldw, int src0, int nvalid, const float* gain, h16* Bt, int K, int row0, int k0, LAS float* scr, int lane) {
#pragma unroll 8
    for (int i = 0; i < 32; ++i) { const int kk = 2 * i + (lane >> 5), c = lane & 31;
        float v = 0.f; if (c < nvalid) v = W[(size_t)(k0 + kk) * ldw + src0 + c];
        if (gain) v *= gain[k0 + kk];
        scr[kk * 33 + c] = v; }
    LDS_WAIT(); asm volatile("" ::: "memory");
    const int c8 = lane & 7;
#pragma unroll
    for (int jj = 0; jj < 4; ++jj) { const int q = (lane >> 3) + 8 * jj; const int o = 8 * ((q >> 2) & 3) + 4 * (q >> 4) + (q & 3);
        const LAS float* s = scr + (8 * c8) * 33 + o;
        u32x4 w; w.x = pk2h(s[0 * 33], s[1 * 33]); w.y = pk2h(s[2 * 33], s[3 * 33]); w.z = pk2h(s[4 * 33], s[5 * 33]); w.w = pk2h(s[6 * 33], s[7 * 33]);
        *(u32x4*)(Bt + (size_t)(row0 + q) * K + k0 + 8 * c8) = w; }
    LDS_WAIT(); asm volatile("" ::: "memory");
}

__device__ __forceinline__ int win_src0(int gi, int& nv) {
    const int pn = gi >> 3, bj = (gi >> 2) & 1, wc = gi & 3; nv = 32;
    if (pn < 2) return 64 * (4 * pn + wc) + 32 * bj;
    if (pn == 2) { if (wc == 0) return 512 + 32 * bj; if (wc == 1) return 576 + 32 * bj; if (wc == 2) return 896 + 32 * bj; nv = bj ? 0 : 4; return 960; }
    if (pn == 3) return 640 + 128 * bj + 32 * wc;
    if (pn == 4) return 964 + 128 * bj + 32 * wc;
    if (pn == 5) return 1220 + 64 * wc + 32 * bj;
    return 1476 + 256 * (pn - 6) + 128 * bj + 32 * wc;
}

struct WPtrs { const float *w1a, *w1b, *win, *wmkv, *wglu, *woa, *wom, *wout, *w2a, *w2b, *g1, *gmix, *g2;
               h16 *W1A, *W1B, *WIN, *WMKV, *WGLU, *WOA, *WOM, *WOUT, *W2A, *W2B; };

constexpr int IT_1A = 176 * 16, IT_1B = 32 * 44, IT_IN = 144 * 16, IT_MKV = 16 * 16, IT_GLU = 64 * 4, IT_OA = 32 * 8, IT_OM = 32 * 4, IT_OUT = 32 * 16;
constexpr int IT_TOTAL = 2 * IT_1A + 2 * IT_1B + IT_IN + IT_MKV + IT_GLU + IT_OA + IT_OM + IT_OUT;

__device__ __forceinline__ void weight_item(const WPtrs& P, int it, LAS float* scr, int lane) {
    int r = it;
    if (r < 2 * IT_1A) { const bool second = r >= IT_1A; if (second) r -= IT_1A; const int gi = r >> 4, kb = r & 15; const int pn = gi >> 3, bj = (gi >> 2) & 1, wc = gi & 3;
        tr_item(second ? P.w2a : P.w1a, 2 * FFN, (bj ? FFN : 0) + 128 * pn + 32 * wc, 32, second ? P.g2 : P.g1, second ? P.W2A : P.W1A, 1024, 32 * gi, 64 * kb, scr, lane); return; }
    r -= 2 * IT_1A;
    if (r < 2 * IT_1B) { const bool second = r >= IT_1B; if (second) r -= IT_1B; const int gi = r / 44, kb = r % 44;
        tr_item(second ? P.w2b : P.w1b, DM, 32 * gi, 32, nullptr, second ? P.W2B : P.W1B, FFN, 32 * gi, 64 * kb, scr, lane); return; }
    r -= 2 * IT_1B;
    if (r < IT_IN) { const int gi = r >> 4, kb = r & 15; int nv; const int s0 = win_src0(gi, nv);
        tr_item(P.win, 4548, s0, nv, P.gmix, P.WIN, 1024, 32 * gi, 64 * kb, scr, lane); return; }
    r -= IT_IN;
    if (r < IT_MKV) { const int gi = r >> 4, kb = r & 15; const int pn = gi >> 3, bj = (gi >> 2) & 1, wc = gi & 3;
        tr_item(P.wmkv, 512, 256 * pn + 64 * wc + 32 * bj, 32, nullptr, P.WMKV, 1024, 32 * gi, 64 * kb, scr, lane); return; }
    r -= IT_MKV;
    if (r < IT_GLU) { const int gi = r >> 2, kb = r & 3; const int pn = gi >> 3, bj = (gi >> 2) & 1, wc = gi & 3;
        tr_item(P.wglu, 2048, (bj ? 1024 : 0) + 128 * pn + 32 * wc, 32, nullptr, P.WGLU, 256, 32 * gi, 64 * kb, scr, lane); return; }
    r -= IT_GLU;
    if (r < IT_OA) { const int gi = r >> 3, kb = r & 7; tr_item(P.woa, DM, 32 * gi, 32, nullptr, P.WOA, 512, 32 * gi, 64 * kb, scr, lane); return; }
    r -= IT_OA;
    if (r < IT_OM) { const int gi = r >> 2, kb = r & 3; tr_item(P.wom, DM, 32 * gi, 32, nullptr, P.WOM, 256, 32 * gi, 64 * kb, scr, lane); return; }
    r -= IT_OM;
    { const int gi = r >> 4, kb = r & 15; tr_item(P.wout, DM, 32 * gi, 32, nullptr, P.WOUT, 1024, 32 * gi, 64 * kb, scr, lane); }
}

__device__ __forceinline__ float row_to_h16(const float* xrow, h16* orow, const float* gain, int lane) {
    const f32x4* xr = (const f32x4*)xrow + lane;
    f32x4 v[4]; float s = 0.f;
#pragma unroll
    for (int j = 0; j < 4; ++j) { v[j] = xr[64 * j]; s += (v[j][0] * v[j][0] + v[j][1] * v[j][1]) + (v[j][2] * v[j][2] + v[j][3] * v[j][3]); }
    const float rstd = 1.0f / sqrtf(wave_sum(s) * (1.0f / DM) + NORM_EPS);
    u32x2* o8 = (u32x2*)orow + lane;
#pragma unroll
    for (int j = 0; j < 4; ++j) { f32x4 w = v[j];
        if (gain) { const f32x4 gv = ((const f32x4*)gain)[lane + 64 * j]; w = w * rstd * gv; }
        u32x2 p; p.x = pk2h(w[0], w[1]); p.y = pk2h(w[2], w[3]); o8[64 * j] = p; }
    return rstd;
}

struct S5In { const float *lre, *lim, *logdt, *bre, *bim, *cre, *cim, *dd; };
__device__ __forceinline__ int slot_row(int c) { const int o = c & 31; return (c & ~31) + 16 * ((o >> 2) & 1) + 4 * (o >> 3) + (o & 3); }
__device__ __forceinline__ void cpow(float ar, float ai, int n, float& pr, float& pi) {
    pr = 1.f; pi = 0.f;
    for (int i = 0; i < n; ++i) { const float t = pr * ar - pi * ai; pi = pr * ai + pi * ar; pr = t; }
}
__device__ __forceinline__ void s5_item(const S5In& I, int g, int j, h16* tcat, h16* wst, float* a64, LAS float* L, int tid) {
    LAS float* Pj = L;
    LAS float* Pj1 = L + 128;
    LAS float* P63 = L + 256;
    LAS float* Bb = L + 384;
    LAS float* CP = L + 384 + 2048;
    LAS float* Kb = L + 384 + 4096;
    const float dt = __expf(I.logdt[g]); const float sig = 1.0f / dt;
    __syncthreads();
    if (tid < 64) { const int p = tid; const float lr = I.lre[g * 64 + p], li = I.lim[g * 64 + p];
        const float mag = __expf(lr * dt); const float ar = mag * cosf(li * dt), ai = mag * sinf(li * dt);
        const float den = lr * lr + li * li; const float fr = ((ar - 1.0f) * lr + ai * li) / den, fi = (ai * lr - (ar - 1.0f) * li) / den;
        float pr, pi; cpow(ar, ai, j, pr, pi); Pj[2 * p] = pr; Pj[2 * p + 1] = pi;
        { const float t = pr * ar - pi * ai; const float u = pr * ai + pi * ar; Pj1[2 * p] = t; Pj1[2 * p + 1] = u; }
        cpow(ar, ai, 63 - j, pr, pi); P63[2 * p] = pr; P63[2 * p + 1] = pi;
        if (j == 0) { cpow(ar, ai, 64, pr, pi); a64[(g * 64 + p) * 2] = pr; a64[(g * 64 + p) * 2 + 1] = pi; }
#pragma unroll 4
        for (int c = 0; c < 16; ++c) { const float br = I.bre[(g * 64 + p) * 16 + c], bi = I.bim[(g * 64 + p) * 16 + c];
            Bb[(p * 16 + c) * 2] = fr * br - fi * bi; Bb[(p * 16 + c) * 2 + 1] = fr * bi + fi * br; }
    }
    __syncthreads();
    for (int e = tid; e < 1024; e += 512) { const int cp = e >> 6, p = e & 63;
        const float cr = I.cre[(g * 16 + cp) * 64 + p], ci = I.cim[(g * 16 + cp) * 64 + p], pr = Pj[2 * p], pi = Pj[2 * p + 1];
        CP[e * 2] = cr * pr - ci * pi; CP[e * 2 + 1] = cr * pi + ci * pr; }
    __syncthreads();
    if (tid < 256) { const int cp = tid >> 4, c = tid & 15; float s = 0.f;
        for (int p = 0; p < 64; ++p) s += CP[(cp * 64 + p) * 2] * Bb[(p * 16 + c) * 2] - CP[(cp * 64 + p) * 2 + 1] * Bb[(p * 16 + c) * 2 + 1];
        if (j == 0 && cp == c) s += I.dd[g * 16 + c];
        Kb[tid] = s * sig; }
    __syncthreads();
    h16* T = tcat + (size_t)g * 1024 * 1280;
    for (int e = tid; e < (64 - j) * 32; e += 512) { const int d = e >> 5, cp = (e >> 1) & 15, h = e & 1;
        const LAS float* k = Kb + cp * 16 + 8 * h;
        u32x4 w; w.x = pk2h(k[0], k[1]); w.y = pk2h(k[2], k[3]); w.z = pk2h(k[4], k[5]); w.w = pk2h(k[6], k[7]);
        *(u32x4*)(T + (size_t)slot_row((j + d) * 16 + cp) * 1280 + 16 * d + 8 * h) = w;
        if (j > 0) *(u32x4*)(T + (size_t)slot_row(d * 16 + cp) * 1280 + 16 * (j + d) + 8 * h) = (u32x4){0u, 0u, 0u, 0u}; }
    for (int e = tid; e < 1024; e += 512) { const int cp = e >> 6, p = e & 63;
        const float cr = I.cre[(g * 16 + cp) * 64 + p], ci = I.cim[(g * 16 + cp) * 64 + p], pr = Pj1[2 * p], pi = Pj1[2 * p + 1];
        h16* row = T + (size_t)slot_row(j * 16 + cp) * 1280;
        row[1024 + p] = (h16)((cr * pr - ci * pi) * sig); row[1088 + p] = (h16)(-(cr * pi + ci * pr) * sig); row[1152 + p] = (h16)0.f; row[1216 + p] = (h16)0.f; }
    h16* Wg = wst + (size_t)g * 256 * 1024;
    for (int e = tid; e < 1024; e += 512) { const int p = e >> 4, c = e & 15;
        const float pr = P63[2 * p], pi = P63[2 * p + 1], br = Bb[(p * 16 + c) * 2], bi = Bb[(p * 16 + c) * 2 + 1];
        Wg[(size_t)slot_row(p) * 1024 + 16 * j + c] = (h16)((pr * br - pi * bi) * sig); Wg[(size_t)slot_row(64 + p) * 1024 + 16 * j + c] = (h16)((pr * bi + pi * br) * sig); }
    for (int e = tid; e < 128 * 16; e += 512) { const int rr = 128 + (e >> 4), c = e & 15; Wg[(size_t)rr * 1024 + 16 * j + c] = (h16)0.f; }
}
}
namespace att {
constexpr int SC_STRIDE = 2052;
constexpr int L_KS = 0, L_VS = 9216, L_MASK = 65664, L_HIST = 82304, L_CAND = 90496, L_RELB = 94592, L_FBUF = 101760, L_END = 103808;
constexpr float NEG_INF = -__builtin_inff();
constexpr float THR = 6.0f;

struct P {
    const h16 *qa, *ka, *va, *qidx, *kidx, *qm, *mk, *mvT; const float* widx; const float* relb;
    h16* out;
};

__device__ __forceinline__ int crow(int r, int hi) { return (r & 3) + 8 * (r >> 2) + 4 * hi; }
__device__ __forceinline__ unsigned fkey(float f) { const unsigned u = __float_as_uint(f); return u ^ ((unsigned)((int)u >> 31) | 0x80000000u); }
__device__ __forceinline__ float swapmax(float m) { auto rr = __builtin_amdgcn_permlane32_swap(__float_as_uint(m), __float_as_uint(m), false, false); return fmaxf(__uint_as_float(rr[0]), __uint_as_float(rr[1])); }
__device__ __forceinline__ float swapsum(float m) { auto rr = __builtin_amdgcn_permlane32_swap(__float_as_uint(m), __float_as_uint(m), false, false); return __uint_as_float(rr[0]) + __uint_as_float(rr[1]); }
__device__ __forceinline__ float qperm_b1(float v) { return __int_as_float(__builtin_amdgcn_mov_dpp(__float_as_int(v), 0xB1, 0xF, 0xF, true)); }
__device__ __forceinline__ float qperm_4e(float v) { return __int_as_float(__builtin_amdgcn_mov_dpp(__float_as_int(v), 0x4E, 0xF, 0xF, true)); }

__device__ __forceinline__ int t5_bucket(int rel) {
    const int n = rel < 0 ? -rel : rel; int v;
    if (n < 8) v = n; else if (n < 12) v = 8; else if (n < 16) v = 9; else if (n < 23) v = 10; else if (n < 32) v = 11; else if (n < 46) v = 12; else if (n < 64) v = 13; else if (n < 91) v = 14; else v = 15;
    return (rel > 0 ? 16 : 0) + v;
}

__device__ __forceinline__ void softmax_tile(f32x16& s, float& mrun, float& lsum, f32x16& O0, f32x16& O1, LAS float* fb  , int lane, int hi, h16x8& p0, h16x8& p1) {
    float tm = fmaxf(fmaxf(s[0], s[1]), fmaxf(s[2], s[3]));
#pragma unroll
    for (int r = 4; r < 16; r += 4) tm = fmaxf(tm, fmaxf(fmaxf(s[r], s[r + 1]), fmaxf(s[r + 2], s[r + 3])));
    tm = swapmax(tm);
    const bool need = tm > mrun + THR;
    if (__any(need)) {
        const float mnew = need ? tm : mrun; const float f = need ? __builtin_amdgcn_exp2f(mrun - mnew) : 1.0f;
        mrun = mnew; lsum *= f;
        if (hi == 0) fb[lane] = f;
        asm volatile("s_waitcnt lgkmcnt(0)" ::: "memory");
#pragma unroll
        for (int g = 0; g < 4; ++g) { const f32x4 fv = *(const LAS f32x4*)(fb + 8 * g + 4 * hi);
#pragma unroll
            for (int i = 0; i < 4; ++i) { O0[4 * g + i] *= fv[i]; O1[4 * g + i] *= fv[i]; } }
        asm volatile("s_waitcnt lgkmcnt(0)" ::: "memory");
    }
    float ps = 0.f;
#pragma unroll
    for (int r = 0; r < 16; ++r) { s[r] = __builtin_amdgcn_exp2f(s[r] - mrun); ps += s[r]; }
    lsum += ps;
    p0 = (h16x8){(h16)s[0], (h16)s[1], (h16)s[2], (h16)s[3], (h16)s[4], (h16)s[5], (h16)s[6], (h16)s[7]};
    p1 = (h16x8){(h16)s[8], (h16)s[9], (h16)s[10], (h16)s[11], (h16)s[12], (h16)s[13], (h16)s[14], (h16)s[15]};
}
__device__ __forceinline__ void store_o(const f32x16& O0, const f32x16& O1, float lsum, LAS float* fb, int lane, int hi, h16* out, size_t tok0, int col0) {
    const float lt = swapsum(lsum);
    if (hi == 0) fb[lane] = 1.0f / lt;
    asm volatile("s_waitcnt lgkmcnt(0)" ::: "memory");
#pragma unroll
    for (int g = 0; g < 4; ++g) { const f32x4 fv = *(const LAS f32x4*)(fb + 8 * g + 4 * hi);
#pragma unroll
        for (int i = 0; i < 4; ++i) { const int q = 8 * g + 4 * hi + i; h16* o = out + (tok0 + q) * 768 + col0 + (lane & 31);
            o[0] = (h16)(O0[4 * g + i] * fv[i]); o[32] = (h16)(O1[4 * g + i] * fv[i]); } }
    asm volatile("s_waitcnt lgkmcnt(0)" ::: "memory");
}

__device__ __forceinline__ float ld_score(const LAS float* row, int i, int lane) { return row[64 * i + lane] + 0.0f; }
__device__ __forceinline__ void select_row(const LAS float* row, int nreg, LAS unsigned* hist, LAS unsigned long long* cand, LAS unsigned* mrow, int lane) {
    float lo = __builtin_inff(), hv = -__builtin_inff();
#pragma unroll 4
    for (int i = 0; i < nreg; ++i) { const float s = ld_score(row, i, lane); lo = fminf(lo, s); hv = fmaxf(hv, s); }
#pragma unroll
    for (int o = 1; o < 64; o <<= 1) { lo = fminf(lo, __shfl_xor(lo, o)); hv = fmaxf(hv, __shfl_xor(hv, o)); }
    unsigned T = fkey(lo); int istar = 255;
    if (hv != lo) {
        const float scale = 256.0f / (hv - lo);
        *(LAS u32x4*)(hist + 4 * lane) = (u32x4){0u, 0u, 0u, 0u};
        asm volatile("s_waitcnt lgkmcnt(0)" ::: "memory");
#pragma unroll 4
        for (int i = 0; i < nreg; ++i) { int bin = (int)((ld_score(row, i, lane) - lo) * scale); bin = bin > 255 ? 255 : bin; __hip_atomic_fetch_add(hist + bin, 1u, __ATOMIC_RELAXED, __HIP_MEMORY_SCOPE_WORKGROUP); }
        asm volatile("s_waitcnt lgkmcnt(0)" ::: "memory");
        const u32x4 cv = *(const LAS u32x4*)(hist + 4 * lane);
        const unsigned tot = cv[0] + cv[1] + cv[2] + cv[3];
        unsigned S = tot;
#pragma unroll
        for (int off = 1; off < 64; off <<= 1) { const unsigned t = __shfl_down(S, off); if (lane + off < 64) S += t; }
        const unsigned above = S - tot; const bool isit = (above < 256u) && (S >= 256u);
        int bl = -1; unsigned Gl = 0, cum = above;
#pragma unroll
        for (int k = 3; k >= 0; --k) { if (bl < 0) { if (cum + cv[k] >= 256u) { bl = 4 * lane + k; Gl = cum; } else cum += cv[k]; } }
        const int src = __ffsll((unsigned long long)__ballot(isit)) - 1;
        const int bstar = __shfl(bl, src); const int rr = 256 - (int)__shfl(Gl, src);
        int n1 = 0;
#pragma unroll 4
        for (int i = 0; i < nreg; ++i) { int bin = (int)((ld_score(row, i, lane) - lo) * scale); bin = bin > 255 ? 255 : bin; n1 += __popcll(__ballot(bin == bstar)); }
        if (n1 <= 64) {
            int base = 0;
#pragma unroll 2
            for (int i = 0; i < nreg; ++i) { const float s = ld_score(row, i, lane); int bin = (int)((s - lo) * scale); bin = bin > 255 ? 255 : bin; const bool isc = (bin == bstar);
                const unsigned long long m = __ballot(isc); const int pos = base + __builtin_amdgcn_mbcnt_hi((unsigned)(m >> 32), __builtin_amdgcn_mbcnt_lo((unsigned)m, 0u));
                if (isc) cand[pos] = ((unsigned long long)fkey(s) << 32) | (unsigned long long)(0xFFFFu - (unsigned)(64 * i + lane));
                base += __popcll(m); }
            asm volatile("s_waitcnt lgkmcnt(0)" ::: "memory");
            const unsigned long long mine = lane < n1 ? cand[lane] : 0ull;
            const unsigned mh = (unsigned)(mine >> 32), ml = (unsigned)mine;
            int cnt = 0;
#pragma unroll 1
            for (int jx = 0; jx < n1; ++jx) { const unsigned oh = __builtin_amdgcn_readlane(mh, jx), ol = __builtin_amdgcn_readlane(ml, jx);
                cnt += (oh > mh || (oh == mh && ol > ml)) ? 1 : 0; }
            const int src2 = __ffsll((unsigned long long)__ballot(lane < n1 && cnt == rr - 1)) - 1;
            T = __shfl(mh, src2); istar = 0xFFFF - (int)(__shfl(ml, src2) & 0xFFFFu);
            asm volatile("s_waitcnt lgkmcnt(0)" ::: "memory");
        } else {
            unsigned Xh = 0u, Xl = 0u;
#pragma unroll 1
            for (int bit = 47; bit >= 0; --bit) {
                const unsigned Yh = bit >= 16 ? (Xh | (1u << (bit - 16))) : Xh, Yl = bit >= 16 ? Xl : (Xl | (1u << bit));
                int cnt = 0;
#pragma unroll 2
                for (int i = 0; i < nreg; ++i) { const float s = ld_score(row, i, lane); int bin = (int)((s - lo) * scale); bin = bin > 255 ? 255 : bin; const unsigned k = fkey(s), lw = 0xFFFFu - (unsigned)(64 * i + lane);
                    cnt += __popcll(__ballot(bin == bstar && (k > Yh || (k == Yh && lw >= Yl)))); }
                if (cnt >= rr) { Xh = Yh; Xl = Yl; }
            }
            T = Xh; istar = 0xFFFF - (int)Xl;
        }
    }
#pragma unroll 2
    for (int i = 0; i < nreg; ++i) { const unsigned k = fkey(ld_score(row, i, lane)); const int idx = 64 * i + lane;
        const unsigned long long m = __ballot(k > T || (k == T && idx <= istar));
        if (lane < 2) mrow[2 * i + lane] = lane ? (unsigned)(m >> 32) : (unsigned)m; }
}

__device__ __forceinline__ void attn_unit(const P& A, int b, int c, LAS unsigned char* lds, int tid) {
    const int lane = tid & 63, wv = __builtin_amdgcn_readfirstlane(tid >> 6), col = lane & 31, hi = lane >> 5;
    const int L = 64 * (c + 1), ntile = L / 32;
    const size_t tokb = (size_t)b * SEQ;
    LAS unsigned* maskw = (LAS unsigned*)(lds + L_MASK);
    LAS float* fb = (LAS float*)(lds + L_FBUF) + wv * 64;
    __syncthreads();
#ifndef NO_STEP1
    if (c < 4) {
        for (int e = tid; e < 64 * ntile; e += 512) { const int q = e / ntile, j = e % ntile; maskw[q * 65 + j] = 0xFFFFFFFFu; }
    } else {
        LAS float* sc = (LAS float*)lds;
        for (int rd = 0; rd < 8; ++rd) {
            const int qq = col >> 2, hI = col & 3; const size_t tq = tokb + 64 * c + 8 * rd + qq;
            h16x8 qf[4];
#pragma unroll
            for (int s = 0; s < 4; ++s) qf[s] = *(const h16x8*)(A.qidx + tq * 256 + hI * 64 + 16 * s + 8 * hi);
            const float wq = A.widx[tq * 4 + hI];
            for (int j = wv; j < ntile; j += 8) {
                const h16* kp = A.kidx + (tokb + 32 * j + col) * 64 + 8 * hi;
                f32x16 acc = {};
#pragma unroll
                for (int s = 0; s < 4; ++s) acc = __builtin_amdgcn_mfma_f32_32x32x16_f16(*(const h16x8*)(kp + 16 * s), qf[s], acc, 0, 0, 0);
                float v[16];
#pragma unroll
                for (int r = 0; r < 16; ++r) { float t = fmaxf(acc[r], 0.f) * wq; t += qperm_b1(t); t += qperm_4e(t); v[r] = t; }
                f32x4 o;
#pragma unroll
                for (int i = 0; i < 4; ++i) o[i] = hI == 0 ? v[i] : hI == 1 ? v[4 + i] : hI == 2 ? v[8 + i] : v[12 + i];
                *(LAS f32x4*)(sc + qq * SC_STRIDE + 32 * j + 8 * hI + 4 * hi) = o;
            }
            __syncthreads();
#ifndef NO_SELECT
            select_row(sc + wv * SC_STRIDE, L / 64, (LAS unsigned*)(lds + L_HIST) + wv * 256, (LAS unsigned long long*)(lds + L_CAND) + wv * 64, maskw + (8 * rd + wv) * 65, lane);
#endif
            __syncthreads();
        }
    }
#endif
#ifndef NO_STEP2
    {
        const int h = wv;
        LAS h16* Ks = (LAS h16*)(lds + L_KS); LAS h16* Vs = (LAS h16*)(lds + L_VS);
        const LAS float* rb = (const LAS float*)(lds + L_RELB) + h * 224;
        h16x8 qf[2][4];
#pragma unroll
        for (int ct = 0; ct < 2; ++ct)
#pragma unroll
            for (int s = 0; s < 4; ++s) qf[ct][s] = *(const h16x8*)(A.qa + (tokb + 64 * c + 32 * ct + col) * 512 + h * 64 + 16 * s + 8 * hi);
        f32x16 O[2][2]; float mrun[2], lsum[2];
#pragma unroll
        for (int ct = 0; ct < 2; ++ct) { O[ct][0] = (f32x16){}; O[ct][1] = (f32x16){}; mrun[ct] = -1e30f; lsum[ct] = 0.f; }
        const float b15 = rb[160 - 100];
        const bool isK = tid < 256; const int t2 = tid & 255, srow = t2 >> 3, spc = t2 & 7;
        const h16* gsrc = (isK ? A.ka : A.va) + (tokb + srow) * 64 + 8 * spc;
        LAS h16* kdst = Ks + srow * 72 + 8 * spc; LAS h16* vdst = Vs + (8 * spc) * 36 + srow;
#define ATT_STAGE(stage, v) do { if (isK) *(LAS u32x4*)(kdst + (stage) * (32 * 72)) = (v); else { const h16x8 hv_ = __builtin_bit_cast(h16x8, (v)); \
            _Pragma("unroll") for (int e_ = 0; e_ < 8; ++e_) vdst[(stage) * (64 * 36) + e_ * 36] = hv_[e_]; } } while (0)
        u32x4 stg = *(const u32x4*)gsrc;
        ATT_STAGE(0, stg);
        __syncthreads();
        for (int j = 0; j < ntile; ++j) {
            const int st = j & 1;
            if (j + 1 < ntile) stg = *(const u32x4*)(gsrc + (size_t)(j + 1) * (32 * 64));
            const LAS h16* kb = Ks + st * (32 * 72) + col * 72 + 8 * hi;
            h16x8 kf[4];
#pragma unroll
            for (int s = 0; s < 4; ++s) kf[s] = *(const LAS h16x8*)(kb + 16 * s);
            const bool far = j <= 2 * c - 4;
            const LAS h16* vb = Vs + st * (64 * 36) + col * 36 + 4 * hi;
#pragma unroll
            for (int ct = 0; ct < 2; ++ct) {
                f32x16 sa;
#pragma unroll
                for (int r = 0; r < 16; ++r) sa[r] = far ? b15 : 0.f;
#pragma unroll
                for (int s = 0; s < 4; ++s) sa = __builtin_amdgcn_mfma_f32_32x32x16_f16(kf[s], qf[ct][s], sa, 0, 0, 0);
                if (!far) { const int rel0 = 32 * j - (64 * c + 32 * ct + col) + 160 + 4 * hi;
#pragma unroll
                    for (int r = 0; r < 16; ++r) sa[r] += rb[rel0 + (r & 3) + 8 * (r >> 2)]; }
                const unsigned word = maskw[(32 * ct + col) * 65 + j] >> (4 * hi);
#pragma unroll
                for (int r = 0; r < 16; ++r) { const int neg = __builtin_amdgcn_sbfe((int)word, (r & 3) + 8 * (r >> 2), 1);
                    sa[r] = __int_as_float((neg & __float_as_int(sa[r])) | (~neg & (int)0xFF800000)); }
                h16x8 p0, p1;
                softmax_tile(sa, mrun[ct], lsum[ct], O[ct][0], O[ct][1], fb + 32 * ct, lane, hi, p0, p1);
#pragma unroll
                for (int db = 0; db < 2; ++db) {
                    const LAS h16* vp = vb + db * (32 * 36);
                    const h16x4 a0 = *(const LAS h16x4*)(vp), a1 = *(const LAS h16x4*)(vp + 8), c0 = *(const LAS h16x4*)(vp + 16), c1 = *(const LAS h16x4*)(vp + 24);
                    const h16x8 v0 = {a0[0], a0[1], a0[2], a0[3], a1[0], a1[1], a1[2], a1[3]}, v1 = {c0[0], c0[1], c0[2], c0[3], c1[0], c1[1], c1[2], c1[3]};
                    O[ct][db] = __builtin_amdgcn_mfma_f32_32x32x16_f16(p0, v0, O[ct][db], 0, 0, 0);
                    O[ct][db] = __builtin_amdgcn_mfma_f32_32x32x16_f16(p1, v1, O[ct][db], 0, 0, 0);
                }
            }
            if (j + 1 < ntile) ATT_STAGE(st ^ 1, stg);
            __syncthreads();
        }
#pragma unroll
        for (int ct = 0; ct < 2; ++ct) store_o(O[ct][0], O[ct][1], lsum[ct], fb + 32 * ct, lane, hi, A.out, tokb + 64 * c + 32 * ct, h * 64);
    }
#endif
#ifndef NO_STEP3
    {
        const int qg = wv >> 2, hm = wv & 3; const size_t tok0 = tokb + 64 * c + 32 * qg;
        h16x8 qf[4];
#pragma unroll
        for (int s = 0; s < 4; ++s) qf[s] = *(const h16x8*)(A.qm + (tok0 + col) * 256 + hm * 64 + 16 * s + 8 * hi);
        f32x16 O0 = {}, O1 = {}; float mrun = -1e30f, lsum = 0.f;
        for (int j = 0; j < MEMT / 32; ++j) {
            const h16* kp = A.mk + ((size_t)b * MEMT + 32 * j + col) * 256 + hm * 64 + 8 * hi;
            f32x16 sa = {};
#pragma unroll
            for (int s = 0; s < 4; ++s) sa = __builtin_amdgcn_mfma_f32_32x32x16_f16(*(const h16x8*)(kp + 16 * s), qf[s], sa, 0, 0, 0);
            h16x8 p0, p1;
            softmax_tile(sa, mrun, lsum, O0, O1, fb, lane, hi, p0, p1);
#pragma unroll
            for (int db = 0; db < 2; ++db) {
                const h16* vp = A.mvT + (((size_t)b * 4 + hm) * 64 + 32 * db + col) * MEMT + 32 * j + 4 * hi;
                const h16x4 a0 = *(const h16x4*)(vp), a1 = *(const h16x4*)(vp + 8), c0 = *(const h16x4*)(vp + 16), c1 = *(const h16x4*)(vp + 24);
                const h16x8 v0 = {a0[0], a0[1], a0[2], a0[3], a1[0], a1[1], a1[2], a1[3]}, v1 = {c0[0], c0[1], c0[2], c0[3], c1[0], c1[1], c1[2], c1[3]};
                if (db == 0) { O0 = __builtin_amdgcn_mfma_f32_32x32x16_f16(p0, v0, O0, 0, 0, 0); O0 = __builtin_amdgcn_mfma_f32_32x32x16_f16(p1, v1, O0, 0, 0, 0); }
                else { O1 = __builtin_amdgcn_mfma_f32_32x32x16_f16(p0, v0, O1, 0, 0, 0); O1 = __builtin_amdgcn_mfma_f32_32x32x16_f16(p1, v1, O1, 0, 0, 0); }
            }
        }
        store_o(O0, O1, lsum, fb, lane, hi, A.out, tok0, 512 + hm * 64);
    }
#endif
}

__device__ __forceinline__ void build_relb(const float* relb, LAS unsigned char* lds, int tid) {
    LAS float* rb = (LAS float*)(lds + L_RELB);
    for (int e = tid; e < 8 * 224; e += 512) { const int h = e / 224, rel = e % 224 - 160; rb[e] = relb[t5_bucket(rel) * 8 + h] * LOG2E; }
}
}
#ifndef MK_N_LAUNCHES
#define MK_N_LAUNCHES 1
#endif
constexpr int N_PHASES = 12;
constexpr int NWAVES = 8;
constexpr size_t MiB = 1u << 20;
constexpr size_t WS_CTL = 0, CTL_ZERO_BYTES = 1 * MiB;
constexpr size_t WS_W1A = 1 * MiB, WS_W1B = 12 * MiB, WS_WIN = 18 * MiB, WS_WMKV = 27 * MiB, WS_WGLU = 28 * MiB, WS_WOA = 29 * MiB, WS_WOM = 30 * MiB, WS_WOUT = 31 * MiB,
                 WS_W2A = 33 * MiB, WS_W2B = 44 * MiB, WS_TCAT = 50 * MiB, WS_WST = 90 * MiB;
constexpr size_t WS_RSTD0 = 98 * MiB, WS_SSQ1 = 99 * MiB, WS_SSQ2 = 103 * MiB, WS_SSQ3 = 107 * MiB, WS_MEMH = 111 * MiB, WS_MK = 127 * MiB, WS_MVT = 131 * MiB, WS_A64 = 135 * MiB;
constexpr size_t WS_ABUF = 136 * MiB;
constexpr size_t WS_CBUF = 264 * MiB;
constexpr size_t WS_YS = WS_CBUF + 96 * MiB;
constexpr size_t WS_BIG = 392 * MiB;
constexpr size_t WS_QA = WS_BIG, WS_QIDX = WS_BIG + 64 * MiB, WS_QM = WS_BIG + 96 * MiB, WS_OB = WS_BIG  ,
                 WS_KA = WS_BIG + 128 * MiB, WS_VAT = WS_BIG + 136 * MiB, WS_KIDX = WS_BIG + 144 * MiB, WS_WIDX = WS_BIG + 152 * MiB, WS_ACAT = WS_BIG + 153 * MiB, WS_GATES = WS_BIG + 193 * MiB;
constexpr size_t WS_END = WS_GATES + 384 * MiB;
static_assert(WS_END <= 1024 * MiB, "workspace map");
constexpr int CW_BAR = 4096;

constexpr int LDS_BYTES = 163840;
constexpr int MISC_OFF = LDS_BYTES - 256;

#define XB_TMO      128
#define XB_XCNT(j)  (256  + 64 * (j))
#define XB_XSUB(j)  (1280 + 64 * (j))
#define XB_XGEN(j)  (2304 + 64 * (j))
#define XB_TOP      3328
#define XB_TOPGEN   3392
#define XCD_BAR_WORDS 3456
#define XB_SPIN_CAP (1u << 18)
__device__ __forceinline__ unsigned xb_ld(unsigned* p)              { return __hip_atomic_load(p, __ATOMIC_RELAXED, __HIP_MEMORY_SCOPE_AGENT); }
__device__ __forceinline__ unsigned xb_add(unsigned* p, unsigned v) { return __hip_atomic_fetch_add(p, v, __ATOMIC_RELAXED, __HIP_MEMORY_SCOPE_AGENT); }
__device__ __forceinline__ unsigned xb_xcc_id() { return (unsigned)__builtin_amdgcn_s_getreg((3 << 11) | 20) & 0xFu; }
#define XB_SPIN(cond, bar) do { unsigned _sp = 0; while (cond) { __builtin_amdgcn_s_sleep(1); \
    if ((++_sp & 255u) == 0u) { if (xb_ld(&(bar)[XB_TMO])) break; if (_sp > XB_SPIN_CAP) { atomicAdd(&(bar)[XB_TMO], 1u); break; } } } } while (0)
struct XcdBarrier { unsigned* bar; unsigned x; volatile LAS unsigned* st; };
__device__ __forceinline__ XcdBarrier xcd_barrier_post(unsigned* bar, volatile LAS unsigned* st) {
    XcdBarrier b; b.bar = bar; b.x = xb_xcc_id(); b.st = st;
    if (threadIdx.x == 0) (void)xb_add(&bar[XB_XCNT(b.x)], 1u);
    return b;
}
__device__ __forceinline__ void xcd_barrier_complete(unsigned* bar, unsigned x, unsigned& nloc, unsigned& nx) {
    const unsigned G = gridDim.x * gridDim.y * gridDim.z;
    unsigned sum, cnt, mine, sp = 0u;
    for (;;) {
        sum = 0u; cnt = 0u; mine = 0u;
#pragma unroll
        for (unsigned j = 0; j < 16; ++j) { const unsigned c = xb_ld(&bar[XB_XCNT(j)]); sum += c; cnt += (c > 0u) ? 1u : 0u; mine = (j == x) ? c : mine; }
        if (sum == G) break;
        __builtin_amdgcn_s_sleep(1);
        if ((++sp & 255u) == 0u) { if (xb_ld(&bar[XB_TMO])) break; if (sp > XB_SPIN_CAP) { atomicAdd(&bar[XB_TMO], 1u); break; } }
    }
    nloc = mine > 0u ? mine : 1u; nx = cnt > 0u ? cnt : 1u;
}
__device__ __forceinline__ void xcd_barrier(const XcdBarrier& b) {
    asm volatile("s_waitcnt vmcnt(0)" ::: "memory");
    __syncthreads();
    if (threadIdx.x == 0) {
        unsigned* bar = b.bar;
        __builtin_amdgcn_s_waitcnt(0);
        unsigned nloc = b.st[0], nx = b.st[1];
        if (nloc == 0u) { xcd_barrier_complete(bar, b.x, nloc, nx); b.st[0] = nloc; b.st[1] = nx; }
        const unsigned old = xb_add(&bar[XB_XSUB(b.x)], 1u);
        const unsigned gen = old / nloc;
        if (old + 1u == (gen + 1u) * nloc) {
            __builtin_amdgcn_fence(__ATOMIC_RELEASE, "agent");
            asm volatile("s_waitcnt vmcnt(0)" ::: "memory");
            const unsigned og = xb_add(&bar[XB_TOP], 1u);
            const unsigned tg = og / nx;
            if (og + 1u == (tg + 1u) * nx) xb_add(&bar[XB_TOPGEN], 1u);
            else XB_SPIN(xb_ld(&bar[XB_TOPGEN]) == tg, bar);
            __builtin_amdgcn_fence(__ATOMIC_ACQUIRE, "agent");
            xb_add(&bar[XB_XGEN(b.x)], 1u);
            asm volatile("s_waitcnt vmcnt(0)" ::: "memory");
        } else {
            XB_SPIN(xb_ld(&bar[XB_XGEN(b.x)]) == gen, bar);
            __builtin_amdgcn_fence(__ATOMIC_ACQUIRE, "agent");
            asm volatile("s_waitcnt vmcnt(0)" ::: "memory");
        }
    }
    __syncthreads();
}

enum { I_X = 0, I_MEM, I_FFN1_NORM, I_FFN1_WIN, I_FFN1_WOUT, I_MIX_NORM, I_W_IN, I_AQG, I_AKG, I_RELB, I_WOA, I_LRE, I_LIM, I_LOGDT, I_BRE, I_BIM, I_CRE, I_CIM, I_SSMD, I_WGLU,
       I_MEM_NORM, I_WMKV, I_MQG, I_MKG, I_WOM, I_WOUT, I_FFN2_NORM, I_FFN2_WIN, I_FFN2_WOUT, I_FINAL_NORM, N_IN };
struct Args { const float* in[N_IN]; float* out; unsigned char* ws; int ph_lo, ph_hi; };
static_assert(sizeof(Args) == (N_IN + 2) * 8 + 8, "Args has no padding");

__global__ void __launch_bounds__(NWAVES * 64, 2) mega_fwd(Args args) {
    extern __shared__ __attribute__((aligned(16))) unsigned char lds_raw[];
    LAS unsigned char* lds = (LAS unsigned char*)lds_raw;
    volatile LAS unsigned* MISC = (volatile LAS unsigned*)(lds + MISC_OFF);
    const int tid = threadIdx.x, lane = tid & 63, wave = __builtin_amdgcn_readfirstlane(tid >> 6);
    const int G = gridDim.x; const int bx = blockIdx.x; const int vcu = (G % 8 == 0) ? (bx % 8) * (G / 8) + bx / 8 : bx;
    unsigned char* ws = args.ws;
    unsigned* ctl = (unsigned*)(ws + WS_CTL);
    for (int u = tid; u < 64; u += NWAVES * 64) MISC[u] = 0u;
    __syncthreads();
    const int lo = args.ph_lo, hi = args.ph_hi;
    XcdBarrier bar; bar.bar = ctl + CW_BAR; bar.x = 0; bar.st = nullptr;
    if (hi - lo > 1) bar = xcd_barrier_post(ctl + CW_BAR, MISC + 8);
#ifdef ONLY_PHASE
#define IN(k) ((k) == ONLY_PHASE && lo <= (k) && (k) < hi)
#else
#define IN(k) (lo <= (k) && (k) < hi)
#endif
#define SEAM(k) do { if (IN(k) && IN((k) + 1)) xcd_barrier(bar); } while (0)

    const float* x = args.in[I_X]; float* xres = args.out;
    h16* W1A = (h16*)(ws + WS_W1A); h16* W1B = (h16*)(ws + WS_W1B); h16* WIN = (h16*)(ws + WS_WIN); h16* WMKV = (h16*)(ws + WS_WMKV); h16* WGLU = (h16*)(ws + WS_WGLU);
    h16* WOA = (h16*)(ws + WS_WOA); h16* WOM = (h16*)(ws + WS_WOM); h16* WOUT = (h16*)(ws + WS_WOUT); h16* W2A = (h16*)(ws + WS_W2A); h16* W2B = (h16*)(ws + WS_W2B);
    h16* TCAT = (h16*)(ws + WS_TCAT); h16* WST = (h16*)(ws + WS_WST);
    float* rstd0 = (float*)(ws + WS_RSTD0); float* ssq1 = (float*)(ws + WS_SSQ1); float* ssq2 = (float*)(ws + WS_SSQ2); float* ssq3 = (float*)(ws + WS_SSQ3);
    h16* memh = (h16*)(ws + WS_MEMH); h16* mk = (h16*)(ws + WS_MK); h16* mvT = (h16*)(ws + WS_MVT); float* a64 = (float*)(ws + WS_A64);
    h16* abuf = (h16*)(ws + WS_ABUF); h16* acatt = (h16*)(ws + WS_CBUF); h16* ys = (h16*)(ws + WS_YS); h16* x2h = (h16*)(ws + WS_CBUF);
    h16* hidden = (h16*)(ws + WS_BIG); h16* qa = (h16*)(ws + WS_QA); h16* qidx = (h16*)(ws + WS_QIDX); h16* qm = (h16*)(ws + WS_QM); h16* ob = (h16*)(ws + WS_OB);
    h16* ka = (h16*)(ws + WS_KA); h16* va = (h16*)(ws + WS_VAT); h16* kidx = (h16*)(ws + WS_KIDX); float* widx = (float*)(ws + WS_WIDX); h16* acat = (h16*)(ws + WS_ACAT); h16* gates = (h16*)(ws + WS_GATES);

    if (IN(0)) {
        const int gw = vcu * NWAVES + wave, NGW = G * NWAVES;
        LAS float* scr = (LAS float*)(lds + wave * 16384);
        pro::WPtrs WP{args.in[I_FFN1_WIN], args.in[I_FFN1_WOUT], args.in[I_W_IN], args.in[I_WMKV], args.in[I_WGLU], args.in[I_WOA], args.in[I_WOM], args.in[I_WOUT], args.in[I_FFN2_WIN], args.in[I_FFN2_WOUT],
                      args.in[I_FFN1_NORM], args.in[I_MIX_NORM], args.in[I_FFN2_NORM], W1A, W1B, WIN, WMKV, WGLU, WOA, WOM, WOUT, W2A, W2B};
        for (int it = gw; it < pro::IT_TOTAL; it += NGW) pro::weight_item(WP, it, scr, lane);
        for (int m = gw; m < MTOK; m += NGW) { const float r = pro::row_to_h16(x + (size_t)m * DM, abuf + (size_t)m * DM, nullptr, lane); if (lane == 0) rstd0[m] = r; }
        for (int m = gw; m < BATCH * MEMT; m += NGW) (void)pro::row_to_h16(args.in[I_MEM] + (size_t)m * DM, memh + (size_t)m * DM, args.in[I_MEM_NORM], lane);
        pro::S5In SI{args.in[I_LRE], args.in[I_LIM], args.in[I_LOGDT], args.in[I_BRE], args.in[I_BIM], args.in[I_CRE], args.in[I_CIM], args.in[I_SSMD]};
        for (int it = vcu; it < 16 * 64; it += G) pro::s5_item(SI, it >> 6, it & 63, TCAT, WST, a64, (LAS float*)lds, tid);
        __syncthreads();
    }
    SEAM(0);
    if (IN(1)) {
        pg8::Gemm g{abuf, W1A, 1024, 1024, 1024}; pg8::StaticOrder S; S.init(MTOK, 2 * FFN, G, bx);
        epi::EpiSwiglu<0> E{hidden, rstd0};
        pg8::gemm_phase<epi::EpiSwiglu<0>, pg8::StaticOrder, true, true>(lds, g, S, E);
    }
    SEAM(1);
    if (IN(2)) {
        { pg8::Gemm g{hidden, W1B, FFN, FFN, FFN}; pg8::StaticOrder S; S.init(MTOK, DM, G, bx);
          epi::EpiResid E{x, xres, abuf, ssq1, 0.5f};
          pg8::gemm_phase<epi::EpiResid, pg8::StaticOrder, true, true>(lds, g, S, E); }
        { pg8::Gemm g{memh, WMKV, 1024, 1024, 1024}; pg8::StaticOrder S; S.init(BATCH * MEMT, 512, G, bx);
          epi::EpiMemKV E{args.in[I_MKG], mk, mvT};
          pg8::gemm_phase<epi::EpiMemKV, pg8::StaticOrder, true, true>(lds, g, S, E); }
    }
    SEAM(2);
    if (IN(3)) {
        pg8::Gemm g{abuf, WIN, 1024, 1024, 1024}; pg8::StaticOrder S; S.init(MTOK, NWIN, G, bx);
        epi::EpiWin E{ssq1, args.in[I_AQG], args.in[I_AKG], args.in[I_MQG], qa, ka, va, qidx, kidx, acat, qm, gates, widx};
        pg8::gemm_phase<epi::EpiWin, pg8::StaticOrder, true, true>(lds, g, S, E);
    }
    SEAM(3);
    if (IN(4)) {
        { pg8::Gemm g{acat, WST, 1024, 1280, 1024}; pg8::DiagOrder S; S.init(16, 4, 1, G, bx);
          epi::EpiS5State E{args.in[I_LOGDT], a64, acat};
          pg8::gemm_phase<epi::EpiS5State, pg8::DiagOrder, false, true>(lds, g, S, E); }
        __syncthreads();
        att::build_relb(args.in[I_RELB], lds, tid);
        att::P AP{qa, ka, va, qidx, kidx, qm, mk, mvT, widx, args.in[I_RELB], acatt};
        if (G == 256) {
            const int b = vcu >> 3, s = vcu & 7;
            for (int i = 0; i < 4; ++i) { const int c = i == 0 ? s : i == 1 ? 31 - s : i == 2 ? 8 + s : 23 - s; att::attn_unit(AP, b, c, lds, tid); }
        } else {
            for (int u = vcu; u < BATCH * 32; u += G) att::attn_unit(AP, u >> 5, u & 31, lds, tid);
        }
        __syncthreads();
    }
    SEAM(4);
    if (IN(5)) {
        pg8::Gemm g{acat, TCAT, 1280, 1280, 1280}; pg8::DiagOrder S; S.init(16, 4, 4, G, bx);
        epi::EpiS5Main E{args.in[I_LOGDT], ys};
        pg8::gemm_phase<epi::EpiS5Main, pg8::DiagOrder, true, true>(lds, g, S, E);
    }
    SEAM(5);
    if (IN(6)) {
        pg8::Gemm g{ys, WGLU, 256, 256, 256}; pg8::StaticOrder S; S.init(MTOK, 2048, G, bx);
        epi::EpiGlu E{ob};
        pg8::gemm_phase<epi::EpiGlu, pg8::StaticOrder, true, true>(lds, g, S, E);
    }
    SEAM(6);
    if (IN(7)) {
        { pg8::Gemm g{acatt, WOA, 512, 768, 512}; pg8::StaticOrder S; S.init(MTOK, DM, G, bx);
          epi::EpiMerge<0> E{gates, ob, abuf};
          pg8::gemm_phase<epi::EpiMerge<0>, pg8::StaticOrder, true, true>(lds, g, S, E); }
        { pg8::Gemm g{acatt + 512, WOM, 256, 768, 256}; pg8::StaticOrder S; S.init(MTOK, DM, G, bx);
          epi::EpiMerge<1> E{gates, ob, abuf};
          pg8::gemm_phase<epi::EpiMerge<1>, pg8::StaticOrder, true, true>(lds, g, S, E); }
    }
    SEAM(7);
    if (IN(8)) {
        pg8::Gemm g{abuf, WOUT, 1024, 1024, 1024}; pg8::StaticOrder S; S.init(MTOK, DM, G, bx);
        epi::EpiResid E{xres, xres, x2h, ssq2, 1.0f};
        pg8::gemm_phase<epi::EpiResid, pg8::StaticOrder, true, true>(lds, g, S, E);
    }
    SEAM(8);
    if (IN(9)) {
        pg8::Gemm g{x2h, W2A, 1024, 1024, 1024}; pg8::StaticOrder S; S.init(MTOK, 2 * FFN, G, bx);
        epi::EpiSwiglu<1> E{hidden, ssq2};
        pg8::gemm_phase<epi::EpiSwiglu<1>, pg8::StaticOrder, true, true>(lds, g, S, E);
    }
    SEAM(9);
    if (IN(10)) {
        pg8::Gemm g{hidden, W2B, FFN, FFN, FFN}; pg8::StaticOrder S; S.init(MTOK, DM, G, bx);
        epi::EpiResid E{xres, xres, nullptr, ssq3, 0.5f};
        pg8::gemm_phase<epi::EpiResid, pg8::StaticOrder, true, true>(lds, g, S, E);
    }
    SEAM(10);
    if (IN(11)) {
        const int gw = vcu * NWAVES + wave, NGW = G * NWAVES; const float* fg = args.in[I_FINAL_NORM];
        for (int m = gw; m < MTOK; m += NGW) {
            const float rs = epi::rstd_from_ssq(ssq3, m);
            f32x4* p = (f32x4*)(xres + (size_t)m * DM) + lane;
#pragma unroll
            for (int j = 0; j < 4; ++j) { const f32x4 gv = ((const f32x4*)fg)[lane + 64 * j]; p[64 * j] = p[64 * j] * rs * gv; }
        }
    }
#undef IN
#undef SEAM
}

#ifndef DBG_TOL
#define DBG_TOL 0.03f
#endif
extern "C" void kernel_launch(void* const* d_in, const int* in_sizes, int n_in, void* d_out, int out_size, void* d_ws, size_t ws_size, hipStream_t stream) {
    static int grid = 0;
    if (grid == 0) {
        if (n_in != N_IN || in_sizes[0] != MTOK * DM || out_size != MTOK * DM || ws_size < WS_END) { fprintf(stderr, "kernel_launch: unexpected shapes (n_in %d, ws %zu)\n", n_in, ws_size); grid = -1; return; }
        int dev = 0, cus = 0, per_cu = 0;
        if (hipGetDevice(&dev) != hipSuccess || hipDeviceGetAttribute(&cus, hipDeviceAttributeMultiprocessorCount, dev) != hipSuccess) { grid = -1; return; }
        if (hipFuncSetAttribute((const void*)mega_fwd, hipFuncAttributeMaxDynamicSharedMemorySize, LDS_BYTES) != hipSuccess) { fprintf(stderr, "kernel_launch: hipFuncSetAttribute failed\n"); grid = -1; return; }
        if (hipOccupancyMaxActiveBlocksPerMultiprocessor(&per_cu, (const void*)mega_fwd, NWAVES * 64, LDS_BYTES) != hipSuccess || per_cu < 1) fprintf(stderr, "kernel_launch: occupancy query reports %d\n", per_cu);
        (void)hipGetLastError();
        grid = cus;
    }
    if (grid < 0) return;
    (void)hipMemsetAsync((char*)d_ws + WS_CTL, 0, CTL_ZERO_BYTES, stream);
    Args a{};
    for (int i = 0; i < N_IN; ++i) a.in[i] = (const float*)d_in[i];
    a.out = (float*)d_out; a.ws = (unsigned char*)d_ws;
#if MK_N_LAUNCHES == 1
    a.ph_lo = 0; a.ph_hi = N_PHASES;
    hipLaunchKernelGGL(mega_fwd, dim3(grid), dim3(NWAVES * 64), LDS_BYTES, stream, a);
#else
    for (int p = 0; p < N_PHASES; ++p) { a.ph_lo = p; a.ph_hi = p + 1; hipLaunchKernelGGL(mega_fwd, dim3(grid), dim3(NWAVES * 64), LDS_BYTES, stream, a);
#ifdef DBG_CHECK
        unsigned char* ws = (unsigned char*)d_ws; unsigned* ctl = (unsigned*)ws; const float* const* in = a.in; float* out = (float*)d_out;
        dbg::ProjBufs PB{(h16*)(ws + WS_QA), (h16*)(ws + WS_KA), (h16*)(ws + WS_VAT), (h16*)(ws + WS_QIDX), (h16*)(ws + WS_KIDX), (h16*)(ws + WS_ACAT), (h16*)(ws + WS_QM), (h16*)(ws + WS_GATES), (float*)(ws + WS_WIDX)};
        if (p == 2) { hipLaunchKernelGGL(dbg::chk_ffn, dim3(8), dim3(256), 0, stream, in[I_X], in[I_FFN1_NORM], in[I_FFN1_WIN], in[I_FFN1_WOUT], (const float*)out, ctl, 1);
                      hipLaunchKernelGGL(dbg::chk_memkv, dim3(4), dim3(256), 0, stream, in[I_MEM], in[I_MEM_NORM], in[I_WMKV], in[I_MKG], (const h16*)(ws + WS_MK), (const h16*)(ws + WS_MVT), ctl); }
        if (p == 3) hipLaunchKernelGGL(dbg::chk_proj, dim3(4), dim3(256), 0, stream, (const float*)out, in[I_MIX_NORM], in[I_W_IN], in[I_AQG], in[I_AKG], in[I_MQG], PB, ctl);
        if (p == 4) { hipLaunchKernelGGL(dbg::chk_attn, dim3(8), dim3(256), 0, stream, PB, in[I_RELB], (const h16*)(ws + WS_CBUF), ctl);
                      hipLaunchKernelGGL(dbg::chk_mem, dim3(8), dim3(256), 0, stream, (const h16*)(ws + WS_QM), (const h16*)(ws + WS_MK), (const h16*)(ws + WS_MVT), (const h16*)(ws + WS_CBUF), ctl); }
        if (p == 5) hipLaunchKernelGGL(dbg::chk_s5, dim3(8), dim3(64), 0, stream, (const h16*)(ws + WS_ACAT), in[I_LRE], in[I_LIM], in[I_LOGDT], in[I_BRE], in[I_BIM], in[I_CRE], in[I_CIM], in[I_SSMD], (const h16*)(ws + WS_YS), ctl);
        if (p == 6) hipLaunchKernelGGL(dbg::chk_glu, dim3(4), dim3(256), 0, stream, (const h16*)(ws + WS_YS), in[I_WGLU], (const h16*)(ws + WS_OB), ctl);
        if (p == 7) hipLaunchKernelGGL(dbg::chk_merge, dim3(8), dim3(256), 0, stream, (const h16*)(ws + WS_CBUF), (const h16*)(ws + WS_OB), (const h16*)(ws + WS_GATES), in[I_WOA], in[I_WOM], (const h16*)(ws + WS_ABUF), (const float*)out, in[I_WOUT], ctl);
        if (p == 8) hipLaunchKernelGGL(dbg::chk_x2, dim3(8), dim3(256), 0, stream, (const float*)out, ctl);
        if (p == N_PHASES - 1) hipLaunchKernelGGL(dbg::chk_report, dim3(1024), dim3(256), 0, stream, out, ctl, DBG_TOL);
#endif
    }
#endif
}
```

```cpp
#define MK_N_LAUNCHES 1
#include <hip/hip_runtime.h>
#include <cstdio>
#include <cstdint>

#define GAS __attribute__((address_space(1)))
#define LAS __attribute__((address_space(3)))
typedef _Float16 h16;
typedef _Float16 h16x8 __attribute__((ext_vector_type(8)));
typedef _Float16 h16x4 __attribute__((ext_vector_type(4)));
typedef _Float16 h16x2 __attribute__((ext_vector_type(2)));
typedef float f32x2 __attribute__((ext_vector_type(2)));
typedef float f32x4 __attribute__((ext_vector_type(4)));
typedef float f32x16 __attribute__((ext_vector_type(16)));
typedef unsigned u32x4 __attribute__((ext_vector_type(4)));
typedef unsigned u32x2 __attribute__((ext_vector_type(2)));

constexpr int BATCH = 32, SEQ = 2048, DM = 1024, MTOK = BATCH * SEQ, FFN = 2816;
constexpr int NWIN = 4608;
constexpr int MEMT = 256;
constexpr float NORM_EPS = 1e-6f;
constexpr float LOG2E = 1.4426950408889634f;

__device__ __forceinline__ unsigned pk2h(float lo, float hi) { f32x2 v = {lo, hi}; h16x2 p = __builtin_convertvector(v, h16x2); return __builtin_bit_cast(unsigned, p); }
__device__ __forceinline__ u32x4 pk8h(f32x4 a, f32x4 b) { u32x4 w; w.x = pk2h(a[0], a[1]); w.y = pk2h(a[2], a[3]); w.z = pk2h(b[0], b[1]); w.w = pk2h(b[2], b[3]); return w; }
__device__ __forceinline__ void unpk8h(u32x4 w, f32x4& a, f32x4& b) {
    h16x8 h = __builtin_bit_cast(h16x8, w);
    a = (f32x4){(float)h[0], (float)h[1], (float)h[2], (float)h[3]}; b = (f32x4){(float)h[4], (float)h[5], (float)h[6], (float)h[7]};
}
__device__ __forceinline__ float fast_sigmoid(float x) { return __builtin_amdgcn_rcpf(1.0f + __builtin_amdgcn_exp2f(-x * LOG2E)); }

namespace pg8 {
constexpr int BM = 256, BK = 64, HALF = 128, HTB = HALF * BK * 2  , STAGE_BYTES = 8 * HTB, NXCD = 8, WGM = 8;

__host__ __device__ __forceinline__ int lds_byte(int r, int c) { const int st = (r >> 4) * 2 + (c >> 5), rr = r & 15, cc = c & 31, ob = rr * 64 + cc * 2; return st * 1024 + (ob ^ (((ob >> 9) & 1) << 5)); }
__host__ __device__ __forceinline__ void stage_rc(int b, int& R, int& C) { const int st = b / 1024, sb = b % 1024, swz = sb ^ (((sb >> 9) & 1) << 5); R = (st >> 1) * 16 + swz / 64; C = (st & 1) * 32 + (swz % 64) / 2; }

struct Unit { int pm, pn; };
struct Gemm { const h16* A; const h16* Bt; int K, lda, ldb; };

struct StaticOrder {
    int nM, nN, nwg, G, c;
    __host__ __device__ void init(int M, int N, int G_, int c_) { nM = M / BM; nN = N / BM; nwg = nM * nN; G = G_; c = c_; }
    __host__ __device__ bool next(int i, Unit& u) const {
        const long L = (long)i * G + c; if (L >= nwg) return false;
        int wgid = (int)L; { const int q = nwg / NXCD, r = nwg % NXCD, xcd = wgid % NXCD, off = wgid / NXCD; wgid = (xcd < r ? xcd * (q + 1) : r * (q + 1) + (xcd - r) * q) + off; }
        const int nig = WGM * nN, gid = wgid / nig, fm = gid * WGM, gsz = (nM - fm) < WGM ? (nM - fm) : WGM;
        u.pm = fm + ((wgid % nig) % gsz); u.pn = (wgid % nig) / gsz; return true;
    }
};
struct DiagOrder {
    int tm, tn, ng, G, c;
    __host__ __device__ void init(int ng_, int tm_, int tn_, int G_, int c_) { ng = ng_; tm = tm_; tn = tn_; G = G_; c = c_; }
    __host__ __device__ bool next(int i, Unit& u) const {
        const long L = (long)i * G + c; if (L >= (long)ng * tm * tn) return false;
        const int per = tm * tn, g = (int)L / per, r = (int)L % per;
        u.pm = g * tm + r / tn; u.pn = g * tn + r % tn; return true;
    }
};

template <class Epi, class Sched, bool ALIGN_EPI = false, bool SP2 = false>
__device__ __forceinline__ void gemm_phase(LAS unsigned char* lds, const Gemm g, const Sched& S, const Epi& E) {
    const int tid = threadIdx.x, wid = __builtin_amdgcn_readfirstlane(tid >> 6), lane = tid & 63, wr = wid >> 2, wc = wid & 3, fr = lane & 15, fq = lane >> 4;
    const int K = g.K, nt = K / BK;
    unsigned voffA[2], voffB[2];
#pragma unroll
    for (int i = 0; i < 2; ++i) { int R, C; stage_rc(tid * 16 + i * 8192, R, C);
        voffA[i] = (unsigned)(R * g.lda + C) * 2u; voffB[i] = (unsigned)(R * g.ldb + C) * 2u; }
    const size_t kstep = (size_t)(BK * 2);
    const size_t hstepA = (size_t)HALF * g.lda * 2, hstepB = (size_t)HALF * g.ldb * 2;
    const size_t tstepA = 2 * hstepA, tstepB = 2 * hstepB;
    const unsigned ldsw = (unsigned)wid * 1024u;
    const int aoff = lds_byte(wr * 64 + fr, fq * 8), boff = lds_byte(wc * 32 + fr, fq * 8);
#define PG8_SA(b, h) (((b) * 2 + (h)) * HTB)
#define PG8_SB(b, h) ((4 + (b) * 2 + (h)) * HTB)
#define PG8_STAGE(bufoff, gbase, voff) do { _Pragma("unroll") for (int _i = 0; _i < 2; ++_i) \
        __builtin_amdgcn_global_load_lds((const unsigned*)((const char*)(gbase) + (voff)[_i]), (LAS unsigned*)(lds + (bufoff) + ldsw + _i * 8192), 16, 0, 0); } while (0)
#define PG8_LDA(dst, b, h) do { _Pragma("unroll") for (int m = 0; m < 4; ++m) _Pragma("unroll") for (int k = 0; k < 2; ++k) dst[m][k] = *(const LAS h16x8*)(lds + PG8_SA(b, h) + aoff + m * 2048 + k * 1024); } while (0)
#define PG8_LDB(dst, b, h) do { _Pragma("unroll") for (int n = 0; n < 2; ++n) _Pragma("unroll") for (int k = 0; k < 2; ++k) dst[n][k] = *(const LAS h16x8*)(lds + PG8_SB(b, h) + boff + n * 2048 + k * 1024); } while (0)
#define PG8_MMA(ai, bj, At, Bt) do { __builtin_amdgcn_s_setprio(1); _Pragma("unroll") for (int m = 0; m < 4; ++m) _Pragma("unroll") for (int n = 0; n < 2; ++n) _Pragma("unroll") for (int k = 0; k < 2; ++k) \
        acc[ai][bj][m][n] = __builtin_amdgcn_mfma_f32_16x16x32_f16(Bt[n][k], At[m][k], acc[ai][bj][m][n], 0, 0, 0); __builtin_amdgcn_s_setprio(0); } while (0)
#define PG8_WAIT_V(n) asm volatile("s_waitcnt vmcnt(" #n ")" ::: "memory")
#define PG8_WAIT_L(n) asm volatile("s_waitcnt lgkmcnt(" #n ")" ::: "memory")
#define PG8_BAR __builtin_amdgcn_s_barrier()
#define PG8_SCHED __builtin_amdgcn_sched_barrier(0)
    Unit cur, nxt; int ui = 0;
    if (!S.next(0, cur)) return;
    f32x4 acc[2][2][4][2];
#pragma unroll
    for (int a = 0; a < 2; ++a)
#pragma unroll
        for (int b = 0; b < 2; ++b)
#pragma unroll
            for (int m = 0; m < 4; ++m)
#pragma unroll
                for (int n = 0; n < 2; ++n) acc[a][b][m][n] = (f32x4){0.f, 0.f, 0.f, 0.f};
    h16x8 At[4][2], B0[2][2], B1[2][2];
    const char* cA = (const char*)g.A + (size_t)cur.pm * tstepA; const char* cB = (const char*)g.Bt + (size_t)cur.pn * tstepB;
    if constexpr (SP2) {
        PG8_STAGE(PG8_SB(0, 0), cB, voffB); PG8_STAGE(PG8_SB(0, 1), cB + hstepB, voffB); PG8_STAGE(PG8_SA(0, 0), cA, voffA); PG8_STAGE(PG8_SA(0, 1), cA + hstepA, voffA);
        if (wr == 1) PG8_BAR;
        PG8_WAIT_V(2); PG8_BAR;
        PG8_STAGE(PG8_SB(1, 0), cB + kstep, voffB); PG8_STAGE(PG8_SA(1, 0), cA + kstep, voffA); PG8_STAGE(PG8_SB(1, 1), cB + hstepB + kstep, voffB);
        PG8_WAIT_V(6); PG8_BAR;
    } else {
        PG8_STAGE(PG8_SB(0, 0), cB, voffB); PG8_STAGE(PG8_SA(0, 0), cA, voffA); PG8_STAGE(PG8_SB(0, 1), cB + hstepB, voffB); PG8_STAGE(PG8_SA(0, 1), cA + hstepA, voffA);
        if (wr == 1) PG8_BAR;
        PG8_WAIT_V(4); PG8_BAR;
        PG8_STAGE(PG8_SB(1, 0), cB + kstep, voffB); PG8_STAGE(PG8_SA(1, 0), cA + kstep, voffA); PG8_STAGE(PG8_SB(1, 1), cB + hstepB + kstep, voffB);
        PG8_WAIT_V(6); PG8_BAR;
    }
    for (;;) {
        const bool has_next = S.next(ui + 1, nxt);
        const char* nA = has_next ? (const char*)g.A + (size_t)nxt.pm * tstepA : cA; const char* nB = has_next ? (const char*)g.Bt + (size_t)nxt.pn * tstepB : cB;
        for (int t = 0; t < nt; t += 2) {
            const bool last = (t == nt - 2);
            const char* a1 = cA + (size_t)(t + 1) * kstep;
            const char* a2 = last ? nA : cA + (size_t)(t + 2) * kstep; const char* b2 = last ? nB : cB + (size_t)(t + 2) * kstep;
            const char* a3 = a2 + kstep; const char* b3 = b2 + kstep;
            if constexpr (SP2) {
            PG8_LDB(B0, 0, 0); PG8_LDB(B1, 0, 1); PG8_SCHED; PG8_LDA(At, 0, 0); PG8_STAGE(PG8_SA(1, 1), a1 + hstepA, voffA);
            PG8_WAIT_V(8); PG8_WAIT_L(0); PG8_BAR; PG8_MMA(0, 0, At, B0); PG8_MMA(0, 1, At, B1); PG8_BAR; PG8_SCHED;
            PG8_LDA(At, 0, 1); PG8_STAGE(PG8_SB(0, 0), b2, voffB); PG8_STAGE(PG8_SB(0, 1), b2 + hstepB, voffB); PG8_STAGE(PG8_SA(0, 0), a2, voffA);
            PG8_WAIT_V(8); PG8_WAIT_L(0); PG8_BAR; PG8_MMA(1, 0, At, B0); PG8_MMA(1, 1, At, B1); PG8_BAR; PG8_SCHED;
            PG8_LDB(B0, 1, 0); PG8_LDB(B1, 1, 1); PG8_SCHED; PG8_LDA(At, 1, 0); PG8_STAGE(PG8_SA(0, 1), a2 + hstepA, voffA);
            PG8_WAIT_V(8); PG8_WAIT_L(0); PG8_BAR; PG8_MMA(0, 0, At, B0); PG8_MMA(0, 1, At, B1); PG8_BAR; PG8_SCHED;
            PG8_LDA(At, 1, 1); PG8_STAGE(PG8_SB(1, 0), b3, voffB); PG8_STAGE(PG8_SB(1, 1), b3 + hstepB, voffB); PG8_STAGE(PG8_SA(1, 0), a3, voffA);
            PG8_WAIT_V(8); PG8_WAIT_L(0); PG8_BAR; PG8_MMA(1, 0, At, B0); PG8_MMA(1, 1, At, B1); PG8_BAR; PG8_SCHED;
            } else {
            PG8_LDB(B0, 0, 0); PG8_SCHED; PG8_LDA(At, 0, 0); PG8_STAGE(PG8_SA(1, 1), a1 + hstepA, voffA);
            PG8_WAIT_L(8); PG8_BAR; PG8_WAIT_L(0); PG8_MMA(0, 0, At, B0); PG8_BAR; PG8_SCHED;
            PG8_LDB(B1, 0, 1); PG8_STAGE(PG8_SB(0, 0), b2, voffB);
            PG8_BAR; PG8_WAIT_L(0); PG8_MMA(0, 1, At, B1); PG8_BAR;
            PG8_LDA(At, 0, 1); PG8_STAGE(PG8_SA(0, 0), a2, voffA);
            PG8_BAR; PG8_WAIT_L(0); PG8_MMA(1, 0, At, B0); PG8_BAR; PG8_SCHED;
            PG8_STAGE(PG8_SB(0, 1), b2 + hstepB, voffB);
            PG8_WAIT_V(6); PG8_BAR; PG8_MMA(1, 1, At, B1); PG8_BAR;
            PG8_LDB(B0, 1, 0); PG8_SCHED; PG8_LDA(At, 1, 0); PG8_STAGE(PG8_SA(0, 1), a2 + hstepA, voffA);
            PG8_WAIT_L(8); PG8_BAR; PG8_WAIT_L(0); PG8_MMA(0, 0, At, B0); PG8_BAR; PG8_SCHED;
            PG8_LDB(B1, 1, 1); PG8_STAGE(PG8_SB(1, 0), b3, voffB);
            PG8_BAR; PG8_WAIT_L(0); PG8_MMA(0, 1, At, B1); PG8_BAR;
            PG8_LDA(At, 1, 1); PG8_STAGE(PG8_SA(1, 0), a3, voffA);
            PG8_BAR; PG8_WAIT_L(0); PG8_MMA(1, 0, At, B0); PG8_BAR; PG8_SCHED;
            PG8_STAGE(PG8_SB(1, 1), b3 + hstepB, voffB);
            PG8_WAIT_V(6); PG8_BAR; PG8_MMA(1, 1, At, B1); PG8_BAR;
            }
        }
        if constexpr (ALIGN_EPI) { if (wr == 0) PG8_BAR; }
        if constexpr (!Epi::AFTER_DRAIN) { E(acc, cur, wr, wc, fr, fq); }
        if (!has_next) break;
#pragma unroll
        for (int a = 0; a < 2; ++a)
#pragma unroll
            for (int b = 0; b < 2; ++b)
#pragma unroll
                for (int m = 0; m < 4; ++m)
#pragma unroll
                    for (int n = 0; n < 2; ++n) acc[a][b][m][n] = (f32x4){0.f, 0.f, 0.f, 0.f};
        cur = nxt; cA = nA; cB = nB; ++ui;
        if constexpr (ALIGN_EPI) { if (wr == 1) PG8_BAR; }
    }
    PG8_WAIT_V(0);
    if constexpr (!ALIGN_EPI) { if (wr == 0) PG8_BAR; }
    PG8_BAR;
    if constexpr (Epi::AFTER_DRAIN) { E.fused(acc, cur, wr, wc, fr, fq, lds); }
#undef PG8_SA
#undef PG8_SB
#undef PG8_STAGE
#undef PG8_LDA
#undef PG8_LDB
#undef PG8_MMA
#undef PG8_WAIT_V
#undef PG8_WAIT_L
#undef PG8_BAR
#undef PG8_SCHED
}
}
namespace epi {
using pg8::Unit;
typedef f32x4 Acc[2][2][4][2];

__device__ __forceinline__ float quad16(float s) { s += __shfl_xor(s, 16); s += __shfl_xor(s, 32); return s; }

__device__ __forceinline__ float rstd_from_ssq(const float* ssq, int r) {
    const f32x4* p = (const f32x4*)(ssq + (size_t)r * 16); const f32x4 a = p[0], b = p[1], c = p[2], d = p[3];
    const float s = ((a[0] + a[1]) + (a[2] + a[3])) + ((b[0] + b[1]) + (b[2] + b[3])) + ((c[0] + c[1]) + (c[2] + c[3])) + ((d[0] + d[1]) + (d[2] + d[3]));
    return 1.0f / sqrtf(s * (1.0f / DM) + NORM_EPS);
}
__device__ __forceinline__ float rstd_from_ssq_q(const float* ssq, int r, int fq) {
    const f32x4 a = ((const f32x4*)(ssq + (size_t)r * 16))[fq];
    const float s = quad16((a[0] + a[1]) + (a[2] + a[3]));
    return 1.0f / sqrtf(s * (1.0f / DM) + NORM_EPS);
}
template <int SRC  > struct EpiSwiglu {
    static constexpr bool AFTER_DRAIN = false;
    h16* H; const float* rsrc;
    __device__ __forceinline__ void operator()(const Acc& acc, const Unit& u, int wr, int wc, int fr, int fq) const {
        const int row0 = u.pm * 256 + wr * 64 + fr, col = u.pn * 128 + wc * 32 + fq * 8;
#pragma unroll
        for (int ai = 0; ai < 2; ++ai)
#pragma unroll
            for (int m = 0; m < 4; ++m) {
                const int r = row0 + ai * 128 + m * 16; const float rs = SRC == 0 ? rsrc[r] : rstd_from_ssq_q(rsrc, r, fq);
                f32x4 o[2];
#pragma unroll
                for (int n = 0; n < 2; ++n)
#pragma unroll
                    for (int j = 0; j < 4; ++j) { const float g = acc[ai][0][m][n][j] * rs, up = acc[ai][1][m][n][j] * rs; o[n][j] = g * fast_sigmoid(g) * up; }
                *(u32x4*)(H + (size_t)r * FFN + col) = pk8h(o[0], o[1]);
            }
    }
};

struct EpiResid {
    static constexpr bool AFTER_DRAIN = false;
    const float* base; float* out; h16* outh; float* ssq; float alpha;
    __device__ __forceinline__ void operator()(const Acc& acc, const Unit& u, int wr, int wc, int fr, int fq) const {
        const int row0 = u.pm * 256 + wr * 64 + fr, col0 = u.pn * 256 + wc * 32 + fq * 8;
#pragma unroll
        for (int ai = 0; ai < 2; ++ai)
#pragma unroll
            for (int m = 0; m < 4; ++m) {
                const int r = row0 + ai * 128 + m * 16; float sq = 0.f;
#pragma unroll
                for (int bj = 0; bj < 2; ++bj) {
                    const size_t off = (size_t)r * DM + col0 + bj * 128;
                    const f32x4 b0 = *(const f32x4*)(base + off), b1 = *(const f32x4*)(base + off + 4);
                    const f32x4 v0 = b0 + alpha * acc[ai][bj][m][0], v1 = b1 + alpha * acc[ai][bj][m][1];
                    *(f32x4*)(out + off) = v0; *(f32x4*)(out + off + 4) = v1;
                    if (outh) *(u32x4*)(outh + off) = pk8h(v0, v1);
                    sq += (v0[0] * v0[0] + v0[1] * v0[1]) + (v0[2] * v0[2] + v0[3] * v0[3]) + (v1[0] * v1[0] + v1[1] * v1[1]) + (v1[2] * v1[2] + v1[3] * v1[3]);
                }
                sq = quad16(sq);
                if (fq == 0) ssq[(size_t)r * 16 + u.pn * 4 + wc] = sq;
            }
    }
};

__device__ __forceinline__ void head_norm_store(const Acc& acc, int ai, int m, float rs, const float* gain, float oscale, h16* dst  , int fq) {
    float sq = 0.f;
#pragma unroll
    for (int bj = 0; bj < 2; ++bj)
#pragma unroll
        for (int n = 0; n < 2; ++n)
#pragma unroll
            for (int j = 0; j < 4; ++j) { const float v = acc[ai][bj][m][n][j] * rs; sq += v * v; }
    sq = quad16(sq);
    const float r = oscale / sqrtf(sq * (1.0f / 64.0f) + NORM_EPS);
#pragma unroll
    for (int bj = 0; bj < 2; ++bj) {
        const f32x4 g0 = *(const f32x4*)(gain + 32 * bj + 8 * fq), g1 = *(const f32x4*)(gain + 32 * bj + 8 * fq + 4);
        const f32x4 v0 = acc[ai][bj][m][0] * (rs * r) * g0, v1 = acc[ai][bj][m][1] * (rs * r) * g1;
        *(u32x4*)(dst + 32 * bj + 8 * fq) = pk8h(v0, v1);
    }
}

struct EpiWin {
    static constexpr bool AFTER_DRAIN = false;
    const float* ssq;
    const float *gq, *gk, *gmq;
    h16 *qa, *ka, *va, *qidx, *kidx, *acat, *qm, *gates; float* widx;
    __device__ __forceinline__ void operator()(const Acc& acc, const Unit& u, int wr, int wc, int fr, int fq) const {
        const int row0 = u.pm * 256 + wr * 64 + fr; const int pn = u.pn;
        float rs[2][4];
#pragma unroll
        for (int ai = 0; ai < 2; ++ai)
#pragma unroll
            for (int m = 0; m < 4; ++m) rs[ai][m] = rstd_from_ssq_q(ssq, row0 + ai * 128 + m * 16, fq);
        if (pn < 2) {
#pragma unroll
            for (int ai = 0; ai < 2; ++ai)
#pragma unroll
                for (int m = 0; m < 4; ++m) { const int r = row0 + ai * 128 + m * 16;
                    head_norm_store(acc, ai, m, rs[ai][m], gq, 0.125f * LOG2E, qa + (size_t)r * 512 + (4 * pn + wc) * 64, fq); }
        } else if (pn == 2) {
            if (wc == 0) {
#pragma unroll
                for (int ai = 0; ai < 2; ++ai)
#pragma unroll
                    for (int m = 0; m < 4; ++m) { const int r = row0 + ai * 128 + m * 16; head_norm_store(acc, ai, m, rs[ai][m], gk, 1.0f, ka + (size_t)r * 64, fq); }
            } else if (wc == 1) {
#pragma unroll
                for (int ai = 0; ai < 2; ++ai)
#pragma unroll
                    for (int m = 0; m < 4; ++m) { const int r = row0 + ai * 128 + m * 16;
#pragma unroll
                        for (int bj = 0; bj < 2; ++bj) *(u32x4*)(va + (size_t)r * 64 + 32 * bj + 8 * fq) = pk8h(acc[ai][bj][m][0] * rs[ai][m], acc[ai][bj][m][1] * rs[ai][m]); }
            } else if (wc == 2) {
#pragma unroll
                for (int ai = 0; ai < 2; ++ai)
#pragma unroll
                    for (int m = 0; m < 4; ++m) { const int r = row0 + ai * 128 + m * 16;
#pragma unroll
                        for (int bj = 0; bj < 2; ++bj) *(u32x4*)(kidx + (size_t)r * 64 + 32 * bj + 8 * fq) = pk8h(acc[ai][bj][m][0] * rs[ai][m], acc[ai][bj][m][1] * rs[ai][m]); }
            } else {
                if (fq == 0) {
#pragma unroll
                    for (int ai = 0; ai < 2; ++ai)
#pragma unroll
                        for (int m = 0; m < 4; ++m) { const int r = row0 + ai * 128 + m * 16; *(f32x4*)(widx + (size_t)r * 4) = acc[ai][0][m][0] * (rs[ai][m] * 0.0625f); }
                }
            }
        } else if (pn == 3) {
#pragma unroll
            for (int ai = 0; ai < 2; ++ai)
#pragma unroll
                for (int m = 0; m < 4; ++m) { const int r = row0 + ai * 128 + m * 16;
#pragma unroll
                    for (int bj = 0; bj < 2; ++bj) *(u32x4*)(qidx + (size_t)r * 256 + 128 * bj + 32 * wc + 8 * fq) = pk8h(acc[ai][bj][m][0] * rs[ai][m], acc[ai][bj][m][1] * rs[ai][m]); }
        } else if (pn == 4) {
#pragma unroll
            for (int ai = 0; ai < 2; ++ai)
#pragma unroll
                for (int m = 0; m < 4; ++m) { const int r = row0 + ai * 128 + m * 16; const int bc = r >> 6, s = r & 63;
#pragma unroll
                    for (int bj = 0; bj < 2; ++bj) { const int col = 128 * bj + 32 * wc + 8 * fq, g = col >> 4, c0 = col & 15;
                        *(u32x4*)(acat + ((size_t)g * 1024 + bc) * 1280 + 16 * s + c0) = pk8h(acc[ai][bj][m][0] * rs[ai][m], acc[ai][bj][m][1] * rs[ai][m]); } }
        } else if (pn == 5) {
#pragma unroll
            for (int ai = 0; ai < 2; ++ai)
#pragma unroll
                for (int m = 0; m < 4; ++m) { const int r = row0 + ai * 128 + m * 16;
                    head_norm_store(acc, ai, m, rs[ai][m], gmq, 0.125f * LOG2E, qm + (size_t)r * 256 + wc * 64, fq); }
        } else {
#pragma unroll
            for (int ai = 0; ai < 2; ++ai)
#pragma unroll
                for (int m = 0; m < 4; ++m) { const int r = row0 + ai * 128 + m * 16;
#pragma unroll
                    for (int bj = 0; bj < 2; ++bj) { f32x4 v0 = acc[ai][bj][m][0] * rs[ai][m], v1 = acc[ai][bj][m][1] * rs[ai][m];
#pragma unroll
                        for (int j = 0; j < 4; ++j) { v0[j] = fast_sigmoid(v0[j]); v1[j] = fast_sigmoid(v1[j]); }
                        *(u32x4*)(gates + (size_t)r * 3072 + (pn - 6) * 256 + 128 * bj + 32 * wc + 8 * fq) = pk8h(v0, v1); } }
        }
    }
};

struct EpiMemKV {
    static constexpr bool AFTER_DRAIN = false;
    const float* gmk; h16* mk; h16* mvT;
    __device__ __forceinline__ void operator()(const Acc& acc, const Unit& u, int wr, int wc, int fr, int fq) const {
        const int row0 = u.pm * 256 + wr * 64 + fr;
        if (u.pn == 0) {
#pragma unroll
            for (int ai = 0; ai < 2; ++ai)
#pragma unroll
                for (int m = 0; m < 4; ++m) { const int r = row0 + ai * 128 + m * 16; head_norm_store(acc, ai, m, 1.0f, gmk, 1.0f, mk + (size_t)r * 256 + wc * 64, fq); }
        } else {
#pragma unroll
            for (int ai = 0; ai < 2; ++ai)
#pragma unroll
                for (int m = 0; m < 4; ++m) { const int r = row0 + ai * 128 + m * 16; const int b = r >> 8, kv = r & 255;
                    h16* dst = mvT + ((size_t)(b * 4 + wc) * 64) * MEMT + kv;
#pragma unroll
                    for (int bj = 0; bj < 2; ++bj)
#pragma unroll
                        for (int n = 0; n < 2; ++n)
#pragma unroll
                            for (int j = 0; j < 4; ++j) dst[(size_t)(32 * bj + 8 * fq + 4 * n + j) * MEMT] = (h16)acc[ai][bj][m][n][j]; }
        }
    }
};

struct EpiGlu {
    static constexpr bool AFTER_DRAIN = false;
    h16* ob;
    __device__ __forceinline__ void operator()(const Acc& acc, const Unit& u, int wr, int wc, int fr, int fq) const {
        const int row0 = u.pm * 256 + wr * 64 + fr, col = u.pn * 128 + wc * 32 + fq * 8;
#pragma unroll
        for (int ai = 0; ai < 2; ++ai)
#pragma unroll
            for (int m = 0; m < 4; ++m) { const int r = row0 + ai * 128 + m * 16; f32x4 o[2];
#pragma unroll
                for (int n = 0; n < 2; ++n)
#pragma unroll
                    for (int j = 0; j < 4; ++j) o[n][j] = acc[ai][0][m][n][j] * fast_sigmoid(acc[ai][1][m][n][j]);
                *(u32x4*)(ob + (size_t)r * DM + col) = pk8h(o[0], o[1]); }
    }
};

template <int MODE> struct EpiMerge {
    static constexpr bool AFTER_DRAIN = false;
    const h16* gates; const h16* ob; h16* merged;
    __device__ __forceinline__ void operator()(const Acc& acc, const Unit& u, int wr, int wc, int fr, int fq) const {
        const int row0 = u.pm * 256 + wr * 64 + fr, col0 = u.pn * 256 + wc * 32 + fq * 8;
#pragma unroll
        for (int ai = 0; ai < 2; ++ai)
#pragma unroll
            for (int m = 0; m < 4; ++m) { const int r = row0 + ai * 128 + m * 16;
#pragma unroll
                for (int bj = 0; bj < 2; ++bj) { const int col = col0 + bj * 128;
                    f32x4 ga0, ga1, t0, t1;
                    if (MODE == 0) { f32x4 gb0, gb1, o0, o1;
                        unpk8h(*(const u32x4*)(gates + (size_t)r * 3072 + col), ga0, ga1); unpk8h(*(const u32x4*)(gates + (size_t)r * 3072 + 1024 + col), gb0, gb1);
                        unpk8h(*(const u32x4*)(ob + (size_t)r * DM + col), o0, o1);
                        t0 = ga0 * acc[ai][bj][m][0] + gb0 * o0; t1 = ga1 * acc[ai][bj][m][1] + gb1 * o1;
                    } else {
                        unpk8h(*(const u32x4*)(gates + (size_t)r * 3072 + 2048 + col), ga0, ga1); unpk8h(*(const u32x4*)(merged + (size_t)r * DM + col), t0, t1);
                        t0 = t0 + ga0 * acc[ai][bj][m][0]; t1 = t1 + ga1 * acc[ai][bj][m][1];
                    }
                    *(u32x4*)(merged + (size_t)r * DM + col) = pk8h(t0, t1); } }
    }
};

struct EpiS5Main {
    static constexpr bool AFTER_DRAIN = false;
    const float* logdt; h16* ys;
    __device__ __forceinline__ void operator()(const Acc& acc, const Unit& u, int wr, int wc, int fr, int fq) const {
        const int g = u.pm >> 2, pmm = u.pm & 3, pnn = u.pn & 3; const float dt = __expf(logdt[g]);
        const int row0 = pmm * 256 + wr * 64 + fr;
#pragma unroll
        for (int ai = 0; ai < 2; ++ai)
#pragma unroll
            for (int m = 0; m < 4; ++m) { const int bc = row0 + ai * 128 + m * 16;
#pragma unroll
                for (int bj = 0; bj < 2; ++bj) { const int tc = pnn * 256 + 128 * bj + 32 * wc + 8 * fq, t = tc >> 4, c0 = tc & 15;
                    f32x4 v[2];
#pragma unroll
                    for (int n = 0; n < 2; ++n)
#pragma unroll
                        for (int j = 0; j < 4; ++j) { const float y = acc[ai][bj][m][n][j] * dt; const float z = 1.5957691216f * (y + 0.044715f * y * y * y); v[n][j] = y * fast_sigmoid(z); }
                    *(u32x4*)(ys + ((size_t)bc * 64 + t) * 256 + 16 * g + c0) = pk8h(v[0], v[1]); } }
    }
};

struct EpiS5State {
    static constexpr bool AFTER_DRAIN = true;
    const float* logdt; const float* a64;
    h16* acat;
    __device__ __forceinline__ void fused(const Acc& acc, const Unit& u, int wr, int wc, int fr, int fq, LAS unsigned char* lds) const {
        const int g = u.pn, pmm = u.pm & 3; const float dt = __expf(logdt[g]);
        LAS float* sb = (LAS float*)lds;
#pragma unroll
        for (int ai = 0; ai < 2; ++ai)
#pragma unroll
            for (int m = 0; m < 4; ++m) { const int r = ai * 128 + wr * 64 + m * 16 + fr;
                *(LAS f32x4*)(sb + r * 132 + 32 * wc + 8 * fq) = acc[ai][0][m][0] * dt; *(LAS f32x4*)(sb + r * 132 + 32 * wc + 8 * fq + 4) = acc[ai][0][m][1] * dt; }
        __syncthreads();
        const int tid = threadIdx.x, bl = tid >> 6, p = tid & 63;
        const float ar = a64[(g * 64 + p) * 2], ai_ = a64[(g * 64 + p) * 2 + 1];
        float xr = 0.f, xi = 0.f;
        h16* dst = acat + ((size_t)g * 1024 + (size_t)(pmm * 8 + bl) * 32) * 1280;
        for (int ch = 0; ch < 32; ++ch) {
            dst[(size_t)ch * 1280 + 1024 + p] = (h16)xr; dst[(size_t)ch * 1280 + 1088 + p] = (h16)xi;
            dst[(size_t)ch * 1280 + 1152 + p] = (h16)0.f; dst[(size_t)ch * 1280 + 1216 + p] = (h16)0.f;
            const float sr = sb[(bl * 32 + ch) * 132 + p], si = sb[(bl * 32 + ch) * 132 + 64 + p];
            const float nr = ar * xr - ai_ * xi + sr, ni = ar * xi + ai_ * xr + si; xr = nr; xi = ni;
        }
        __syncthreads();
    }
};
}
namespace pro {
#define LDS_WAIT() asm volatile("s_waitcnt lgkmcnt(0)" ::: "memory")

__device__ __forceinline__ float wave_sum(float v) {
#pragma unroll
    for (int o = 1; o < 64; o <<= 1) v += __shfl_xor(v, o);
    return v;
}

__device__ __forceinline__ void tr_item(const float* W, int ldw, int src0, int nvalid, const float* gain, h16* Bt, int K, int row0, int k0, LAS float* scr, int lane) {
#pragma unroll 8
    for (int i = 0; i < 32; ++i) { const int kk = 2 * i + (lane >> 5), c = lane & 31;
        float v = 0.f; if (c < nvalid) v = W[(size_t)(k0 + kk) * ldw + src0 + c];
        if (gain) v *= gain[k0 + kk];
        scr[kk * 33 + c] = v; }
    LDS_WAIT(); asm volatile("" ::: "memory");
    const int c8 = lane & 7;
#pragma unroll
    for (int jj = 0; jj < 4; ++jj) { const int q = (lane >> 3) + 8 * jj; const int o = 8 * ((q >> 2) & 3) + 4 * (q >> 4) + (q & 3);
        const LAS float* s = scr + (8 * c8) * 33 + o;
        u32x4 w; w.x = pk2h(s[0 * 33], s[1 * 33]); w.y = pk2h(s[2 * 33], s[3 * 33]); w.z = pk2h(s[4 * 33], s[5 * 33]); w.w = pk2h(s[6 * 33], s[7 * 33]);
        *(u32x4*)(Bt + (size_t)(row0 + q) * K + k0 + 8 * c8) = w; }
    LDS_WAIT(); asm volatile("" ::: "memory");
}

__device__ __forceinline__ int win_src0(int gi, int& nv) {
    const int pn = gi >> 3, bj = (gi >> 2) & 1, wc = gi & 3; nv = 32;
    if (pn < 2) return 64 * (4 * pn + wc) + 32 * bj;
    if (pn == 2) { if (wc == 0) return 512 + 32 * bj; if (wc == 1) return 576 + 32 * bj; if (wc == 2) return 896 + 32 * bj; nv = bj ? 0 : 4; return 960; }
    if (pn == 3) return 640 + 128 * bj + 32 * wc;
    if (pn == 4) return 964 + 128 * bj + 32 * wc;
    if (pn == 5) return 1220 + 64 * wc + 32 * bj;
    return 1476 + 256 * (pn - 6) + 128 * bj + 32 * wc;
}

struct WPtrs { const float *w1a, *w1b, *win, *wmkv, *wglu, *woa, *wom, *wout, *w2a, *w2b, *g1, *gmix, *g2;
               h16 *W1A, *W1B, *WIN, *WMKV, *WGLU, *WOA, *WOM, *WOUT, *W2A, *W2B; };

constexpr int IT_1A = 176 * 16, IT_1B = 32 * 44, IT_IN = 144 * 16, IT_MKV = 16 * 16, IT_GLU = 64 * 4, IT_OA = 32 * 8, IT_OM = 32 * 4, IT_OUT = 32 * 16;
constexpr int IT_TOTAL = 2 * IT_1A + 2 * IT_1B + IT_IN + IT_MKV + IT_GLU + IT_OA + IT_OM + IT_OUT;

__device__ __forceinline__ void weight_item(const WPtrs& P, int it, LAS float* scr, int lane) {
    int r = it;
    if (r < 2 * IT_1A) { const bool second = r >= IT_1A; if (second) r -= IT_1A; const int gi = r >> 4, kb = r & 15; const int pn = gi >> 3, bj = (gi >> 2) & 1, wc = gi & 3;
        tr_item(second ? P.w2a : P.w1a, 2 * FFN, (bj ? FFN : 0) + 128 * pn + 32 * wc, 32, second ? P.g2 : P.g1, second ? P.W2A : P.W1A, 1024, 32 * gi, 64 * kb, scr, lane); return; }
    r -= 2 * IT_1A;
    if (r < 2 * IT_1B) { const bool second = r >= IT_1B; if (second) r -= IT_1B; const int gi = r / 44, kb = r % 44;
        tr_item(second ? P.w2b : P.w1b, DM, 32 * gi, 32, nullptr, second ? P.W2B : P.W1B, FFN, 32 * gi, 64 * kb, scr, lane); return; }
    r -= 2 * IT_1B;
    if (r < IT_IN) { const int gi = r >> 4, kb = r & 15; int nv; const int s0 = win_src0(gi, nv);
        tr_item(P.win, 4548, s0, nv, P.gmix, P.WIN, 1024, 32 * gi, 64 * kb, scr, lane); return; }
    r -= IT_IN;
    if (r < IT_MKV) { const int gi = r >> 4, kb = r & 15; const int pn = gi >> 3, bj = (gi >> 2) & 1, wc = gi & 3;
        tr_item(P.wmkv, 512, 256 * pn + 64 * wc + 32 * bj, 32, nullptr, P.WMKV, 1024, 32 * gi, 64 * kb, scr, lane); return; }
    r -= IT_MKV;
    if (r < IT_GLU) { const int gi = r >> 2, kb = r & 3; const int pn = gi >> 3, bj = (gi >> 2) & 1, wc = gi & 3;
        tr_item(P.wglu, 2048, (bj ? 1024 : 0) + 128 * pn + 32 * wc, 32, nullptr, P.WGLU, 256, 32 * gi, 64 * kb, scr, lane); return; }
    r -= IT_GLU;
    if (r < IT_OA) { const int gi = r >> 3, kb = r & 7; tr_item(P.woa, DM, 32 * gi, 32, nullptr, P.WOA, 512, 32 * gi, 64 * kb, scr, lane); return; }
    r -= IT_OA;
    if (r < IT_OM) { const int gi = r >> 2, kb = r & 3; tr_item(P.wom, DM, 32 * gi, 32, nullptr, P.WOM, 256, 32 * gi, 64 * kb, scr, lane); return; }
    r -= IT_OM;
    { const int gi = r >> 4, kb = r & 15; tr_item(P.wout, DM, 32 * gi, 32, nullptr, P.WOUT, 1024, 32 * gi, 64 * kb, scr, lane); }
}

__device__ __forceinline__ float row_to_h16(const float* xrow, h16* orow, const float* gain, int lane) {
    const f32x4* xr = (const f32x4*)xrow + lane;
    f32x4 v[4]; float s = 0.f;
#pragma unroll
    for (int j = 0; j < 4; ++j) { v[j] = xr[64 * j]; s += (v[j][0] * v[j][0] + v[j][1] * v[j][1]) + (v[j][2] * v[j][2] + v[j][3] * v[j][3]); }
    const float rstd = 1.0f / sqrtf(wave_sum(s) * (1.0f / DM) + NORM_EPS);
    u32x2* o8 = (u32x2*)orow + lane;
#pragma unroll
    for (int j = 0; j < 4; ++j) { f32x4 w = v[j];
        if (gain) { const f32x4 gv = ((const f32x4*)gain)[lane + 64 * j]; w = w * rstd * gv; }
        u32x2 p; p.x = pk2h(w[0], w[1]); p.y = pk2h(w[2], w[3]); o8[64 * j] = p; }
    return rstd;
}

struct S5In { const float *lre, *lim, *logdt, *bre, *bim, *cre, *cim, *dd; };
__device__ __forceinline__ int slot_row(int c) { const int o = c & 31; return (c & ~31) + 16 * ((o >> 2) & 1) + 4 * (o >> 3) + (o & 3); }
__device__ __forceinline__ void cpow(float ar, float ai, int n, float& pr, float& pi) {
    pr = 1.f; pi = 0.f;
    for (int i = 0; i < n; ++i) { const float t = pr * ar - pi * ai; pi = pr * ai + pi * ar; pr = t; }
}
__device__ __forceinline__ void s5_item(const S5In& I, int g, int j, h16* tcat, h16* wst, float* a64, LAS float* L, int tid) {
    LAS float* Pj = L;
    LAS float* Pj1 = L + 128;
    LAS float* P63 = L + 256;
    LAS float* Bb = L + 384;
    LAS float* CP = L + 384 + 2048;
    LAS float* Kb = L + 384 + 4096;
    const float dt = __expf(I.logdt[g]); const float sig = 1.0f / dt;
    __syncthreads();
    if (tid < 64) { const int p = tid; const float lr = I.lre[g * 64 + p], li = I.lim[g * 64 + p];
        const float mag = __expf(lr * dt); const float ar = mag * cosf(li * dt), ai = mag * sinf(li * dt);
        const float den = lr * lr + li * li; const float fr = ((ar - 1.0f) * lr + ai * li) / den, fi = (ai * lr - (ar - 1.0f) * li) / den;
        float pr, pi; cpow(ar, ai, j, pr, pi); Pj[2 * p] = pr; Pj[2 * p + 1] = pi;
        { const float t = pr * ar - pi * ai; const float u = pr * ai + pi * ar; Pj1[2 * p] = t; Pj1[2 * p + 1] = u; }
        cpow(ar, ai, 63 - j, pr, pi); P63[2 * p] = pr; P63[2 * p + 1] = pi;
        if (j == 0) { cpow(ar, ai, 64, pr, pi); a64[(g * 64 + p) * 2] = pr; a64[(g * 64 + p) * 2 + 1] = pi; }
#pragma unroll 4
        for (int c = 0; c < 16; ++c) { const float br = I.bre[(g * 64 + p) * 16 + c], bi = I.bim[(g * 64 + p) * 16 + c];
            Bb[(p * 16 + c) * 2] = fr * br - fi * bi; Bb[(p * 16 + c) * 2 + 1] = fr * bi + fi * br; }
    }
    __syncthreads();
    for (int e = tid; e < 1024; e += 512) { const int cp = e >> 6, p = e & 63;
        const float cr = I.cre[(g * 16 + cp) * 64 + p], ci = I.cim[(g * 16 + cp) * 64 + p], pr = Pj[2 * p], pi = Pj[2 * p + 1];
        CP[e * 2] = cr * pr - ci * pi; CP[e * 2 + 1] = cr * pi + ci * pr; }
    __syncthreads();
    if (tid < 256) { const int cp = tid >> 4, c = tid & 15; float s = 0.f;
        for (int p = 0; p < 64; ++p) s += CP[(cp * 64 + p) * 2] * Bb[(p * 16 + c) * 2] - CP[(cp * 64 + p) * 2 + 1] * Bb[(p * 16 + c) * 2 + 1];
        if (j == 0 && cp == c) s += I.dd[g * 16 + c];
        Kb[tid] = s * sig; }
    __syncthreads();
    h16* T = tcat + (size_t)g * 1024 * 1280;
    for (int e = tid; e < (64 - j) * 32; e += 512) { const int d = e >> 5, cp = (e >> 1) & 15, h = e & 1;
        const LAS float* k = Kb + cp * 16 + 8 * h;
        u32x4 w; w.x = pk2h(k[0], k[1]); w.y = pk2h(k[2], k[3]); w.z = pk2h(k[4], k[5]); w.w = pk2h(k[6], k[7]);
        *(u32x4*)(T + (size_t)slot_row((j + d) * 16 + cp) * 1280 + 16 * d + 8 * h) = w;
        if (j > 0) *(u32x4*)(T + (size_t)slot_row(d * 16 + cp) * 1280 + 16 * (j + d) + 8 * h) = (u32x4){0u, 0u, 0u, 0u}; }
    for (int e = tid; e < 1024; e += 512) { const int cp = e >> 6, p = e & 63;
        const float cr = I.cre[(g * 16 + cp) * 64 + p], ci = I.cim[(g * 16 + cp) * 64 + p], pr = Pj1[2 * p], pi = Pj1[2 * p + 1];
        h16* row = T + (size_t)slot_row(j * 16 + cp) * 1280;
        row[1024 + p] = (h16)((cr * pr - ci * pi) * sig); row[1088 + p] = (h16)(-(cr * pi + ci * pr) * sig); row[1152 + p] = (h16)0.f; row[1216 + p] = (h16)0.f; }
    h16* Wg = wst + (size_t)g * 256 * 1024;
    for (int e = tid; e < 1024; e += 512) { const int p = e >> 4, c = e & 15;
        const float pr = P63[2 * p], pi = P63[2 * p + 1], br = Bb[(p * 16 + c) * 2], bi = Bb[(p * 16 + c) * 2 + 1];
        Wg[(size_t)slot_row(p) * 1024 + 16 * j + c] = (h16)((pr * br - pi * bi) * sig); Wg[(size_t)slot_row(64 + p) * 1024 + 16 * j + c] = (h16)((pr * bi + pi * br) * sig); }
    for (int e = tid; e < 128 * 16; e += 512) { const int rr = 128 + (e >> 4), c = e & 15; Wg[(size_t)rr * 1024 + 16 * j + c] = (h16)0.f; }
}
}
namespace att {
constexpr int SC_STRIDE = 2052;
constexpr int L_KS = 0, L_VS = 9216, L_MASK = 65664, L_HIST = 82304, L_CAND = 90496, L_RELB = 94592, L_FBUF = 101760, L_END = 103808;
constexpr float NEG_INF = -__builtin_inff();
constexpr float THR = 6.0f;

struct P {
    const h16 *qa, *ka, *va, *qidx, *kidx, *qm, *mk, *mvT; const float* widx; const float* relb;
    h16* out;
};

__device__ __forceinline__ int crow(int r, int hi) { return (r & 3) + 8 * (r >> 2) + 4 * hi; }
__device__ __forceinline__ unsigned fkey(float f) { const unsigned u = __float_as_uint(f); return u ^ ((unsigned)((int)u >> 31) | 0x80000000u); }
__device__ __forceinline__ float swapmax(float m) { auto rr = __builtin_amdgcn_permlane32_swap(__float_as_uint(m), __float_as_uint(m), false, false); return fmaxf(__uint_as_float(rr[0]), __uint_as_float(rr[1])); }
__device__ __forceinline__ float swapsum(float m) { auto rr = __builtin_amdgcn_permlane32_swap(__float_as_uint(m), __float_as_uint(m), false, false); return __uint_as_float(rr[0]) + __uint_as_float(rr[1]); }
__device__ __forceinline__ float qperm_b1(float v) { return __int_as_float(__builtin_amdgcn_mov_dpp(__float_as_int(v), 0xB1, 0xF, 0xF, true)); }
__device__ __forceinline__ float qperm_4e(float v) { return __int_as_float(__builtin_amdgcn_mov_dpp(__float_as_int(v), 0x4E, 0xF, 0xF, true)); }

__device__ __forceinline__ int t5_bucket(int rel) {
    const int n = rel < 0 ? -rel : rel; int v;
    if (n < 8) v = n; else if (n < 12) v = 8; else if (n < 16) v = 9; else if (n < 23) v = 10; else if (n < 32) v = 11; else if (n < 46) v = 12; else if (n < 64) v = 13; else if (n < 91) v = 14; else v = 15;
    return (rel > 0 ? 16 : 0) + v;
}

__device__ __forceinline__ void softmax_tile(f32x16& s, float& mrun, float& lsum, f32x16& O0, f32x16& O1, LAS float* fb  , int lane, int hi, h16x8& p0, h16x8& p1) {
    float tm = fmaxf(fmaxf(s[0], s[1]), fmaxf(s[2], s[3]));
#pragma unroll
    for (int r = 4; r < 16; r += 4) tm = fmaxf(tm, fmaxf(fmaxf(s[r], s[r + 1]), fmaxf(s[r + 2], s[r + 3])));
    tm = swapmax(tm);
    const bool need = tm > mrun + THR;
    if (__any(need)) {
        const float mnew = need ? tm : mrun; const float f = need ? __builtin_amdgcn_exp2f(mrun - mnew) : 1.0f;
        mrun = mnew; lsum *= f;
        if (hi == 0) fb[lane] = f;
        asm volatile("s_waitcnt lgkmcnt(0)" ::: "memory");
#pragma unroll
        for (int g = 0; g < 4; ++g) { const f32x4 fv = *(const LAS f32x4*)(fb + 8 * g + 4 * hi);
#pragma unroll
            for (int i = 0; i < 4; ++i) { O0[4 * g + i] *= fv[i]; O1[4 * g + i] *= fv[i]; } }
        asm volatile("s_waitcnt lgkmcnt(0)" ::: "memory");
    }
    float ps = 0.f;
#pragma unroll
    for (int r = 0; r < 16; ++r) { s[r] = __builtin_amdgcn_exp2f(s[r] - mrun); ps += s[r]; }
    lsum += ps;
    p0 = (h16x8){(h16)s[0], (h16)s[1], (h16)s[2], (h16)s[3], (h16)s[4], (h16)s[5], (h16)s[6], (h16)s[7]};
    p1 = (h16x8){(h16)s[8], (h16)s[9], (h16)s[10], (h16)s[11], (h16)s[12], (h16)s[13], (h16)s[14], (h16)s[15]};
}
__device__ __forceinline__ void store_o(const f32x16& O0, const f32x16& O1, float lsum, LAS float* fb, int lane, int hi, h16* out, size_t tok0, int col0) {
    const float lt = swapsum(lsum);
    if (hi == 0) fb[lane] = 1.0f / lt;
    asm volatile("s_waitcnt lgkmcnt(0)" ::: "memory");
#pragma unroll
    for (int g = 0; g < 4; ++g) { const f32x4 fv = *(const LAS f32x4*)(fb + 8 * g + 4 * hi);
#pragma unroll
        for (int i = 0; i < 4; ++i) { const int q = 8 * g + 4 * hi + i; h16* o = out + (tok0 + q) * 768 + col0 + (lane & 31);
            o[0] = (h16)(O0[4 * g + i] * fv[i]); o[32] = (h16)(O1[4 * g + i] * fv[i]); } }
    asm volatile("s_waitcnt lgkmcnt(0)" ::: "memory");
}

#define SEL_LOAD4(i0) float s4[4]; _Pragma("unroll") for (int k_ = 0; k_ < 4; ++k_) s4[k_] = ((i0) + k_ < nreg) ? row[64 * ((i0) + k_) + lane] + 0.0f : __builtin_nanf("");
__device__ __forceinline__ void select_row(const LAS float* row, int nreg, LAS unsigned* hist, LAS unsigned long long* cand, LAS unsigned* mrow, int lane) {
    float lo = __builtin_inff(), hv = -__builtin_inff();
    for (int i0 = 0; i0 < nreg; i0 += 4) { SEL_LOAD4(i0);
#pragma unroll
        for (int k = 0; k < 4; ++k) { lo = fminf(lo, s4[k]); hv = fmaxf(hv, s4[k]); } }
#pragma unroll
    for (int o = 1; o < 64; o <<= 1) { lo = fminf(lo, __shfl_xor(lo, o)); hv = fmaxf(hv, __shfl_xor(hv, o)); }
    unsigned T = 0u; int istar = 0; int rr = 256;
    for (int level = 0; level < 40; ++level) {
        if (hv == lo) {
            int cnt = 0; T = fkey(lo);
            for (int i0 = 0; i0 < nreg; i0 += 4) { SEL_LOAD4(i0);
#pragma unroll
                for (int k = 0; k < 4; ++k) { unsigned long long m = __ballot(s4[k] == lo); const int pc = __popcll(m);
                    if (cnt < rr && cnt + pc >= rr) { for (int z = rr - cnt - 1; z > 0; --z) m &= m - 1ull; istar = 64 * (i0 + k) + __ffsll(m) - 1; }
                    cnt += pc; } }
            break;
        }
        const float scale = 256.0f / (hv - lo);
        *(LAS u32x4*)(hist + 4 * lane) = (u32x4){0u, 0u, 0u, 0u};
        asm volatile("s_waitcnt lgkmcnt(0)" ::: "memory");
        for (int i0 = 0; i0 < nreg; i0 += 4) { SEL_LOAD4(i0);
#pragma unroll
            for (int k = 0; k < 4; ++k) if (s4[k] >= lo && s4[k] <= hv) { int bin = (int)((s4[k] - lo) * scale); bin = bin > 255 ? 255 : bin; __hip_atomic_fetch_add(hist + bin, 1u, __ATOMIC_RELAXED, __HIP_MEMORY_SCOPE_WORKGROUP); } }
        asm volatile("s_waitcnt lgkmcnt(0)" ::: "memory");
        const u32x4 cv = *(const LAS u32x4*)(hist + 4 * lane);
        const unsigned tot = cv[0] + cv[1] + cv[2] + cv[3];
        unsigned S = tot;
#pragma unroll
        for (int off = 1; off < 64; off <<= 1) { const unsigned t = __shfl_down(S, off); if (lane + off < 64) S += t; }
        const unsigned above = S - tot; const bool isit = (above < (unsigned)rr) && (S >= (unsigned)rr);
        int bl = -1; unsigned Gl = 0, cum = above;
#pragma unroll
        for (int k = 3; k >= 0; --k) { if (bl < 0) { if (cum + cv[k] >= (unsigned)rr) { bl = 4 * lane + k; Gl = cum; } else cum += cv[k]; } }
        const int src = __ffsll((unsigned long long)__ballot(isit)) - 1;
        const int bstar = __shfl(bl, src); rr -= (int)__shfl(Gl, src);
        int n1 = 0; float clo = __builtin_inff(), chi = -__builtin_inff();
        for (int i0 = 0; i0 < nreg; i0 += 4) { SEL_LOAD4(i0);
#pragma unroll
            for (int k = 0; k < 4; ++k) { bool isc = false;
                if (s4[k] >= lo && s4[k] <= hv) { int bin = (int)((s4[k] - lo) * scale); bin = bin > 255 ? 255 : bin; isc = (bin == bstar); }
                const unsigned long long m = __ballot(isc); const int pos = n1 + __builtin_amdgcn_mbcnt_hi((unsigned)(m >> 32), __builtin_amdgcn_mbcnt_lo((unsigned)m, 0u));
                if (isc) { clo = fminf(clo, s4[k]); chi = fmaxf(chi, s4[k]); if (pos < 64) cand[pos] = ((unsigned long long)fkey(s4[k]) << 32) | (unsigned long long)(0xFFFFu - (unsigned)(64 * (i0 + k) + lane)); }
                n1 += __popcll(m); } }
#pragma unroll
        for (int o = 1; o < 64; o <<= 1) { clo = fminf(clo, __shfl_xor(clo, o)); chi = fmaxf(chi, __shfl_xor(chi, o)); }
        if (n1 <= 64 && clo != chi) {
            asm volatile("s_waitcnt lgkmcnt(0)" ::: "memory");
            const unsigned long long mine = lane < n1 ? cand[lane] : 0ull;
            const unsigned mh = (unsigned)(mine >> 32), ml = (unsigned)mine;
            int cnt = 0;
#pragma unroll 1
            for (int jx = 0; jx < n1; ++jx) { const unsigned oh = __builtin_amdgcn_readlane(mh, jx), ol = __builtin_amdgcn_readlane(ml, jx);
                cnt += (oh > mh || (oh == mh && ol > ml)) ? 1 : 0; }
            const int src2 = __ffsll((unsigned long long)__ballot(lane < n1 && cnt == rr - 1)) - 1;
            T = __shfl(mh, src2); istar = 0xFFFF - (int)(__shfl(ml, src2) & 0xFFFFu);
            asm volatile("s_waitcnt lgkmcnt(0)" ::: "memory");
            break;
        }
        lo = clo; hv = chi;
    }
    for (int i0 = 0; i0 < nreg; i0 += 4) { SEL_LOAD4(i0);
#pragma unroll
        for (int k = 0; k < 4; ++k) { const unsigned kk = fkey(s4[k]); const int idx = 64 * (i0 + k) + lane;
            const unsigned long long m = __ballot(kk > T || (kk == T && idx <= istar));
            if (lane < 2 && i0 + k < nreg) mrow[2 * (i0 + k) + lane] = lane ? (unsigned)(m >> 32) : (unsigned)m; } }
}
#undef SEL_LOAD4

#ifdef TIMING_VARIANT
#define TV(bit) (variant & (bit))
#else
#define TV(bit) 0
#endif
__device__ __forceinline__ void attn_unit(const P& A, int b, int c, LAS unsigned char* lds, int tid, int variant) {
    const int lane = tid & 63, wv = __builtin_amdgcn_readfirstlane(tid >> 6), col = lane & 31, hi = lane >> 5;
    const int L = 64 * (c + 1), ntile = L / 32;
    const size_t tokb = (size_t)b * SEQ;
    LAS unsigned* maskw = (LAS unsigned*)(lds + L_MASK);
    LAS float* fb = (LAS float*)(lds + L_FBUF) + wv * 64;
    __syncthreads();
    if (c < 4 || TV(1)) {
        for (int e = tid; e < 64 * ntile; e += 512) { const int q = e / ntile, j = e % ntile; maskw[q * 65 + j] = 0xFFFFFFFFu; }
    } else {
        LAS float* sc = (LAS float*)lds;
        for (int rd = 0; rd < 8; ++rd) {
            const int qq = col >> 2, hI = col & 3; const size_t tq = tokb + 64 * c + 8 * rd + qq;
            h16x8 qf[4];
#pragma unroll
            for (int s = 0; s < 4; ++s) qf[s] = *(const h16x8*)(A.qidx + tq * 256 + hI * 64 + 16 * s + 8 * hi);
            const float wq = A.widx[tq * 4 + hI];
            for (int j = wv; j < ntile; j += 8) {
                const h16* kp = A.kidx + (tokb + 32 * j + col) * 64 + 8 * hi;
                f32x16 acc = {};
#pragma unroll
                for (int s = 0; s < 4; ++s) acc = __builtin_amdgcn_mfma_f32_32x32x16_f16(*(const h16x8*)(kp + 16 * s), qf[s], acc, 0, 0, 0);
                float v[16];
#pragma unroll
                for (int r = 0; r < 16; ++r) { float t = fmaxf(acc[r], 0.f) * wq; t += qperm_b1(t); t += qperm_4e(t); v[r] = t; }
                f32x4 o;
#pragma unroll
                for (int i = 0; i < 4; ++i) o[i] = hI == 0 ? v[i] : hI == 1 ? v[4 + i] : hI == 2 ? v[8 + i] : v[12 + i];
                *(LAS f32x4*)(sc + qq * SC_STRIDE + 32 * j + 8 * hI + 4 * hi) = o;
            }
            __syncthreads();
            if (!TV(16))
            select_row(sc + wv * SC_STRIDE, L / 64, (LAS unsigned*)(lds + L_HIST) + wv * 256, (LAS unsigned long long*)(lds + L_CAND) + wv * 64, maskw + (8 * rd + wv) * 65, lane);
            __syncthreads();
        }
    }
    if (!TV(2)) {
        const int h = wv;
        LAS h16* Ks = (LAS h16*)(lds + L_KS); LAS h16* Vs = (LAS h16*)(lds + L_VS);
        const LAS float* rb = (const LAS float*)(lds + L_RELB) + h * 224;
        h16x8 qf[2][4];
#pragma unroll
        for (int ct = 0; ct < 2; ++ct)
#pragma unroll
            for (int s = 0; s < 4; ++s) qf[ct][s] = *(const h16x8*)(A.qa + (tokb + 64 * c + 32 * ct + col) * 512 + h * 64 + 16 * s + 8 * hi);
        f32x16 O[2][2]; float mrun[2], lsum[2];
#pragma unroll
        for (int ct = 0; ct < 2; ++ct) { O[ct][0] = (f32x16){}; O[ct][1] = (f32x16){}; mrun[ct] = -1e30f; lsum[ct] = 0.f; }
        const float b15 = rb[160 - 100];
        const bool isK = tid < 256; const int t2 = tid & 255, srow = t2 >> 3, spc = t2 & 7;
        const h16* gsrc = (isK ? A.ka : A.va) + (tokb + srow) * 64 + 8 * spc;
        LAS h16* kdst = Ks + srow * 72 + 8 * spc; LAS h16* vdst = Vs + (8 * spc) * 36 + srow;
#define ATT_STAGE(stage, v) do { if (isK) *(LAS u32x4*)(kdst + (stage) * (32 * 72)) = (v); else { const h16x8 hv_ = __builtin_bit_cast(h16x8, (v)); \
            _Pragma("unroll") for (int e_ = 0; e_ < 8; ++e_) vdst[(stage) * (64 * 36) + e_ * 36] = hv_[e_]; } } while (0)
        u32x4 stg = *(const u32x4*)gsrc;
        ATT_STAGE(0, stg);
        __syncthreads();
        for (int j = 0; j < ntile; ++j) {
            const int st = j & 1;
            if (j + 1 < ntile) stg = *(const u32x4*)(gsrc + (size_t)(j + 1) * (32 * 64));
            const LAS h16* kb = Ks + st * (32 * 72) + col * 72 + 8 * hi;
            h16x8 kf[4];
#pragma unroll
            for (int s = 0; s < 4; ++s) kf[s] = *(const LAS h16x8*)(kb + 16 * s);
            const bool far = j <= 2 * c - 4;
            const LAS h16* vb = Vs + st * (64 * 36) + col * 36 + 4 * hi;
#pragma unroll
            for (int ct = 0; ct < 2; ++ct) {
                f32x16 sa;
#pragma unroll
                for (int r = 0; r < 16; ++r) sa[r] = far ? b15 : 0.f;
#pragma unroll
                for (int s = 0; s < 4; ++s) sa = __builtin_amdgcn_mfma_f32_32x32x16_f16(kf[s], qf[ct][s], sa, 0, 0, 0);
                if (!far) { const int rel0 = 32 * j - (64 * c + 32 * ct + col) + 160 + 4 * hi;
#pragma unroll
                    for (int r = 0; r < 16; ++r) sa[r] += rb[rel0 + (r & 3) + 8 * (r >> 2)]; }
                const unsigned word = maskw[(32 * ct + col) * 65 + j] >> (4 * hi);
#pragma unroll
                for (int r = 0; r < 16; ++r) { const int neg = __builtin_amdgcn_sbfe((int)word, (r & 3) + 8 * (r >> 2), 1);
                    sa[r] = __int_as_float((neg & __float_as_int(sa[r])) | (~neg & (int)0xFF800000)); }
                h16x8 p0, p1;
                softmax_tile(sa, mrun[ct], lsum[ct], O[ct][0], O[ct][1], fb + 32 * ct, lane, hi, p0, p1);
#pragma unroll
                for (int db = 0; db < 2; ++db) {
                    const LAS h16* vp = vb + db * (32 * 36);
                    const h16x4 a0 = *(const LAS h16x4*)(vp), a1 = *(const LAS h16x4*)(vp + 8), c0 = *(const LAS h16x4*)(vp + 16), c1 = *(const LAS h16x4*)(vp + 24);
                    const h16x8 v0 = {a0[0], a0[1], a0[2], a0[3], a1[0], a1[1], a1[2], a1[3]}, v1 = {c0[0], c0[1], c0[2], c0[3], c1[0], c1[1], c1[2], c1[3]};
                    O[ct][db] = __builtin_amdgcn_mfma_f32_32x32x16_f16(p0, v0, O[ct][db], 0, 0, 0);
                    O[ct][db] = __builtin_amdgcn_mfma_f32_32x32x16_f16(p1, v1, O[ct][db], 0, 0, 0);
                }
            }
            if (j + 1 < ntile) ATT_STAGE(st ^ 1, stg);
            __syncthreads();
        }
#pragma unroll
        for (int ct = 0; ct < 2; ++ct) store_o(O[ct][0], O[ct][1], lsum[ct], fb + 32 * ct, lane, hi, A.out, tokb + 64 * c + 32 * ct, h * 64);
    }
    if (!TV(4)) {
        const int qg = wv >> 2, hm = wv & 3; const size_t tok0 = tokb + 64 * c + 32 * qg;
        h16x8 qf[4];
#pragma unroll
        for (int s = 0; s < 4; ++s) qf[s] = *(const h16x8*)(A.qm + (tok0 + col) * 256 + hm * 64 + 16 * s + 8 * hi);
        f32x16 O0 = {}, O1 = {}; float mrun = -1e30f, lsum = 0.f;
        for (int j = 0; j < MEMT / 32; ++j) {
            const h16* kp = A.mk + ((size_t)b * MEMT + 32 * j + col) * 256 + hm * 64 + 8 * hi;
            f32x16 sa = {};
#pragma unroll
            for (int s = 0; s < 4; ++s) sa = __builtin_amdgcn_mfma_f32_32x32x16_f16(*(const h16x8*)(kp + 16 * s), qf[s], sa, 0, 0, 0);
            h16x8 p0, p1;
            softmax_tile(sa, mrun, lsum, O0, O1, fb, lane, hi, p0, p1);
#pragma unroll
            for (int db = 0; db < 2; ++db) {
                const h16* vp = A.mvT + (((size_t)b * 4 + hm) * 64 + 32 * db + col) * MEMT + 32 * j + 4 * hi;
                const h16x4 a0 = *(const h16x4*)(vp), a1 = *(const h16x4*)(vp + 8), c0 = *(const h16x4*)(vp + 16), c1 = *(const h16x4*)(vp + 24);
                const h16x8 v0 = {a0[0], a0[1], a0[2], a0[3], a1[0], a1[1], a1[2], a1[3]}, v1 = {c0[0], c0[1], c0[2], c0[3], c1[0], c1[1], c1[2], c1[3]};
                if (db == 0) { O0 = __builtin_amdgcn_mfma_f32_32x32x16_f16(p0, v0, O0, 0, 0, 0); O0 = __builtin_amdgcn_mfma_f32_32x32x16_f16(p1, v1, O0, 0, 0, 0); }
                else { O1 = __builtin_amdgcn_mfma_f32_32x32x16_f16(p0, v0, O1, 0, 0, 0); O1 = __builtin_amdgcn_mfma_f32_32x32x16_f16(p1, v1, O1, 0, 0, 0); }
            }
        }
        store_o(O0, O1, lsum, fb, lane, hi, A.out, tok0, 512 + hm * 64);
    }
}

__device__ __forceinline__ void build_relb(const float* relb, LAS unsigned char* lds, int tid) {
    LAS float* rb = (LAS float*)(lds + L_RELB);
    for (int e = tid; e < 8 * 224; e += 512) { const int h = e / 224, rel = e % 224 - 160; rb[e] = relb[t5_bucket(rel) * 8 + h] * LOG2E; }
}
}
#ifndef MK_N_LAUNCHES
#define MK_N_LAUNCHES 1
#endif
constexpr int N_PHASES = 12;
constexpr int NWAVES = 8;
constexpr size_t MiB = 1u << 20;
constexpr size_t WS_CTL = 0, CTL_ZERO_BYTES = 1 * MiB;
constexpr size_t WS_W1A = 1 * MiB, WS_W1B = 12 * MiB, WS_WIN = 18 * MiB, WS_WMKV = 27 * MiB, WS_WGLU = 28 * MiB, WS_WOA = 29 * MiB, WS_WOM = 30 * MiB, WS_WOUT = 31 * MiB,
                 WS_W2A = 33 * MiB, WS_W2B = 44 * MiB, WS_TCAT = 50 * MiB, WS_WST = 90 * MiB;
constexpr size_t WS_RSTD0 = 98 * MiB, WS_SSQ1 = 99 * MiB, WS_SSQ2 = 103 * MiB, WS_SSQ3 = 107 * MiB, WS_MEMH = 111 * MiB, WS_MK = 127 * MiB, WS_MVT = 131 * MiB, WS_A64 = 135 * MiB;
constexpr size_t WS_ABUF = 136 * MiB;
constexpr size_t WS_CBUF = 264 * MiB;
constexpr size_t WS_YS = WS_CBUF + 96 * MiB;
constexpr size_t WS_BIG = 392 * MiB;
constexpr size_t WS_QA = WS_BIG, WS_QIDX = WS_BIG + 64 * MiB, WS_QM = WS_BIG + 96 * MiB, WS_OB = WS_BIG  ,
                 WS_KA = WS_BIG + 128 * MiB, WS_VAT = WS_BIG + 136 * MiB, WS_KIDX = WS_BIG + 144 * MiB, WS_WIDX = WS_BIG + 152 * MiB, WS_ACAT = WS_BIG + 153 * MiB, WS_GATES = WS_BIG + 193 * MiB;
constexpr size_t WS_END = WS_GATES + 384 * MiB;
static_assert(WS_END <= 1024 * MiB, "workspace map");
constexpr int CW_BAR = 4096;

constexpr int LDS_BYTES = 163840;
constexpr int MISC_OFF = LDS_BYTES - 256;

#define XB_TMO      128
#define XB_XCNT(j)  (256  + 64 * (j))
#define XB_XSUB(j)  (1280 + 64 * (j))
#define XB_XGEN(j)  (2304 + 64 * (j))
#define XB_TOP      3328
#define XB_TOPGEN   3392
#define XCD_BAR_WORDS 3456
#define XB_SPIN_CAP (1u << 18)
__device__ __forceinline__ unsigned xb_ld(unsigned* p)              { return __hip_atomic_load(p, __ATOMIC_RELAXED, __HIP_MEMORY_SCOPE_AGENT); }
__device__ __forceinline__ unsigned xb_add(unsigned* p, unsigned v) { return __hip_atomic_fetch_add(p, v, __ATOMIC_RELAXED, __HIP_MEMORY_SCOPE_AGENT); }
__device__ __forceinline__ unsigned xb_xcc_id() { return (unsigned)__builtin_amdgcn_s_getreg((3 << 11) | 20) & 0xFu; }
#define XB_SPIN(cond, bar) do { unsigned _sp = 0; while (cond) { __builtin_amdgcn_s_sleep(1); \
    if ((++_sp & 255u) == 0u) { if (xb_ld(&(bar)[XB_TMO])) break; if (_sp > XB_SPIN_CAP) { atomicAdd(&(bar)[XB_TMO], 1u); break; } } } } while (0)
struct XcdBarrier { unsigned* bar; unsigned x; volatile LAS unsigned* st; };
__device__ __forceinline__ XcdBarrier xcd_barrier_post(unsigned* bar, volatile LAS unsigned* st) {
    XcdBarrier b; b.bar = bar; b.x = xb_xcc_id(); b.st = st;
    if (threadIdx.x == 0) (void)xb_add(&bar[XB_XCNT(b.x)], 1u);
    return b;
}
__device__ __forceinline__ void xcd_barrier_complete(unsigned* bar, unsigned x, unsigned& nloc, unsigned& nx) {
    const unsigned G = gridDim.x * gridDim.y * gridDim.z;
    unsigned sum, cnt, mine, sp = 0u;
    for (;;) {
        sum = 0u; cnt = 0u; mine = 0u;
#pragma unroll
        for (unsigned j = 0; j < 16; ++j) { const unsigned c = xb_ld(&bar[XB_XCNT(j)]); sum += c; cnt += (c > 0u) ? 1u : 0u; mine = (j == x) ? c : mine; }
        if (sum == G) break;
        __builtin_amdgcn_s_sleep(1);
        if ((++sp & 255u) == 0u) { if (xb_ld(&bar[XB_TMO])) break; if (sp > XB_SPIN_CAP) { atomicAdd(&bar[XB_TMO], 1u); break; } }
    }
    nloc = mine > 0u ? mine : 1u; nx = cnt > 0u ? cnt : 1u;
}
__device__ __forceinline__ void xcd_barrier(const XcdBarrier& b) {
    asm volatile("s_waitcnt vmcnt(0)" ::: "memory");
    __syncthreads();
    if (threadIdx.x == 0) {
        unsigned* bar = b.bar;
        __builtin_amdgcn_s_waitcnt(0);
        unsigned nloc = b.st[0], nx = b.st[1];
        if (nloc == 0u) { xcd_barrier_complete(bar, b.x, nloc, nx); b.st[0] = nloc; b.st[1] = nx; }
        const unsigned old = xb_add(&bar[XB_XSUB(b.x)], 1u);
        const unsigned gen = old / nloc;
        if (old + 1u == (gen + 1u) * nloc) {
            __builtin_amdgcn_fence(__ATOMIC_RELEASE, "agent");
            asm volatile("s_waitcnt vmcnt(0)" ::: "memory");
            const unsigned og = xb_add(&bar[XB_TOP], 1u);
            const unsigned tg = og / nx;
            if (og + 1u == (tg + 1u) * nx) xb_add(&bar[XB_TOPGEN], 1u);
            else XB_SPIN(xb_ld(&bar[XB_TOPGEN]) == tg, bar);
            __builtin_amdgcn_fence(__ATOMIC_ACQUIRE, "agent");
            xb_add(&bar[XB_XGEN(b.x)], 1u);
            asm volatile("s_waitcnt vmcnt(0)" ::: "memory");
        } else {
            XB_SPIN(xb_ld(&bar[XB_XGEN(b.x)]) == gen, bar);
            __builtin_amdgcn_fence(__ATOMIC_ACQUIRE, "agent");
            asm volatile("s_waitcnt vmcnt(0)" ::: "memory");
        }
    }
    __syncthreads();
}

enum { I_X = 0, I_MEM, I_FFN1_NORM, I_FFN1_WIN, I_FFN1_WOUT, I_MIX_NORM, I_W_IN, I_AQG, I_AKG, I_RELB, I_WOA, I_LRE, I_LIM, I_LOGDT, I_BRE, I_BIM, I_CRE, I_CIM, I_SSMD, I_WGLU,
       I_MEM_NORM, I_WMKV, I_MQG, I_MKG, I_WOM, I_WOUT, I_FFN2_NORM, I_FFN2_WIN, I_FFN2_WOUT, I_FINAL_NORM, N_IN };
struct Args { const float* in[N_IN]; float* out; unsigned char* ws; int ph_lo, ph_hi, variant, pad; };
static_assert(sizeof(Args) == (N_IN + 2) * 8 + 16, "Args has no padding");

__global__ void __launch_bounds__(NWAVES * 64, 2) mega_fwd(Args args) {
    extern __shared__ __attribute__((aligned(16))) unsigned char lds_raw[];
    LAS unsigned char* lds = (LAS unsigned char*)lds_raw;
    volatile LAS unsigned* MISC = (volatile LAS unsigned*)(lds + MISC_OFF);
    const int tid = threadIdx.x, lane = tid & 63, wave = __builtin_amdgcn_readfirstlane(tid >> 6);
    const int G = gridDim.x; const int bx = blockIdx.x; const int vcu = (G % 8 == 0) ? (bx % 8) * (G / 8) + bx / 8 : bx;
    unsigned char* ws = args.ws;
    unsigned* ctl = (unsigned*)(ws + WS_CTL);
    for (int u = tid; u < 64; u += NWAVES * 64) MISC[u] = 0u;
    __syncthreads();
    const int lo = args.ph_lo, hi = args.ph_hi;
    XcdBarrier bar; bar.bar = ctl + CW_BAR; bar.x = 0; bar.st = nullptr;
    if (hi - lo > 1) bar = xcd_barrier_post(ctl + CW_BAR, MISC + 8);
#ifdef ONLY_PHASE
#define IN(k) ((k) == ONLY_PHASE && lo <= (k) && (k) < hi)
#else
#define IN(k) (lo <= (k) && (k) < hi)
#endif
#define SEAM(k) do { if (IN(k) && IN((k) + 1)) xcd_barrier(bar); } while (0)

    const float* x = args.in[I_X]; float* xres = args.out;
    h16* W1A = (h16*)(ws + WS_W1A); h16* W1B = (h16*)(ws + WS_W1B); h16* WIN = (h16*)(ws + WS_WIN); h16* WMKV = (h16*)(ws + WS_WMKV); h16* WGLU = (h16*)(ws + WS_WGLU);
    h16* WOA = (h16*)(ws + WS_WOA); h16* WOM = (h16*)(ws + WS_WOM); h16* WOUT = (h16*)(ws + WS_WOUT); h16* W2A = (h16*)(ws + WS_W2A); h16* W2B = (h16*)(ws + WS_W2B);
    h16* TCAT = (h16*)(ws + WS_TCAT); h16* WST = (h16*)(ws + WS_WST);
    float* rstd0 = (float*)(ws + WS_RSTD0); float* ssq1 = (float*)(ws + WS_SSQ1); float* ssq2 = (float*)(ws + WS_SSQ2); float* ssq3 = (float*)(ws + WS_SSQ3);
    h16* memh = (h16*)(ws + WS_MEMH); h16* mk = (h16*)(ws + WS_MK); h16* mvT = (h16*)(ws + WS_MVT); float* a64 = (float*)(ws + WS_A64);
    h16* abuf = (h16*)(ws + WS_ABUF); h16* acatt = (h16*)(ws + WS_CBUF); h16* ys = (h16*)(ws + WS_YS); h16* x2h = (h16*)(ws + WS_CBUF);
    h16* hidden = (h16*)(ws + WS_BIG); h16* qa = (h16*)(ws + WS_QA); h16* qidx = (h16*)(ws + WS_QIDX); h16* qm = (h16*)(ws + WS_QM); h16* ob = (h16*)(ws + WS_OB);
    h16* ka = (h16*)(ws + WS_KA); h16* va = (h16*)(ws + WS_VAT); h16* kidx = (h16*)(ws + WS_KIDX); float* widx = (float*)(ws + WS_WIDX); h16* acat = (h16*)(ws + WS_ACAT); h16* gates = (h16*)(ws + WS_GATES);

    if (IN(0)) {
        const int gw = vcu * NWAVES + wave, NGW = G * NWAVES;
        LAS float* scr = (LAS float*)(lds + wave * 16384);
        pro::WPtrs WP{args.in[I_FFN1_WIN], args.in[I_FFN1_WOUT], args.in[I_W_IN], args.in[I_WMKV], args.in[I_WGLU], args.in[I_WOA], args.in[I_WOM], args.in[I_WOUT], args.in[I_FFN2_WIN], args.in[I_FFN2_WOUT],
                      args.in[I_FFN1_NORM], args.in[I_MIX_NORM], args.in[I_FFN2_NORM], W1A, W1B, WIN, WMKV, WGLU, WOA, WOM, WOUT, W2A, W2B};
        for (int it = gw; it < pro::IT_TOTAL; it += NGW) pro::weight_item(WP, it, scr, lane);
        for (int m = gw; m < MTOK; m += NGW) { const float r = pro::row_to_h16(x + (size_t)m * DM, abuf + (size_t)m * DM, nullptr, lane); if (lane == 0) rstd0[m] = r; }
        for (int m = gw; m < BATCH * MEMT; m += NGW) (void)pro::row_to_h16(args.in[I_MEM] + (size_t)m * DM, memh + (size_t)m * DM, args.in[I_MEM_NORM], lane);
        pro::S5In SI{args.in[I_LRE], args.in[I_LIM], args.in[I_LOGDT], args.in[I_BRE], args.in[I_BIM], args.in[I_CRE], args.in[I_CIM], args.in[I_SSMD]};
        for (int it = vcu; it < 16 * 64; it += G) pro::s5_item(SI, it >> 6, it & 63, TCAT, WST, a64, (LAS float*)lds, tid);
        __syncthreads();
    }
    SEAM(0);
    if (IN(1)) {
        pg8::Gemm g{abuf, W1A, 1024, 1024, 1024}; pg8::StaticOrder S; S.init(MTOK, 2 * FFN, G, bx);
        epi::EpiSwiglu<0> E{hidden, rstd0};
        pg8::gemm_phase<epi::EpiSwiglu<0>, pg8::StaticOrder, true, true>(lds, g, S, E);
    }
    SEAM(1);
    if (IN(2)) {
        { pg8::Gemm g{hidden, W1B, FFN, FFN, FFN}; pg8::StaticOrder S; S.init(MTOK, DM, G, bx);
          epi::EpiResid E{x, xres, abuf, ssq1, 0.5f};
          pg8::gemm_phase<epi::EpiResid, pg8::StaticOrder, true, true>(lds, g, S, E); }
        { pg8::Gemm g{memh, WMKV, 1024, 1024, 1024}; pg8::StaticOrder S; S.init(BATCH * MEMT, 512, G, bx);
          epi::EpiMemKV E{args.in[I_MKG], mk, mvT};
          pg8::gemm_phase<epi::EpiMemKV, pg8::StaticOrder, true, true>(lds, g, S, E); }
    }
    SEAM(2);
    if (IN(3)) {
        pg8::Gemm g{abuf, WIN, 1024, 1024, 1024}; pg8::StaticOrder S; S.init(MTOK, NWIN, G, bx);
        epi::EpiWin E{ssq1, args.in[I_AQG], args.in[I_AKG], args.in[I_MQG], qa, ka, va, qidx, kidx, acat, qm, gates, widx};
        pg8::gemm_phase<epi::EpiWin, pg8::StaticOrder, true, true>(lds, g, S, E);
    }
    SEAM(3);
    if (IN(4)) {
        const int variant = args.variant;
        if (!TV(8)) { pg8::Gemm g{acat, WST, 1024, 1280, 1024}; pg8::DiagOrder S; S.init(16, 4, 1, G, bx);
          epi::EpiS5State E{args.in[I_LOGDT], a64, acat};
          pg8::gemm_phase<epi::EpiS5State, pg8::DiagOrder, false, true>(lds, g, S, E); }
        __syncthreads();
        att::build_relb(args.in[I_RELB], lds, tid);
        att::P AP{qa, ka, va, qidx, kidx, qm, mk, mvT, widx, args.in[I_RELB], variant ? abuf : acatt};
        if (G == 256) {
            const int b = vcu >> 3, s = vcu & 7;
            for (int i = 0; i < 4; ++i) { const int c = i == 0 ? s : i == 1 ? 31 - s : i == 2 ? 8 + s : 23 - s; att::attn_unit(AP, b, c, lds, tid, variant); }
        } else {
            for (int u = vcu; u < BATCH * 32; u += G) att::attn_unit(AP, u >> 5, u & 31, lds, tid, variant);
        }
        __syncthreads();
    }
    SEAM(4);
    if (IN(5)) {
        pg8::Gemm g{acat, TCAT, 1280, 1280, 1280}; pg8::DiagOrder S; S.init(16, 4, 4, G, bx);
        epi::EpiS5Main E{args.in[I_LOGDT], ys};
        pg8::gemm_phase<epi::EpiS5Main, pg8::DiagOrder, true, true>(lds, g, S, E);
    }
    SEAM(5);
    if (IN(6)) {
        pg8::Gemm g{ys, WGLU, 256, 256, 256}; pg8::StaticOrder S; S.init(MTOK, 2048, G, bx);
        epi::EpiGlu E{ob};
        pg8::gemm_phase<epi::EpiGlu, pg8::StaticOrder, true, true>(lds, g, S, E);
    }
    SEAM(6);
    if (IN(7)) {
        { pg8::Gemm g{acatt, WOA, 512, 768, 512}; pg8::StaticOrder S; S.init(MTOK, DM, G, bx);
          epi::EpiMerge<0> E{gates, ob, abuf};
          pg8::gemm_phase<epi::EpiMerge<0>, pg8::StaticOrder, true, true>(lds, g, S, E); }
        { pg8::Gemm g{acatt + 512, WOM, 256, 768, 256}; pg8::StaticOrder S; S.init(MTOK, DM, G, bx);
          epi::EpiMerge<1> E{gates, ob, abuf};
          pg8::gemm_phase<epi::EpiMerge<1>, pg8::StaticOrder, true, true>(lds, g, S, E); }
    }
    SEAM(7);
    if (IN(8)) {
        pg8::Gemm g{abuf, WOUT, 1024, 1024, 1024}; pg8::StaticOrder S; S.init(MTOK, DM, G, bx);
        epi::EpiResid E{xres, xres, x2h, ssq2, 1.0f};
        pg8::gemm_phase<epi::EpiResid, pg8::StaticOrder, true, true>(lds, g, S, E);
    }
    SEAM(8);
    if (IN(9)) {
        pg8::Gemm g{x2h, W2A, 1024, 1024, 1024}; pg8::StaticOrder S; S.init(MTOK, 2 * FFN, G, bx);
        epi::EpiSwiglu<1> E{hidden, ssq2};
        pg8::gemm_phase<epi::EpiSwiglu<1>, pg8::StaticOrder, true, true>(lds, g, S, E);
    }
    SEAM(9);
    if (IN(10)) {
        pg8::Gemm g{hidden, W2B, FFN, FFN, FFN}; pg8::StaticOrder S; S.init(MTOK, DM, G, bx);
        epi::EpiResid E{xres, xres, nullptr, ssq3, 0.5f};
        pg8::gemm_phase<epi::EpiResid, pg8::StaticOrder, true, true>(lds, g, S, E);
    }
    SEAM(10);
    if (IN(11)) {
        const int gw = vcu * NWAVES + wave, NGW = G * NWAVES; const float* fg = args.in[I_FINAL_NORM];
        for (int m = gw; m < MTOK; m += NGW) {
            const float rs = epi::rstd_from_ssq(ssq3, m);
            f32x4* p = (f32x4*)(xres + (size_t)m * DM) + lane;
#pragma unroll
            for (int j = 0; j < 4; ++j) { const f32x4 gv = ((const f32x4*)fg)[lane + 64 * j]; p[64 * j] = p[64 * j] * rs * gv; }
        }
    }
#undef IN
#undef SEAM
}

#ifndef DBG_TOL
#define DBG_TOL 0.03f
#endif
extern "C" void kernel_launch(void* const* d_in, const int* in_sizes, int n_in, void* d_out, int out_size, void* d_ws, size_t ws_size, hipStream_t stream) {
    static int grid = 0;
    if (grid == 0) {
        if (n_in != N_IN || in_sizes[0] != MTOK * DM || out_size != MTOK * DM || ws_size < WS_END) { fprintf(stderr, "kernel_launch: unexpected shapes (n_in %d, ws %zu)\n", n_in, ws_size); grid = -1; return; }
        int dev = 0, cus = 0, per_cu = 0;
        if (hipGetDevice(&dev) != hipSuccess || hipDeviceGetAttribute(&cus, hipDeviceAttributeMultiprocessorCount, dev) != hipSuccess) { grid = -1; return; }
        if (hipFuncSetAttribute((const void*)mega_fwd, hipFuncAttributeMaxDynamicSharedMemorySize, LDS_BYTES) != hipSuccess) { fprintf(stderr, "kernel_launch: hipFuncSetAttribute failed\n"); grid = -1; return; }
        if (hipOccupancyMaxActiveBlocksPerMultiprocessor(&per_cu, (const void*)mega_fwd, NWAVES * 64, LDS_BYTES) != hipSuccess || per_cu < 1) fprintf(stderr, "kernel_launch: occupancy query reports %d\n", per_cu);
        (void)hipGetLastError();
        grid = cus;
    }
    if (grid < 0) return;
    (void)hipMemsetAsync((char*)d_ws + WS_CTL, 0, CTL_ZERO_BYTES, stream);
    Args a{};
    for (int i = 0; i < N_IN; ++i) a.in[i] = (const float*)d_in[i];
    a.out = (float*)d_out; a.ws = (unsigned char*)d_ws;
#if MK_N_LAUNCHES == 1
    a.ph_lo = 0; a.ph_hi = N_PHASES;
    hipLaunchKernelGGL(mega_fwd, dim3(grid), dim3(NWAVES * 64), LDS_BYTES, stream, a);
#else
    for (int p = 0; p < N_PHASES; ++p) { a.ph_lo = p; a.ph_hi = p + 1; hipLaunchKernelGGL(mega_fwd, dim3(grid), dim3(NWAVES * 64), LDS_BYTES, stream, a);
#ifdef REP_PHASE
        if (p == REP_PHASE) for (int rep_ = 1; rep_ < REP_COUNT; ++rep_) { Args a2 = a;
#ifdef TIMING_VARIANT
            a2.variant = TIMING_VARIANT;
#endif
            hipLaunchKernelGGL(mega_fwd, dim3(grid), dim3(NWAVES * 64), LDS_BYTES, stream, a2); }
#endif
#ifdef DBG_CHECK
        unsigned char* ws = (unsigned char*)d_ws; unsigned* ctl = (unsigned*)ws; const float* const* in = a.in; float* out = (float*)d_out;
        dbg::ProjBufs PB{(h16*)(ws + WS_QA), (h16*)(ws + WS_KA), (h16*)(ws + WS_VAT), (h16*)(ws + WS_QIDX), (h16*)(ws + WS_KIDX), (h16*)(ws + WS_ACAT), (h16*)(ws + WS_QM), (h16*)(ws + WS_GATES), (float*)(ws + WS_WIDX)};
        if (p == 2) { hipLaunchKernelGGL(dbg::chk_ffn, dim3(8), dim3(256), 0, stream, in[I_X], in[I_FFN1_NORM], in[I_FFN1_WIN], in[I_FFN1_WOUT], (const float*)out, ctl, 1);
                      hipLaunchKernelGGL(dbg::chk_memkv, dim3(4), dim3(256), 0, stream, in[I_MEM], in[I_MEM_NORM], in[I_WMKV], in[I_MKG], (const h16*)(ws + WS_MK), (const h16*)(ws + WS_MVT), ctl); }
        if (p == 3) hipLaunchKernelGGL(dbg::chk_proj, dim3(4), dim3(256), 0, stream, (const float*)out, in[I_MIX_NORM], in[I_W_IN], in[I_AQG], in[I_AKG], in[I_MQG], PB, ctl);
        if (p == 4) { hipLaunchKernelGGL(dbg::chk_attn, dim3(8), dim3(256), 0, stream, PB, in[I_RELB], (const h16*)(ws + WS_CBUF), ctl);
                      hipLaunchKernelGGL(dbg::chk_mem, dim3(8), dim3(256), 0, stream, (const h16*)(ws + WS_QM), (const h16*)(ws + WS_MK), (const h16*)(ws + WS_MVT), (const h16*)(ws + WS_CBUF), ctl); }
        if (p == 5) hipLaunchKernelGGL(dbg::chk_s5, dim3(8), dim3(64), 0, stream, (const h16*)(ws + WS_ACAT), in[I_LRE], in[I_LIM], in[I_LOGDT], in[I_BRE], in[I_BIM], in[I_CRE], in[I_CIM], in[I_SSMD], (const h16*)(ws + WS_YS), ctl);
        if (p == 6) hipLaunchKernelGGL(dbg::chk_glu, dim3(4), dim3(256), 0, stream, (const h16*)(ws + WS_YS), in[I_WGLU], (const h16*)(ws + WS_OB), ctl);
        if (p == 7) hipLaunchKernelGGL(dbg::chk_merge, dim3(8), dim3(256), 0, stream, (const h16*)(ws + WS_CBUF), (const h16*)(ws + WS_OB), (const h16*)(ws + WS_GATES), in[I_WOA], in[I_WOM], (const h16*)(ws + WS_ABUF), (const float*)out, in[I_WOUT], ctl);
        if (p == 8) hipLaunchKernelGGL(dbg::chk_x2, dim3(8), dim3(256), 0, stream, (const float*)out, ctl);
        if (p == N_PHASES - 1) hipLaunchKernelGGL(dbg::chk_report, dim3(1024), dim3(256), 0, stream, out, ctl, DBG_TOL);
#endif
    }
#endif
}
```

```cpp
#define MK_N_LAUNCHES 1
#include <hip/hip_runtime.h>
#include <cstdio>
#include <cstdint>

#define GAS __attribute__((address_space(1)))
#define LAS __attribute__((address_space(3)))
typedef _Float16 h16;
typedef _Float16 h16x8 __attribute__((ext_vector_type(8)));
typedef _Float16 h16x4 __attribute__((ext_vector_type(4)));
typedef _Float16 h16x2 __attribute__((ext_vector_type(2)));
typedef float f32x2 __attribute__((ext_vector_type(2)));
typedef float f32x4 __attribute__((ext_vector_type(4)));
typedef float f32x16 __attribute__((ext_vector_type(16)));
typedef unsigned u32x4 __attribute__((ext_vector_type(4)));
typedef unsigned u32x2 __attribute__((ext_vector_type(2)));

constexpr int BATCH = 32, SEQ = 2048, DM = 1024, MTOK = BATCH * SEQ, FFN = 2816;
constexpr int NWIN = 4608;
constexpr int MEMT = 256;
constexpr float NORM_EPS = 1e-6f;
constexpr float LOG2E = 1.4426950408889634f;

__device__ __forceinline__ unsigned pk2h(float lo, float hi) { f32x2 v = {lo, hi}; h16x2 p = __builtin_convertvector(v, h16x2); return __builtin_bit_cast(unsigned, p); }
__device__ __forceinline__ u32x4 pk8h(f32x4 a, f32x4 b) { u32x4 w; w.x = pk2h(a[0], a[1]); w.y = pk2h(a[2], a[3]); w.z = pk2h(b[0], b[1]); w.w = pk2h(b[2], b[3]); return w; }
__device__ __forceinline__ void unpk8h(u32x4 w, f32x4& a, f32x4& b) {
    h16x8 h = __builtin_bit_cast(h16x8, w);
    a = (f32x4){(float)h[0], (float)h[1], (float)h[2], (float)h[3]}; b = (f32x4){(float)h[4], (float)h[5], (float)h[6], (float)h[7]};
}
__device__ __forceinline__ float fast_sigmoid(float x) { return __builtin_amdgcn_rcpf(1.0f + __builtin_amdgcn_exp2f(-x * LOG2E)); }

namespace pg8 {
constexpr int BM = 256, BK = 64, HALF = 128, HTB = HALF * BK * 2  , STAGE_BYTES = 8 * HTB, NXCD = 8, WGM = 8;

__host__ __device__ __forceinline__ int lds_byte(int r, int c) { const int st = (r >> 4) * 2 + (c >> 5), rr = r & 15, cc = c & 31, ob = rr * 64 + cc * 2; return st * 1024 + (ob ^ (((ob >> 9) & 1) << 5)); }
__host__ __device__ __forceinline__ void stage_rc(int b, int& R, int& C) { const int st = b / 1024, sb = b % 1024, swz = sb ^ (((sb >> 9) & 1) << 5); R = (st >> 1) * 16 + swz / 64; C = (st & 1) * 32 + (swz % 64) / 2; }

struct Unit { int pm, pn; };
struct Gemm { const h16* A; const h16* Bt; int K, lda, ldb; };

struct StaticOrder {
    int nM, nN, nwg, G, c;
    __host__ __device__ void init(int M, int N, int G_, int c_) { nM = M / BM; nN = N / BM; nwg = nM * nN; G = G_; c = c_; }
    __host__ __device__ bool next(int i, Unit& u) const {
        const long L = (long)i * G + c; if (L >= nwg) return false;
        int wgid = (int)L; { const int q = nwg / NXCD, r = nwg % NXCD, xcd = wgid % NXCD, off = wgid / NXCD; wgid = (xcd < r ? xcd * (q + 1) : r * (q + 1) + (xcd - r) * q) + off; }
        const int nig = WGM * nN, gid = wgid / nig, fm = gid * WGM, gsz = (nM - fm) < WGM ? (nM - fm) : WGM;
        u.pm = fm + ((wgid % nig) % gsz); u.pn = (wgid % nig) / gsz; return true;
    }
};
struct DiagOrder {
    int tm, tn, ng, G, c;
    __host__ __device__ void init(int ng_, int tm_, int tn_, int G_, int c_) { ng = ng_; tm = tm_; tn = tn_; G = G_; c = c_; }
    __host__ __device__ bool next(int i, Unit& u) const {
        const long L = (long)i * G + c; if (L >= (long)ng * tm * tn) return false;
        const int per = tm * tn, g = (int)L / per, r = (int)L % per;
        u.pm = g * tm + r / tn; u.pn = g * tn + r % tn; return true;
    }
};

template <class Epi, class Sched, bool ALIGN_EPI = false, bool SP2 = false, bool TWO = false>
__device__ __forceinline__ void gemm_phase(LAS unsigned char* lds, const Gemm g, const Sched& S, const Epi& E, const Gemm g2 = Gemm{nullptr, nullptr, 0, 0, 0}) {
    const int tid = threadIdx.x, wid = __builtin_amdgcn_readfirstlane(tid >> 6), lane = tid & 63, wr = wid >> 2, wc = wid & 3, fr = lane & 15, fq = lane >> 4;
    const int nt0 = g.K / BK, nt1 = TWO ? g2.K / BK : nt0;
    unsigned voffA[2], voffB0[2], voffB1[2];
#pragma unroll
    for (int i = 0; i < 2; ++i) { int R, C; stage_rc(tid * 16 + i * 8192, R, C);
        voffA[i] = (unsigned)(R * g.lda + C) * 2u; voffB0[i] = (unsigned)(R * g.ldb + C) * 2u; voffB1[i] = TWO ? (unsigned)(R * g2.ldb + C) * 2u : voffB0[i]; }
    const size_t kstep = (size_t)(BK * 2);
    const size_t hstepA = (size_t)HALF * g.lda * 2, hstepB0 = (size_t)HALF * g.ldb * 2, hstepB1 = TWO ? (size_t)HALF * g2.ldb * 2 : hstepB0;
    const size_t tstepA = 2 * hstepA;
#define PG8_NEXT(i, u, part) (TWO ? ((part) = (i) & 1, S.next((i) >> 1, (u))) : ((part) = 0, S.next((i), (u))))
#define PG8_ABASE(u, part) ((const char*)((TWO && (part)) ? g2.A : g.A) + (size_t)(u).pm * tstepA)
#define PG8_BBASE(u, part) ((TWO && (part)) ? (const char*)g2.Bt + (size_t)(u).pn * 2 * hstepB1 : (const char*)g.Bt + (size_t)(u).pn * 2 * hstepB0)
    const unsigned ldsw = (unsigned)wid * 1024u;
    const int aoff = lds_byte(wr * 64 + fr, fq * 8), boff = lds_byte(wc * 32 + fr, fq * 8);
#define PG8_SA(b, h) (((b) * 2 + (h)) * HTB)
#define PG8_SB(b, h) ((4 + (b) * 2 + (h)) * HTB)
#define PG8_STAGE(bufoff, gbase, voff) do { _Pragma("unroll") for (int _i = 0; _i < 2; ++_i) \
        __builtin_amdgcn_global_load_lds((const unsigned*)((const char*)(gbase) + (voff)[_i]), (LAS unsigned*)(lds + (bufoff) + ldsw + _i * 8192), 16, 0, 0); } while (0)
#define PG8_LDA(dst, b, h) do { _Pragma("unroll") for (int m = 0; m < 4; ++m) _Pragma("unroll") for (int k = 0; k < 2; ++k) dst[m][k] = *(const LAS h16x8*)(lds + PG8_SA(b, h) + aoff + m * 2048 + k * 1024); } while (0)
#define PG8_LDB(dst, b, h) do { _Pragma("unroll") for (int n = 0; n < 2; ++n) _Pragma("unroll") for (int k = 0; k < 2; ++k) dst[n][k] = *(const LAS h16x8*)(lds + PG8_SB(b, h) + boff + n * 2048 + k * 1024); } while (0)
#define PG8_MMA(ai, bj, At, Bt) do { __builtin_amdgcn_s_setprio(1); _Pragma("unroll") for (int m = 0; m < 4; ++m) _Pragma("unroll") for (int n = 0; n < 2; ++n) _Pragma("unroll") for (int k = 0; k < 2; ++k) \
        acc[ai][bj][m][n] = __builtin_amdgcn_mfma_f32_16x16x32_f16(Bt[n][k], At[m][k], acc[ai][bj][m][n], 0, 0, 0); __builtin_amdgcn_s_setprio(0); } while (0)
#define PG8_WAIT_V(n) asm volatile("s_waitcnt vmcnt(" #n ")" ::: "memory")
#define PG8_WAIT_L(n) asm volatile("s_waitcnt lgkmcnt(" #n ")" ::: "memory")
#define PG8_BAR __builtin_amdgcn_s_barrier()
#define PG8_SCHED __builtin_amdgcn_sched_barrier(0)
    Unit cur, nxt; int ui = 0, pcur = 0, pnxt = 0;
    if (!PG8_NEXT(0, cur, pcur)) return;
    f32x4 acc[2][2][4][2];
#pragma unroll
    for (int a = 0; a < 2; ++a)
#pragma unroll
        for (int b = 0; b < 2; ++b)
#pragma unroll
            for (int m = 0; m < 4; ++m)
#pragma unroll
                for (int n = 0; n < 2; ++n) acc[a][b][m][n] = (f32x4){0.f, 0.f, 0.f, 0.f};
    h16x8 At[4][2], B0[2][2], B1[2][2];
    const char* cA = PG8_ABASE(cur, pcur); const char* cB = PG8_BBASE(cur, pcur);
    unsigned voffB[2] = {voffB0[0], voffB0[1]}; size_t hstepB = hstepB0;
    if constexpr (SP2) {
        PG8_STAGE(PG8_SB(0, 0), cB, voffB); PG8_STAGE(PG8_SB(0, 1), cB + hstepB, voffB); PG8_STAGE(PG8_SA(0, 0), cA, voffA); PG8_STAGE(PG8_SA(0, 1), cA + hstepA, voffA);
        if (wr == 1) PG8_BAR;
        PG8_WAIT_V(2); PG8_BAR;
        PG8_STAGE(PG8_SB(1, 0), cB + kstep, voffB); PG8_STAGE(PG8_SA(1, 0), cA + kstep, voffA); PG8_STAGE(PG8_SB(1, 1), cB + hstepB + kstep, voffB);
        PG8_WAIT_V(6); PG8_BAR;
    } else {
        PG8_STAGE(PG8_SB(0, 0), cB, voffB); PG8_STAGE(PG8_SA(0, 0), cA, voffA); PG8_STAGE(PG8_SB(0, 1), cB + hstepB, voffB); PG8_STAGE(PG8_SA(0, 1), cA + hstepA, voffA);
        if (wr == 1) PG8_BAR;
        PG8_WAIT_V(4); PG8_BAR;
        PG8_STAGE(PG8_SB(1, 0), cB + kstep, voffB); PG8_STAGE(PG8_SA(1, 0), cA + kstep, voffA); PG8_STAGE(PG8_SB(1, 1), cB + hstepB + kstep, voffB);
        PG8_WAIT_V(6); PG8_BAR;
    }
    for (;;) {
        const bool has_next = PG8_NEXT(ui + 1, nxt, pnxt);
        const char* nA = has_next ? PG8_ABASE(nxt, pnxt) : cA; const char* nB = has_next ? PG8_BBASE(nxt, pnxt) : cB;
        const int nt = pcur ? nt1 : nt0;
        const unsigned vBc0 = voffB[0], vBc1 = voffB[1]; const size_t hBc = hstepB;
        const bool np1 = has_next ? (pnxt != 0) : (pcur != 0);
        const unsigned vBn0 = np1 ? voffB1[0] : voffB0[0], vBn1 = np1 ? voffB1[1] : voffB0[1]; const size_t hBn = np1 ? hstepB1 : hstepB0;
#pragma unroll 1
        for (int t = 0; t < nt; t += 2) {
            const bool last = (t == nt - 2);
            const char* a1 = cA + (size_t)(t + 1) * kstep;
            const char* a2 = last ? nA : cA + (size_t)(t + 2) * kstep; const char* b2 = last ? nB : cB + (size_t)(t + 2) * kstep;
            const char* a3 = a2 + kstep; const char* b3 = b2 + kstep;
            if constexpr (TWO) { voffB[0] = last ? vBn0 : vBc0; voffB[1] = last ? vBn1 : vBc1; hstepB = last ? hBn : hBc; }
            if constexpr (SP2) {
            PG8_LDB(B0, 0, 0); PG8_LDB(B1, 0, 1); PG8_SCHED; PG8_LDA(At, 0, 0); PG8_STAGE(PG8_SA(1, 1), a1 + hstepA, voffA);
            PG8_WAIT_V(8); PG8_WAIT_L(0); PG8_BAR; PG8_MMA(0, 0, At, B0); PG8_MMA(0, 1, At, B1); PG8_BAR; PG8_SCHED;
            PG8_LDA(At, 0, 1); PG8_STAGE(PG8_SB(0, 0), b2, voffB); PG8_STAGE(PG8_SB(0, 1), b2 + hstepB, voffB); PG8_STAGE(PG8_SA(0, 0), a2, voffA);
            PG8_WAIT_V(8); PG8_WAIT_L(0); PG8_BAR; PG8_MMA(1, 0, At, B0); PG8_MMA(1, 1, At, B1); PG8_BAR; PG8_SCHED;
            PG8_LDB(B0, 1, 0); PG8_LDB(B1, 1, 1); PG8_SCHED; PG8_LDA(At, 1, 0); PG8_STAGE(PG8_SA(0, 1), a2 + hstepA, voffA);
            PG8_WAIT_V(8); PG8_WAIT_L(0); PG8_BAR; PG8_MMA(0, 0, At, B0); PG8_MMA(0, 1, At, B1); PG8_BAR; PG8_SCHED;
            PG8_LDA(At, 1, 1); PG8_STAGE(PG8_SB(1, 0), b3, voffB); PG8_STAGE(PG8_SB(1, 1), b3 + hstepB, voffB); PG8_STAGE(PG8_SA(1, 0), a3, voffA);
            PG8_WAIT_V(8); PG8_WAIT_L(0); PG8_BAR; PG8_MMA(1, 0, At, B0); PG8_MMA(1, 1, At, B1); PG8_BAR; PG8_SCHED;
            } else {
            PG8_LDB(B0, 0, 0); PG8_SCHED; PG8_LDA(At, 0, 0); PG8_STAGE(PG8_SA(1, 1), a1 + hstepA, voffA);
            PG8_WAIT_L(8); PG8_BAR; PG8_WAIT_L(0); PG8_MMA(0, 0, At, B0); PG8_BAR; PG8_SCHED;
            PG8_LDB(B1, 0, 1); PG8_STAGE(PG8_SB(0, 0), b2, voffB);
            PG8_BAR; PG8_WAIT_L(0); PG8_MMA(0, 1, At, B1); PG8_BAR;
            PG8_LDA(At, 0, 1); PG8_STAGE(PG8_SA(0, 0), a2, voffA);
            PG8_BAR; PG8_WAIT_L(0); PG8_MMA(1, 0, At, B0); PG8_BAR; PG8_SCHED;
            PG8_STAGE(PG8_SB(0, 1), b2 + hstepB, voffB);
            PG8_WAIT_V(6); PG8_BAR; PG8_MMA(1, 1, At, B1); PG8_BAR;
            PG8_LDB(B0, 1, 0); PG8_SCHED; PG8_LDA(At, 1, 0); PG8_STAGE(PG8_SA(0, 1), a2 + hstepA, voffA);
            PG8_WAIT_L(8); PG8_BAR; PG8_WAIT_L(0); PG8_MMA(0, 0, At, B0); PG8_BAR; PG8_SCHED;
            PG8_LDB(B1, 1, 1); PG8_STAGE(PG8_SB(1, 0), b3, voffB);
            PG8_BAR; PG8_WAIT_L(0); PG8_MMA(0, 1, At, B1); PG8_BAR;
            PG8_LDA(At, 1, 1); PG8_STAGE(PG8_SA(1, 0), a3, voffA);
            PG8_BAR; PG8_WAIT_L(0); PG8_MMA(1, 0, At, B0); PG8_BAR; PG8_SCHED;
            PG8_STAGE(PG8_SB(1, 1), b3 + hstepB, voffB);
            PG8_WAIT_V(6); PG8_BAR; PG8_MMA(1, 1, At, B1); PG8_BAR;
            }
        }
        if constexpr (ALIGN_EPI) { if (wr == 0) PG8_BAR; }
        bool zero = true;
        if constexpr (TWO) { if (pcur == 0) { E.mid(acc, cur, wr, wc, fr, fq); zero = false; } else E(acc, cur, wr, wc, fr, fq); }
        else if constexpr (!Epi::AFTER_DRAIN) { E(acc, cur, wr, wc, fr, fq); }
        if (!has_next) break;
        if (zero) {
#pragma unroll
        for (int a = 0; a < 2; ++a)
#pragma unroll
            for (int b = 0; b < 2; ++b)
#pragma unroll
                for (int m = 0; m < 4; ++m)
#pragma unroll
                    for (int n = 0; n < 2; ++n) acc[a][b][m][n] = (f32x4){0.f, 0.f, 0.f, 0.f};
        }
        cur = nxt; pcur = pnxt; cA = nA; cB = nB; ++ui;
        if constexpr (TWO) { voffB[0] = vBn0; voffB[1] = vBn1; hstepB = hBn; }
        if constexpr (ALIGN_EPI) { if (wr == 1) PG8_BAR; }
    }
    PG8_WAIT_V(0);
    if constexpr (!ALIGN_EPI) { if (wr == 0) PG8_BAR; }
    PG8_BAR;
    if constexpr (Epi::AFTER_DRAIN) { E.fused(acc, cur, wr, wc, fr, fq, lds); }
#undef PG8_NEXT
#undef PG8_ABASE
#undef PG8_BBASE
#undef PG8_SA
#undef PG8_SB
#undef PG8_STAGE
#undef PG8_LDA
#undef PG8_LDB
#undef PG8_MMA
#undef PG8_WAIT_V
#undef PG8_WAIT_L
#undef PG8_BAR
#undef PG8_SCHED
}
}
namespace epi {
using pg8::Unit;
typedef f32x4 Acc[2][2][4][2];

__device__ __forceinline__ float quad16(float s) {
    auto a = __builtin_amdgcn_permlane16_swap(__float_as_uint(s), __float_as_uint(s), false, false); s = __uint_as_float(a[0]) + __uint_as_float(a[1]);
    auto b = __builtin_amdgcn_permlane32_swap(__float_as_uint(s), __float_as_uint(s), false, false); return __uint_as_float(b[0]) + __uint_as_float(b[1]);
}

__device__ __forceinline__ float rstd_from_ssq(const float* ssq, int r) {
    const f32x4* p = (const f32x4*)(ssq + (size_t)r * 16); const f32x4 a = p[0], b = p[1], c = p[2], d = p[3];
    const float s = ((a[0] + a[1]) + (a[2] + a[3])) + ((b[0] + b[1]) + (b[2] + b[3])) + ((c[0] + c[1]) + (c[2] + c[3])) + ((d[0] + d[1]) + (d[2] + d[3]));
    return __builtin_amdgcn_rsqf(s * (1.0f / DM) + NORM_EPS);
}
__device__ __forceinline__ float rstd_from_sum(const float* ssum, int r) { return __builtin_amdgcn_rsqf(ssum[r] * (1.0f / DM) + NORM_EPS); }
__device__ __forceinline__ float rstd_from_ssq_q(const float* ssq, int r, int fq) {
    const f32x4 a = ((const f32x4*)(ssq + (size_t)r * 16))[fq];
    const float s = quad16((a[0] + a[1]) + (a[2] + a[3]));
    return __builtin_amdgcn_rsqf(s * (1.0f / DM) + NORM_EPS);
}
template <int SRC  > struct EpiSwiglu {
    static constexpr bool AFTER_DRAIN = false;
    h16* H; const float* rsrc;
    __device__ __forceinline__ void operator()(const Acc& acc, const Unit& u, int wr, int wc, int fr, int fq) const {
        const int row0 = u.pm * 256 + wr * 64 + fr, col = u.pn * 128 + wc * 32 + fq * 8;
#pragma unroll
        for (int ai = 0; ai < 2; ++ai)
#pragma unroll
            for (int m = 0; m < 4; ++m) {
                const int r = row0 + ai * 128 + m * 16; const float rs = SRC == 0 ? rsrc[r] : rstd_from_sum(rsrc, r);
                f32x4 o[2];
#pragma unroll
                for (int n = 0; n < 2; ++n)
#pragma unroll
                    for (int j = 0; j < 4; ++j) { const float g = acc[ai][0][m][n][j] * rs, up = acc[ai][1][m][n][j] * rs; o[n][j] = g * fast_sigmoid(g) * up; }
                *(u32x4*)(H + (size_t)r * FFN + col) = pk8h(o[0], o[1]);
            }
    }
};

template <bool BASEH> struct EpiResid {
    static constexpr bool AFTER_DRAIN = false;
    const void* base; h16* outh; float* ssq; float alpha;
    __device__ __forceinline__ void operator()(const Acc& acc, const Unit& u, int wr, int wc, int fr, int fq) const {
        const int row0 = u.pm * 256 + wr * 64 + fr, col0 = u.pn * 256 + wc * 32 + fq * 8;
#pragma unroll
        for (int ai = 0; ai < 2; ++ai)
#pragma unroll
            for (int m = 0; m < 4; ++m) {
                const int r = row0 + ai * 128 + m * 16; float sq = 0.f;
#pragma unroll
                for (int bj = 0; bj < 2; ++bj) {
                    const size_t off = (size_t)r * DM + col0 + bj * 128;
                    f32x4 b0, b1;
                    if (BASEH) unpk8h(*(const u32x4*)((const h16*)base + off), b0, b1); else { b0 = *(const f32x4*)((const float*)base + off); b1 = *(const f32x4*)((const float*)base + off + 4); }
                    const f32x4 v0 = b0 + alpha * acc[ai][bj][m][0], v1 = b1 + alpha * acc[ai][bj][m][1];
                    *(u32x4*)(outh + off) = pk8h(v0, v1);
                    sq += (v0[0] * v0[0] + v0[1] * v0[1]) + (v0[2] * v0[2] + v0[3] * v0[3]) + (v1[0] * v1[0] + v1[1] * v1[1]) + (v1[2] * v1[2] + v1[3] * v1[3]);
                }
                sq = quad16(sq);
                if (fq == 0) __hip_atomic_fetch_add(ssq + r, sq, __ATOMIC_RELAXED, __HIP_MEMORY_SCOPE_AGENT);
            }
    }
};

struct EpiFinal {
    static constexpr bool AFTER_DRAIN = false;
    const h16* base; float* out; float* ssq; unsigned* cnt; const float* gain; float alpha;
    __device__ __forceinline__ void operator()(Acc& acc, const Unit& u, int wr, int wc, int fr, int fq) const {
        const int row0 = u.pm * 256 + wr * 64 + fr, col0 = u.pn * 256 + wc * 32 + fq * 8;
#pragma unroll
        for (int ai = 0; ai < 2; ++ai)
#pragma unroll
            for (int m = 0; m < 4; ++m) {
                const int r = row0 + ai * 128 + m * 16; float sq = 0.f;
#pragma unroll
                for (int bj = 0; bj < 2; ++bj) {
                    f32x4 b0, b1; unpk8h(*(const u32x4*)(base + (size_t)r * DM + col0 + bj * 128), b0, b1);
                    const f32x4 v0 = b0 + alpha * acc[ai][bj][m][0], v1 = b1 + alpha * acc[ai][bj][m][1];
                    acc[ai][bj][m][0] = v0; acc[ai][bj][m][1] = v1;
                    sq += (v0[0] * v0[0] + v0[1] * v0[1]) + (v0[2] * v0[2] + v0[3] * v0[3]) + (v1[0] * v1[0] + v1[1] * v1[1]) + (v1[2] * v1[2] + v1[3] * v1[3]);
                }
                sq = quad16(sq);
                if (fq == 0) __hip_atomic_fetch_add(ssq + r, sq, __ATOMIC_RELAXED, __HIP_MEMORY_SCOPE_AGENT);
            }
        asm volatile("s_waitcnt vmcnt(0)" ::: "memory");
        unsigned* c = cnt + 64 * u.pm;
        if ((threadIdx.x & 63) == 0) __hip_atomic_fetch_add(c, 1u, __ATOMIC_RELAXED, __HIP_MEMORY_SCOPE_AGENT);
        { unsigned spins = 0;
          while ((unsigned)__builtin_amdgcn_readfirstlane(__hip_atomic_load(c, __ATOMIC_RELAXED, __HIP_MEMORY_SCOPE_AGENT)) < 32u) { __builtin_amdgcn_s_sleep(2); if (++spins > (1u << 22)) break; } }
        f32x4 gv[2][2];
#pragma unroll
        for (int bj = 0; bj < 2; ++bj) { gv[bj][0] = *(const f32x4*)(gain + col0 + bj * 128); gv[bj][1] = *(const f32x4*)(gain + col0 + bj * 128 + 4); }
#pragma unroll
        for (int ai = 0; ai < 2; ++ai)
#pragma unroll
            for (int m = 0; m < 4; ++m) {
                const int r = row0 + ai * 128 + m * 16;
                const float rs = __builtin_amdgcn_rsqf(__hip_atomic_load(ssq + r, __ATOMIC_RELAXED, __HIP_MEMORY_SCOPE_AGENT) * (1.0f / DM) + NORM_EPS);
#pragma unroll
                for (int bj = 0; bj < 2; ++bj) { float* o = out + (size_t)r * DM + col0 + bj * 128;
                    *(f32x4*)o = acc[ai][bj][m][0] * rs * gv[bj][0]; *(f32x4*)(o + 4) = acc[ai][bj][m][1] * rs * gv[bj][1]; }
            }
    }
};

__device__ __forceinline__ void head_norm_store(const Acc& acc, int ai, int m, float rs, const float* gain, float oscale, h16* dst  , int fq) {
    float sq = 0.f;
#pragma unroll
    for (int bj = 0; bj < 2; ++bj)
#pragma unroll
        for (int n = 0; n < 2; ++n)
#pragma unroll
            for (int j = 0; j < 4; ++j) { const float v = acc[ai][bj][m][n][j] * rs; sq += v * v; }
    sq = quad16(sq);
    const float r = oscale * __builtin_amdgcn_rsqf(sq * (1.0f / 64.0f) + NORM_EPS);
#pragma unroll
    for (int bj = 0; bj < 2; ++bj) {
        const f32x4 g0 = *(const f32x4*)(gain + 32 * bj + 8 * fq), g1 = *(const f32x4*)(gain + 32 * bj + 8 * fq + 4);
        const f32x4 v0 = acc[ai][bj][m][0] * (rs * r) * g0, v1 = acc[ai][bj][m][1] * (rs * r) * g1;
        *(u32x4*)(dst + 32 * bj + 8 * fq) = pk8h(v0, v1);
    }
}

struct EpiWin {
    static constexpr bool AFTER_DRAIN = false;
    const float* ssq;
    const float *gq, *gk, *gmq;
    h16 *qa, *ka, *va, *qidx, *kidx, *acat, *qm, *gates; float* widx;
    __device__ __forceinline__ void operator()(const Acc& acc, const Unit& u, int wr, int wc, int fr, int fq) const {
        const int row0 = u.pm * 256 + wr * 64 + fr; const int pn = u.pn;
        float rs[2][4];
#pragma unroll
        for (int ai = 0; ai < 2; ++ai)
#pragma unroll
            for (int m = 0; m < 4; ++m) rs[ai][m] = rstd_from_sum(ssq, row0 + ai * 128 + m * 16);
        if (pn < 2) {
#pragma unroll
            for (int ai = 0; ai < 2; ++ai)
#pragma unroll
                for (int m = 0; m < 4; ++m) { const int r = row0 + ai * 128 + m * 16;
                    head_norm_store(acc, ai, m, rs[ai][m], gq, 0.125f * LOG2E, qa + (size_t)r * 512 + (4 * pn + wc) * 64, fq); }
        } else if (pn == 2) {
            if (wc == 0) {
#pragma unroll
                for (int ai = 0; ai < 2; ++ai)
#pragma unroll
                    for (int m = 0; m < 4; ++m) { const int r = row0 + ai * 128 + m * 16; head_norm_store(acc, ai, m, rs[ai][m], gk, 1.0f, ka + (size_t)r * 64, fq); }
            } else if (wc == 1) {
#pragma unroll
                for (int ai = 0; ai < 2; ++ai)
#pragma unroll
                    for (int m = 0; m < 4; ++m) { const int r = row0 + ai * 128 + m * 16;
#pragma unroll
                        for (int bj = 0; bj < 2; ++bj) *(u32x4*)(va + (size_t)r * 64 + 32 * bj + 8 * fq) = pk8h(acc[ai][bj][m][0] * rs[ai][m], acc[ai][bj][m][1] * rs[ai][m]); }
            } else if (wc == 2) {
#pragma unroll
                for (int ai = 0; ai < 2; ++ai)
#pragma unroll
                    for (int m = 0; m < 4; ++m) { const int r = row0 + ai * 128 + m * 16;
#pragma unroll
                        for (int bj = 0; bj < 2; ++bj) *(u32x4*)(kidx + (size_t)r * 64 + 32 * bj + 8 * fq) = pk8h(acc[ai][bj][m][0] * rs[ai][m], acc[ai][bj][m][1] * rs[ai][m]); }
            } else {
                if (fq == 0) {
#pragma unroll
                    for (int ai = 0; ai < 2; ++ai)
#pragma unroll
                        for (int m = 0; m < 4; ++m) { const int r = row0 + ai * 128 + m * 16; *(f32x4*)(widx + (size_t)r * 4) = acc[ai][0][m][0] * (rs[ai][m] * 0.0625f); }
                }
            }
        } else if (pn == 3) {
#pragma unroll
            for (int ai = 0; ai < 2; ++ai)
#pragma unroll
                for (int m = 0; m < 4; ++m) { const int r = row0 + ai * 128 + m * 16;
#pragma unroll
                    for (int bj = 0; bj < 2; ++bj) *(u32x4*)(qidx + (size_t)r * 256 + 128 * bj + 32 * wc + 8 * fq) = pk8h(acc[ai][bj][m][0] * rs[ai][m], acc[ai][bj][m][1] * rs[ai][m]); }
        } else if (pn == 4) {
#pragma unroll
            for (int ai = 0; ai < 2; ++ai)
#pragma unroll
                for (int m = 0; m < 4; ++m) { const int r = row0 + ai * 128 + m * 16; const int bc = r >> 6, s = r & 63;
#pragma unroll
                    for (int bj = 0; bj < 2; ++bj) { const int col = 128 * bj + 32 * wc + 8 * fq, g = col >> 4, c0 = col & 15;
                        *(u32x4*)(acat + ((size_t)g * 1024 + bc) * 1280 + 16 * s + c0) = pk8h(acc[ai][bj][m][0] * rs[ai][m], acc[ai][bj][m][1] * rs[ai][m]); } }
        } else if (pn == 5) {
#pragma unroll
            for (int ai = 0; ai < 2; ++ai)
#pragma unroll
                for (int m = 0; m < 4; ++m) { const int r = row0 + ai * 128 + m * 16;
                    head_norm_store(acc, ai, m, rs[ai][m], gmq, 0.125f * LOG2E, qm + (size_t)r * 256 + wc * 64, fq); }
        } else {
#pragma unroll
            for (int ai = 0; ai < 2; ++ai)
#pragma unroll
                for (int m = 0; m < 4; ++m) { const int r = row0 + ai * 128 + m * 16;
#pragma unroll
                    for (int bj = 0; bj < 2; ++bj) { f32x4 v0 = acc[ai][bj][m][0] * rs[ai][m], v1 = acc[ai][bj][m][1] * rs[ai][m];
#pragma unroll
                        for (int j = 0; j < 4; ++j) { v0[j] = fast_sigmoid(v0[j]); v1[j] = fast_sigmoid(v1[j]); }
                        *(u32x4*)(gates + (size_t)r * 3072 + (pn - 6) * 256 + 128 * bj + 32 * wc + 8 * fq) = pk8h(v0, v1); } }
        }
    }
};

struct EpiMemKV {
    static constexpr bool AFTER_DRAIN = false;
    const float* gmk; h16* mk; h16* mvT;
    __device__ __forceinline__ void operator()(const Acc& acc, const Unit& u, int wr, int wc, int fr, int fq) const {
        const int row0 = u.pm * 256 + wr * 64 + fr;
        if (u.pn == 0) {
#pragma unroll
            for (int ai = 0; ai < 2; ++ai)
#pragma unroll
                for (int m = 0; m < 4; ++m) { const int r = row0 + ai * 128 + m * 16; head_norm_store(acc, ai, m, 1.0f, gmk, 1.0f, mk + (size_t)r * 256 + wc * 64, fq); }
        } else {
#pragma unroll
            for (int ai = 0; ai < 2; ++ai)
#pragma unroll
                for (int m = 0; m < 4; ++m) { const int r = row0 + ai * 128 + m * 16; const int b = r >> 8, kv = r & 255;
                    h16* dst = mvT + ((size_t)(b * 4 + wc) * 64) * MEMT + kv;
#pragma unroll
                    for (int bj = 0; bj < 2; ++bj)
#pragma unroll
                        for (int n = 0; n < 2; ++n)
#pragma unroll
                            for (int j = 0; j < 4; ++j) dst[(size_t)(32 * bj + 8 * fq + 4 * n + j) * MEMT] = (h16)acc[ai][bj][m][n][j]; }
        }
    }
};

struct EpiGlu {
    static constexpr bool AFTER_DRAIN = false;
    h16* ob;
    __device__ __forceinline__ void operator()(const Acc& acc, const Unit& u, int wr, int wc, int fr, int fq) const {
        const int row0 = u.pm * 256 + wr * 64 + fr, col = u.pn * 128 + wc * 32 + fq * 8;
#pragma unroll
        for (int ai = 0; ai < 2; ++ai)
#pragma unroll
            for (int m = 0; m < 4; ++m) { const int r = row0 + ai * 128 + m * 16; f32x4 o[2];
#pragma unroll
                for (int n = 0; n < 2; ++n)
#pragma unroll
                    for (int j = 0; j < 4; ++j) o[n][j] = acc[ai][0][m][n][j] * fast_sigmoid(acc[ai][1][m][n][j]);
                *(u32x4*)(ob + (size_t)r * DM + col) = pk8h(o[0], o[1]); }
    }
};

struct EpiMerge2 {
    static constexpr bool AFTER_DRAIN = false; static constexpr float GMIN = 5.9604645e-8f;
    const h16* gates; const h16* ob; h16* merged;
    __device__ __forceinline__ void mid(Acc& acc, const Unit& u, int wr, int wc, int fr, int fq) const {
        const int row0 = u.pm * 256 + wr * 64 + fr, col0 = u.pn * 256 + wc * 32 + fq * 8;
#pragma unroll
        for (int ai = 0; ai < 2; ++ai)
#pragma unroll
            for (int m = 0; m < 4; ++m) { const int r = row0 + ai * 128 + m * 16;
#pragma unroll
                for (int bj = 0; bj < 2; ++bj) { const int col = col0 + bj * 128; f32x4 a0, a1, c0, c1;
                    unpk8h(*(const u32x4*)(gates + (size_t)r * 3072 + col), a0, a1); unpk8h(*(const u32x4*)(gates + (size_t)r * 3072 + 2048 + col), c0, c1);
#pragma unroll
                    for (int j = 0; j < 4; ++j) { acc[ai][bj][m][0][j] *= a0[j] * __builtin_amdgcn_rcpf(fmaxf(c0[j], GMIN)); acc[ai][bj][m][1][j] *= a1[j] * __builtin_amdgcn_rcpf(fmaxf(c1[j], GMIN)); } } }
    }
    __device__ __forceinline__ void operator()(const Acc& acc, const Unit& u, int wr, int wc, int fr, int fq) const {
        const int row0 = u.pm * 256 + wr * 64 + fr, col0 = u.pn * 256 + wc * 32 + fq * 8;
#pragma unroll
        for (int ai = 0; ai < 2; ++ai)
#pragma unroll
            for (int m = 0; m < 4; ++m) { const int r = row0 + ai * 128 + m * 16;
#pragma unroll
                for (int bj = 0; bj < 2; ++bj) { const int col = col0 + bj * 128; f32x4 b0, b1, c0, c1, o0, o1;
                    unpk8h(*(const u32x4*)(gates + (size_t)r * 3072 + 1024 + col), b0, b1); unpk8h(*(const u32x4*)(gates + (size_t)r * 3072 + 2048 + col), c0, c1);
                    unpk8h(*(const u32x4*)(ob + (size_t)r * DM + col), o0, o1);
#pragma unroll
                    for (int j = 0; j < 4; ++j) { c0[j] = fmaxf(c0[j], GMIN); c1[j] = fmaxf(c1[j], GMIN); }
                    *(u32x4*)(merged + (size_t)r * DM + col) = pk8h(c0 * acc[ai][bj][m][0] + b0 * o0, c1 * acc[ai][bj][m][1] + b1 * o1); } }
    }
};

struct EpiS5Main {
    static constexpr bool AFTER_DRAIN = false;
    const float* logdt; h16* ys;
    __device__ __forceinline__ void operator()(const Acc& acc, const Unit& u, int wr, int wc, int fr, int fq) const {
        const int g = u.pm >> 2, pmm = u.pm & 3, pnn = u.pn & 3; const float dt = __expf(logdt[g]);
        const int row0 = pmm * 256 + wr * 64 + fr;
#pragma unroll
        for (int ai = 0; ai < 2; ++ai)
#pragma unroll
            for (int m = 0; m < 4; ++m) { const int bc = row0 + ai * 128 + m * 16;
#pragma unroll
                for (int bj = 0; bj < 2; ++bj) { const int tc = pnn * 256 + 128 * bj + 32 * wc + 8 * fq, t = tc >> 4, c0 = tc & 15;
                    f32x4 v[2];
#pragma unroll
                    for (int n = 0; n < 2; ++n)
#pragma unroll
                        for (int j = 0; j < 4; ++j) { const float y = acc[ai][bj][m][n][j] * dt; const float z = 1.5957691216f * (y + 0.044715f * y * y * y); v[n][j] = y * fast_sigmoid(z); }
                    *(u32x4*)(ys + ((size_t)bc * 64 + t) * 256 + 16 * g + c0) = pk8h(v[0], v[1]); } }
    }
};

struct EpiS5State {
    static constexpr bool AFTER_DRAIN = true;
    const float* logdt; const float* a64;
    h16* acat;
    __device__ __forceinline__ void fused(const Acc& acc, const Unit& u, int wr, int wc, int fr, int fq, LAS unsigned char* lds) const {
        const int g = u.pn, pmm = u.pm & 3; const float dt = __expf(logdt[g]);
        LAS float* sb = (LAS float*)lds;
#pragma unroll
        for (int ai = 0; ai < 2; ++ai)
#pragma unroll
            for (int m = 0; m < 4; ++m) { const int r = ai * 128 + wr * 64 + m * 16 + fr;
                *(LAS f32x4*)(sb + r * 132 + 32 * wc + 8 * fq) = acc[ai][0][m][0] * dt; *(LAS f32x4*)(sb + r * 132 + 32 * wc + 8 * fq + 4) = acc[ai][0][m][1] * dt; }
        __syncthreads();
        const int tid = threadIdx.x, bl = tid >> 6, p = tid & 63;
        const float ar = a64[(g * 64 + p) * 2], ai_ = a64[(g * 64 + p) * 2 + 1];
        float xr = 0.f, xi = 0.f;
        h16* dst = acat + ((size_t)g * 1024 + (size_t)(pmm * 8 + bl) * 32) * 1280;
        for (int ch = 0; ch < 32; ++ch) {
            dst[(size_t)ch * 1280 + 1024 + p] = (h16)xr; dst[(size_t)ch * 1280 + 1088 + p] = (h16)xi;
            dst[(size_t)ch * 1280 + 1152 + p] = (h16)0.f; dst[(size_t)ch * 1280 + 1216 + p] = (h16)0.f;
            const float sr = sb[(bl * 32 + ch) * 132 + p], si = sb[(bl * 32 + ch) * 132 + 64 + p];
            const float nr = ar * xr - ai_ * xi + sr, ni = ar * xi + ai_ * xr + si; xr = nr; xi = ni;
        }
        __syncthreads();
    }
};
}
namespace pro {
#define LDS_WAIT() asm volatile("s_waitcnt lgkmcnt(0)" ::: "memory")

__device__ __forceinline__ float wave_sum(float v) {
#pragma unroll
    for (int o = 1; o < 64; o <<= 1) v += __shfl_xor(v, o);
    return v;
}

__device__ __forceinline__ void tr_item(const float* W, int ldw, int src0, int nvalid, const float* gain, h16* Bt, int K, int row0, int k0, LAS float* scr, int lane) {
    { const int c = lane & 31, kh = lane >> 5; const bool ok = c < nvalid;
      const float* wp = W + (size_t)(k0 + kh) * ldw + src0 + c; const size_t st2 = (size_t)2 * ldw;
#pragma unroll
      for (int hb = 0; hb < 2; ++hb) { float v[16];
#pragma unroll
          for (int i = 0; i < 16; ++i) { v[i] = ok ? *wp : 0.f; wp += st2; }
#pragma unroll
          for (int i = 0; i < 16; ++i) { const int kk = 2 * (16 * hb + i) + kh; scr[kk * 33 + c] = gain ? v[i] * gain[k0 + kk] : v[i]; } } }
    LDS_WAIT(); asm volatile("" ::: "memory");
    const int c8 = lane & 7;
#pragma unroll
    for (int jj = 0; jj < 4; ++jj) { const int q = (lane >> 3) + 8 * jj; const int o = 8 * ((q >> 2) & 3) + 4 * (q >> 4) + (q & 3);
        const LAS float* s = scr + (8 * c8) * 33 + o;
        u32x4 w; w.x = pk2h(s[0 * 33], s[1 * 33]); w.y = pk2h(s[2 * 33], s[3 * 33]); w.z = pk2h(s[4 * 33], s[5 * 33]); w.w = pk2h(s[6 * 33], s[7 * 33]);
        *(u32x4*)(Bt + (size_t)(row0 + q) * K + k0 + 8 * c8) = w; }
    LDS_WAIT(); asm volatile("" ::: "memory");
}

__device__ __forceinline__ int win_src0(int gi, int& nv) {
    const int pn = gi >> 3, bj = (gi >> 2) & 1, wc = gi & 3; nv = 32;
    if (pn < 2) return 64 * (4 * pn + wc) + 32 * bj;
    if (pn == 2) { if (wc == 0) return 512 + 32 * bj; if (wc == 1) return 576 + 32 * bj; if (wc == 2) return 896 + 32 * bj; nv = bj ? 0 : 4; return 960; }
    if (pn == 3) return 640 + 128 * bj + 32 * wc;
    if (pn == 4) return 964 + 128 * bj + 32 * wc;
    if (pn == 5) return 1220 + 64 * wc + 32 * bj;
    return 1476 + 256 * (pn - 6) + 128 * bj + 32 * wc;
}

struct WPtrs { const float *w1a, *w1b, *win, *wmkv, *wglu, *woa, *wom, *wout, *w2a, *w2b, *g1, *gmix, *g2;
               h16 *W1A, *W1B, *WIN, *WMKV, *WGLU, *WOA, *WOM, *WOUT, *W2A, *W2B; };

constexpr int IT_1A = 176 * 16, IT_1B = 32 * 44, IT_IN = 144 * 16, IT_MKV = 16 * 16, IT_GLU = 64 * 4, IT_OA = 32 * 8, IT_OM = 32 * 4, IT_OUT = 32 * 16;
constexpr int IT_TOTAL = 2 * IT_1A + 2 * IT_1B + IT_IN + IT_MKV + IT_GLU + IT_OA + IT_OM + IT_OUT;

__device__ __forceinline__ void weight_item(const WPtrs& P, int it, LAS float* scr, int lane) {
    int r = it;
    if (r < 2 * IT_1A) { const bool second = r >= IT_1A; if (second) r -= IT_1A; const int gi = r >> 4, kb = r & 15; const int pn = gi >> 3, bj = (gi >> 2) & 1, wc = gi & 3;
        tr_item(second ? P.w2a : P.w1a, 2 * FFN, (bj ? FFN : 0) + 128 * pn + 32 * wc, 32, second ? P.g2 : P.g1, second ? P.W2A : P.W1A, 1024, 32 * gi, 64 * kb, scr, lane); return; }
    r -= 2 * IT_1A;
    if (r < 2 * IT_1B) { const bool second = r >= IT_1B; if (second) r -= IT_1B; const int gi = r / 44, kb = r % 44;
        tr_item(second ? P.w2b : P.w1b, DM, 32 * gi, 32, nullptr, second ? P.W2B : P.W1B, FFN, 32 * gi, 64 * kb, scr, lane); return; }
    r -= 2 * IT_1B;
    if (r < IT_IN) { const int gi = r >> 4, kb = r & 15; int nv; const int s0 = win_src0(gi, nv);
        tr_item(P.win, 4548, s0, nv, P.gmix, P.WIN, 1024, 32 * gi, 64 * kb, scr, lane); return; }
    r -= IT_IN;
    if (r < IT_MKV) { const int gi = r >> 4, kb = r & 15; const int pn = gi >> 3, bj = (gi >> 2) & 1, wc = gi & 3;
        tr_item(P.wmkv, 512, 256 * pn + 64 * wc + 32 * bj, 32, nullptr, P.WMKV, 1024, 32 * gi, 64 * kb, scr, lane); return; }
    r -= IT_MKV;
    if (r < IT_GLU) { const int gi = r >> 2, kb = r & 3; const int pn = gi >> 3, bj = (gi >> 2) & 1, wc = gi & 3;
        tr_item(P.wglu, 2048, (bj ? 1024 : 0) + 128 * pn + 32 * wc, 32, nullptr, P.WGLU, 256, 32 * gi, 64 * kb, scr, lane); return; }
    r -= IT_GLU;
    if (r < IT_OA) { const int gi = r >> 3, kb = r & 7; tr_item(P.woa, DM, 32 * gi, 32, nullptr, P.WOA, 512, 32 * gi, 64 * kb, scr, lane); return; }
    r -= IT_OA;
    if (r < IT_OM) { const int gi = r >> 2, kb = r & 3; tr_item(P.wom, DM, 32 * gi, 32, nullptr, P.WOM, 256, 32 * gi, 64 * kb, scr, lane); return; }
    r -= IT_OM;
    { const int gi = r >> 4, kb = r & 15; tr_item(P.wout, DM, 32 * gi, 32, nullptr, P.WOUT, 1024, 32 * gi, 64 * kb, scr, lane); }
}

template <int NR> __device__ __forceinline__ void rows_to_h16(const float* x, h16* o, int m0, int mstep, int mend, const float* gain, float* rstd_out, int lane) {
    f32x4 v[NR][4];
#pragma unroll
    for (int r = 0; r < NR; ++r) { const int m = m0 + r * mstep; if (m < mend) {
#pragma unroll
        for (int j = 0; j < 4; ++j) v[r][j] = ((const f32x4*)(x + (size_t)m * DM))[lane + 64 * j]; } }
#pragma unroll
    for (int r = 0; r < NR; ++r) { const int m = m0 + r * mstep; if (m < mend) {
        float s = 0.f;
#pragma unroll
        for (int j = 0; j < 4; ++j) s += (v[r][j][0] * v[r][j][0] + v[r][j][1] * v[r][j][1]) + (v[r][j][2] * v[r][j][2] + v[r][j][3] * v[r][j][3]);
        const float rstd = 1.0f / sqrtf(wave_sum(s) * (1.0f / DM) + NORM_EPS);
        if (rstd_out && lane == 0) rstd_out[m] = rstd;
        u32x2* o8 = (u32x2*)(o + (size_t)m * DM) + lane;
#pragma unroll
        for (int j = 0; j < 4; ++j) { f32x4 w = v[r][j];
            if (gain) { const f32x4 gv = ((const f32x4*)gain)[lane + 64 * j]; w = w * rstd * gv; }
            u32x2 p; p.x = pk2h(w[0], w[1]); p.y = pk2h(w[2], w[3]); o8[64 * j] = p; } } }
}

struct S5In { const float *lre, *lim, *logdt, *bre, *bim, *cre, *cim, *dd; };
__device__ __forceinline__ int slot_row(int c) { const int o = c & 31; return (c & ~31) + 16 * ((o >> 2) & 1) + 4 * (o >> 3) + (o & 3); }
__device__ __forceinline__ void cpow(float ar, float ai, int n, float& pr, float& pi) {
    pr = 1.f; pi = 0.f;
    for (int i = 0; i < n; ++i) { const float t = pr * ar - pi * ai; pi = pr * ai + pi * ar; pr = t; }
}
__device__ __forceinline__ void s5_item(const S5In& I, int g, int j, h16* tcat, h16* wst, float* a64, LAS float* L, int tid) {
    LAS float* Pj = L;
    LAS float* Pj1 = L + 128;
    LAS float* P63 = L + 256;
    LAS float* Bb = L + 384;
    LAS float* CP = L + 384 + 2048;
    LAS float* Kb = L + 384 + 4096;
    const float dt = __expf(I.logdt[g]); const float sig = 1.0f / dt;
    __syncthreads();
    if (tid < 64) { const int p = tid; const float lr = I.lre[g * 64 + p], li = I.lim[g * 64 + p];
        const float mag = __expf(lr * dt); const float ar = mag * cosf(li * dt), ai = mag * sinf(li * dt);
        const float den = lr * lr + li * li; const float fr = ((ar - 1.0f) * lr + ai * li) / den, fi = (ai * lr - (ar - 1.0f) * li) / den;
        float pr, pi; cpow(ar, ai, j, pr, pi); Pj[2 * p] = pr; Pj[2 * p + 1] = pi;
        { const float t = pr * ar - pi * ai; const float u = pr * ai + pi * ar; Pj1[2 * p] = t; Pj1[2 * p + 1] = u; }
        cpow(ar, ai, 63 - j, pr, pi); P63[2 * p] = pr; P63[2 * p + 1] = pi;
        if (j == 0) { cpow(ar, ai, 64, pr, pi); a64[(g * 64 + p) * 2] = pr; a64[(g * 64 + p) * 2 + 1] = pi; }
#pragma unroll 4
        for (int c = 0; c < 16; ++c) { const float br = I.bre[(g * 64 + p) * 16 + c], bi = I.bim[(g * 64 + p) * 16 + c];
            Bb[(p * 16 + c) * 2] = fr * br - fi * bi; Bb[(p * 16 + c) * 2 + 1] = fr * bi + fi * br; }
    }
    __syncthreads();
    for (int e = tid; e < 1024; e += 512) { const int cp = e >> 6, p = e & 63;
        const float cr = I.cre[(g * 16 + cp) * 64 + p], ci = I.cim[(g * 16 + cp) * 64 + p], pr = Pj[2 * p], pi = Pj[2 * p + 1];
        CP[e * 2] = cr * pr - ci * pi; CP[e * 2 + 1] = cr * pi + ci * pr; }
    __syncthreads();
    if (tid < 256) { const int cp = tid >> 4, c = tid & 15; float s = 0.f;
        for (int p = 0; p < 64; ++p) s += CP[(cp * 64 + p) * 2] * Bb[(p * 16 + c) * 2] - CP[(cp * 64 + p) * 2 + 1] * Bb[(p * 16 + c) * 2 + 1];
        if (j == 0 && cp == c) s += I.dd[g * 16 + c];
        Kb[tid] = s * sig; }
    __syncthreads();
    h16* T = tcat + (size_t)g * 1024 * 1280;
    for (int e = tid; e < (64 - j) * 32; e += 512) { const int d = e >> 5, cp = (e >> 1) & 15, h = e & 1;
        const LAS float* k = Kb + cp * 16 + 8 * h;
        u32x4 w; w.x = pk2h(k[0], k[1]); w.y = pk2h(k[2], k[3]); w.z = pk2h(k[4], k[5]); w.w = pk2h(k[6], k[7]);
        *(u32x4*)(T + (size_t)slot_row((j + d) * 16 + cp) * 1280 + 16 * d + 8 * h) = w;
        if (j > 0) *(u32x4*)(T + (size_t)slot_row(d * 16 + cp) * 1280 + 16 * (j + d) + 8 * h) = (u32x4){0u, 0u, 0u, 0u}; }
    for (int e = tid; e < 1024; e += 512) { const int cp = e >> 6, p = e & 63;
        const float cr = I.cre[(g * 16 + cp) * 64 + p], ci = I.cim[(g * 16 + cp) * 64 + p], pr = Pj1[2 * p], pi = Pj1[2 * p + 1];
        h16* row = T + (size_t)slot_row(j * 16 + cp) * 1280;
        row[1024 + p] = (h16)((cr * pr - ci * pi) * sig); row[1088 + p] = (h16)(-(cr * pi + ci * pr) * sig); row[1152 + p] = (h16)0.f; row[1216 + p] = (h16)0.f; }
    h16* Wg = wst + (size_t)g * 256 * 1024;
    for (int e = tid; e < 1024; e += 512) { const int p = e >> 4, c = e & 15;
        const float pr = P63[2 * p], pi = P63[2 * p + 1], br = Bb[(p * 16 + c) * 2], bi = Bb[(p * 16 + c) * 2 + 1];
        Wg[(size_t)slot_row(p) * 1024 + 16 * j + c] = (h16)((pr * br - pi * bi) * sig); Wg[(size_t)slot_row(64 + p) * 1024 + 16 * j + c] = (h16)((pr * bi + pi * br) * sig); }
    for (int e = tid; e < 128 * 16; e += 512) { const int rr = 128 + (e >> 4), c = e & 15; Wg[(size_t)rr * 1024 + 16 * j + c] = (h16)0.f; }
}
}
namespace att {
constexpr int SC_STRIDE = 2080;
constexpr int L_KS = 0, L_VS = 18432, L_RELB = 36864, L_FBUF = 44032, L_MASK = 133120, L_HIST = 149760, L_QMM = 157952, L_TROW = 158080, L_END = 162176;
constexpr float NEG_INF = -__builtin_inff();
constexpr float THR = 6.0f;

struct P {
    const unsigned char* big; const unsigned char* small; const float* relb;
    h16* out;
    static constexpr size_t MB = 1u << 20;
    __device__ __forceinline__ const h16* qa() const { return (const h16*)big; }
    __device__ __forceinline__ const h16* qidx() const { return (const h16*)(big + 64 * MB); }
    __device__ __forceinline__ const h16* qm() const { return (const h16*)(big + 96 * MB); }
    __device__ __forceinline__ const h16* ka() const { return (const h16*)(big + 128 * MB); }
    __device__ __forceinline__ const h16* va() const { return (const h16*)(big + 136 * MB); }
    __device__ __forceinline__ const h16* kidx() const { return (const h16*)(big + 144 * MB); }
    __device__ __forceinline__ const float* widx() const { return (const float*)(big + 152 * MB); }
    __device__ __forceinline__ const h16* mk() const { return (const h16*)small; }
    __device__ __forceinline__ const h16* mvT() const { return (const h16*)(small + 4 * MB); }
};

__device__ __forceinline__ int crow(int r, int hi) { return (r & 3) + 8 * (r >> 2) + 4 * hi; }
__device__ __forceinline__ unsigned fkey(float f) { const unsigned u = __float_as_uint(f); return u ^ ((unsigned)((int)u >> 31) | 0x80000000u); }
__device__ __forceinline__ float swapmax(float m) { auto rr = __builtin_amdgcn_permlane32_swap(__float_as_uint(m), __float_as_uint(m), false, false); return fmaxf(__uint_as_float(rr[0]), __uint_as_float(rr[1])); }
__device__ __forceinline__ float swapsum(float m) { auto rr = __builtin_amdgcn_permlane32_swap(__float_as_uint(m), __float_as_uint(m), false, false); return __uint_as_float(rr[0]) + __uint_as_float(rr[1]); }
__device__ __forceinline__ float qperm_b1(float v) { return __int_as_float(__builtin_amdgcn_mov_dpp(__float_as_int(v), 0xB1, 0xF, 0xF, true)); }
__device__ __forceinline__ float qperm_4e(float v) { return __int_as_float(__builtin_amdgcn_mov_dpp(__float_as_int(v), 0x4E, 0xF, 0xF, true)); }

__device__ __forceinline__ int t5_bucket(int rel) {
    const int n = rel < 0 ? -rel : rel; int v;
    if (n < 8) v = n; else if (n < 12) v = 8; else if (n < 16) v = 9; else if (n < 23) v = 10; else if (n < 32) v = 11; else if (n < 46) v = 12; else if (n < 64) v = 13; else if (n < 91) v = 14; else v = 15;
    return (rel > 0 ? 16 : 0) + v;
}

typedef short v4i16_t __attribute__((ext_vector_type(4)));
__device__ __forceinline__ h16x4 vtr(const LAS h16* p) { return __builtin_bit_cast(h16x4, __builtin_amdgcn_ds_read_tr16_b64_v4i16((LAS v4i16_t*)p)); }
__device__ __forceinline__ float max3f(float a, float b, float c) { float r; asm("v_max3_f32 %0, %1, %2, %3" : "=v"(r) : "v"(a), "v"(b), "v"(c)); return r; }
__device__ __forceinline__ void softmax_tile(f32x16& s, float& cref, h16x8& qx, bool& started, float& lsum, f32x16& O0, f32x16& O1, LAS float* fb  , int lane, int hi, h16x8& p0, h16x8& p1) {
    float tm = max3f(s[0], s[1], s[2]); tm = max3f(tm, s[3], s[4]); tm = max3f(tm, s[5], s[6]); tm = max3f(tm, s[7], s[8]); tm = max3f(tm, s[9], s[10]); tm = max3f(tm, s[11], s[12]);
    tm = max3f(tm, s[13], s[14]); tm = max3f(tm, s[15], s[15]);
    tm = swapmax(tm);
    const bool live = tm > -__builtin_inff();
    const bool need = tm > THR || (!started && live && tm < -THR);
    if (__any(need)) {
        const float newc = need ? (float)(h16)(cref - tm) : cref; const float d = cref - newc;
        const float f = (need && started) ? __builtin_amdgcn_exp2f(-d) : 1.0f;
        cref = newc; if (hi == 0) qx[0] = (h16)newc;
        lsum *= f;
        if (hi == 0) fb[lane] = f;
        asm volatile("s_waitcnt lgkmcnt(0)" ::: "memory");
#pragma unroll
        for (int g = 0; g < 4; ++g) { const f32x4 fv = *(const LAS f32x4*)(fb + 8 * g + 4 * hi);
#pragma unroll
            for (int i = 0; i < 4; ++i) { O0[4 * g + i] *= fv[i]; O1[4 * g + i] *= fv[i]; } }
        asm volatile("s_waitcnt lgkmcnt(0)" ::: "memory");
#pragma unroll
        for (int r = 0; r < 16; ++r) s[r] -= d;
    }
    started = started || live;
    float ps = 0.f;
#pragma unroll
    for (int r = 0; r < 16; ++r) { s[r] = __builtin_amdgcn_exp2f(s[r]); ps += s[r]; }
    lsum += ps;
    p0 = (h16x8){(h16)s[0], (h16)s[1], (h16)s[2], (h16)s[3], (h16)s[4], (h16)s[5], (h16)s[6], (h16)s[7]};
    p1 = (h16x8){(h16)s[8], (h16)s[9], (h16)s[10], (h16)s[11], (h16)s[12], (h16)s[13], (h16)s[14], (h16)s[15]};
}
__device__ __forceinline__ void softmax_tile2(f32x16 (&s)[2], float (&cref)[2], bool (&started)[2], float (&lsum)[2], f32x16 (&O)[2][2], LAS float* fb  , int lane, int hi, h16x8 (&p0)[2], h16x8 (&p1)[2]) {
    float tm[2];
#pragma unroll
    for (int ct = 0; ct < 2; ++ct) { float t = max3f(s[ct][0], s[ct][1], s[ct][2]); t = max3f(t, s[ct][3], s[ct][4]); t = max3f(t, s[ct][5], s[ct][6]); t = max3f(t, s[ct][7], s[ct][8]);
        t = max3f(t, s[ct][9], s[ct][10]); t = max3f(t, s[ct][11], s[ct][12]); t = max3f(t, s[ct][13], s[ct][14]); tm[ct] = max3f(t, s[ct][15], s[ct][15]); }
    tm[0] = swapmax(tm[0]); tm[1] = swapmax(tm[1]);
    bool live[2], need[2];
#pragma unroll
    for (int ct = 0; ct < 2; ++ct) { live[ct] = tm[ct] > -__builtin_inff(); need[ct] = tm[ct] > THR || (!started[ct] && live[ct] && tm[ct] < -THR); }
    if (__any(need[0] || need[1])) {
        float d[2];
#pragma unroll
        for (int ct = 0; ct < 2; ++ct) { const float newc = need[ct] ? (float)(h16)(cref[ct] - tm[ct]) : cref[ct]; d[ct] = cref[ct] - newc;
            const float f = (need[ct] && started[ct]) ? __builtin_amdgcn_exp2f(-d[ct]) : 1.0f;
            cref[ct] = newc; if (hi == 0) fb[32 * ct + lane] = f;
            lsum[ct] *= f; }
        asm volatile("s_waitcnt lgkmcnt(0)" ::: "memory");
#pragma unroll
        for (int ct = 0; ct < 2; ++ct)
#pragma unroll
            for (int g = 0; g < 4; ++g) { const f32x4 fv = *(const LAS f32x4*)(fb + 32 * ct + 8 * g + 4 * hi);
#pragma unroll
                for (int i = 0; i < 4; ++i) { O[ct][0][4 * g + i] *= fv[i]; O[ct][1][4 * g + i] *= fv[i]; } }
        asm volatile("s_waitcnt lgkmcnt(0)" ::: "memory");
#pragma unroll
        for (int ct = 0; ct < 2; ++ct)
#pragma unroll
            for (int r = 0; r < 16; ++r) s[ct][r] -= d[ct];
    }
#pragma unroll
    for (int ct = 0; ct < 2; ++ct) { started[ct] = started[ct] || live[ct];
        float ps = 0.f;
#pragma unroll
        for (int r = 0; r < 16; ++r) { s[ct][r] = __builtin_amdgcn_exp2f(s[ct][r]); ps += s[ct][r]; }
        lsum[ct] += ps;
        p0[ct] = (h16x8){(h16)s[ct][0], (h16)s[ct][1], (h16)s[ct][2], (h16)s[ct][3], (h16)s[ct][4], (h16)s[ct][5], (h16)s[ct][6], (h16)s[ct][7]};
        p1[ct] = (h16x8){(h16)s[ct][8], (h16)s[ct][9], (h16)s[ct][10], (h16)s[ct][11], (h16)s[ct][12], (h16)s[ct][13], (h16)s[ct][14], (h16)s[ct][15]}; }
}
__device__ __forceinline__ void store_o(const f32x16& O0, const f32x16& O1, float lsum, LAS float* fb, int lane, int hi, h16* out, size_t tok0, int col0) {
    const float lt = swapsum(lsum);
    if (hi == 0) fb[lane] = 1.0f / lt;
    asm volatile("s_waitcnt lgkmcnt(0)" ::: "memory");
#pragma unroll
    for (int g = 0; g < 4; ++g) { const f32x4 fv = *(const LAS f32x4*)(fb + 8 * g + 4 * hi);
#pragma unroll
        for (int i = 0; i < 4; ++i) { const int q = 8 * g + 4 * hi + i; h16* o = out + (tok0 + q) * 768 + col0 + (lane & 31);
            o[0] = (h16)(O0[4 * g + i] * fv[i]); o[32] = (h16)(O1[4 * g + i] * fv[i]); } }
    asm volatile("s_waitcnt lgkmcnt(0)" ::: "memory");
}

#define SEL_LOAD4(dst, rowp, i0) float dst[4]; _Pragma("unroll") for (int k_ = 0; k_ < 4; ++k_) dst[k_] = ((i0) + k_ < nreg) ? (rowp)[64 * ((i0) + k_) + lane] : __builtin_nanf("");
__device__ __forceinline__ float ikey(unsigned k) { return __uint_as_float((k & 0x80000000u) ? (k ^ 0x80000000u) : ~k); }
__device__ __forceinline__ int rank64(unsigned mh, unsigned ml, int n1) {
    int cnt = 0;
#pragma unroll 1
    for (int jx = 0; jx < n1; ++jx) { const unsigned oh = __builtin_amdgcn_readlane(mh, jx), ol = __builtin_amdgcn_readlane(ml, jx); cnt += (oh > mh || (oh == mh && ol > ml)) ? 1 : 0; }
    return cnt;
}
__device__ __forceinline__ void select_slow(const LAS float* row, int nreg, LAS unsigned* hist, LAS unsigned long long* cand, LAS unsigned* mrow, float lo, float hv, int rr, int lane) {
    unsigned T = 0u; int istar = 0;
    for (int level = 0; level < 40; ++level) {
        if (hv == lo) {
            int cnt = 0; T = fkey(lo);
            for (int i0 = 0; i0 < nreg; i0 += 4) { SEL_LOAD4(s4, row, i0);
#pragma unroll
                for (int k = 0; k < 4; ++k) { unsigned long long m = __ballot(s4[k] == lo); const int pc = __popcll(m);
                    if (cnt < rr && cnt + pc >= rr) { for (int z = rr - cnt - 1; z > 0; --z) m &= m - 1ull; istar = 64 * (i0 + k) + __ffsll(m) - 1; }
                    cnt += pc; } }
            break;
        }
        const float scale = 256.0f / (hv - lo);
        *(LAS u32x4*)(hist + 4 * lane) = (u32x4){0u, 0u, 0u, 0u};
        asm volatile("s_waitcnt lgkmcnt(0)" ::: "memory");
        for (int i0 = 0; i0 < nreg; i0 += 4) { SEL_LOAD4(s4, row, i0);
#pragma unroll
            for (int k = 0; k < 4; ++k) if (s4[k] >= lo && s4[k] <= hv) { int bin = (int)((s4[k] - lo) * scale); bin = bin > 255 ? 255 : bin; __hip_atomic_fetch_add(hist + bin, 1u, __ATOMIC_RELAXED, __HIP_MEMORY_SCOPE_WORKGROUP); } }
        asm volatile("s_waitcnt lgkmcnt(0)" ::: "memory");
        const u32x4 cv = *(const LAS u32x4*)(hist + 4 * lane);
        asm volatile("s_waitcnt lgkmcnt(0)" ::: "memory");
        const unsigned tot = cv[0] + cv[1] + cv[2] + cv[3];
        unsigned S = tot;
#pragma unroll
        for (int off = 1; off < 64; off <<= 1) { const unsigned t = __shfl_down(S, off); if (lane + off < 64) S += t; }
        const unsigned above = S - tot; const bool isit = (above < (unsigned)rr) && (S >= (unsigned)rr);
        int bl = -1; unsigned Gl = 0, cum = above;
#pragma unroll
        for (int k = 3; k >= 0; --k) { if (bl < 0) { if (cum + cv[k] >= (unsigned)rr) { bl = 4 * lane + k; Gl = cum; } else cum += cv[k]; } }
        const int src = __ffsll((unsigned long long)__ballot(isit)) - 1;
        const int bstar = __shfl(bl, src); rr -= (int)__shfl(Gl, src);
        int n1 = 0; float clo = __builtin_inff(), chi = -__builtin_inff();
        for (int i0 = 0; i0 < nreg; i0 += 4) { SEL_LOAD4(s4, row, i0);
#pragma unroll
            for (int k = 0; k < 4; ++k) { bool isc = false;
                if (s4[k] >= lo && s4[k] <= hv) { int bin = (int)((s4[k] - lo) * scale); bin = bin > 255 ? 255 : bin; isc = (bin == bstar); }
                const unsigned long long m = __ballot(isc); const int pos = n1 + __builtin_amdgcn_mbcnt_hi((unsigned)(m >> 32), __builtin_amdgcn_mbcnt_lo((unsigned)m, 0u));
                if (isc) { clo = fminf(clo, s4[k]); chi = fmaxf(chi, s4[k]); if (pos < 64) cand[pos] = ((unsigned long long)fkey(s4[k]) << 32) | (unsigned long long)(0xFFFFu - (unsigned)(64 * (i0 + k) + lane)); }
                n1 += __popcll(m); } }
#pragma unroll
        for (int o = 1; o < 64; o <<= 1) { clo = fminf(clo, __shfl_xor(clo, o)); chi = fmaxf(chi, __shfl_xor(chi, o)); }
        if (n1 <= 64 && clo != chi) {
            asm volatile("s_waitcnt lgkmcnt(0)" ::: "memory");
            const unsigned long long mine = lane < n1 ? cand[lane] : 0ull;
            const unsigned mh = (unsigned)(mine >> 32), ml = (unsigned)mine;
            const int cnt = rank64(mh, ml, n1);
            const int src2 = __ffsll((unsigned long long)__ballot(lane < n1 && cnt == rr - 1)) - 1;
            T = __shfl(mh, src2); istar = 0xFFFF - (int)(__shfl(ml, src2) & 0xFFFFu);
            asm volatile("s_waitcnt lgkmcnt(0)" ::: "memory");
            break;
        }
        lo = clo; hv = chi;
    }
    for (int i0 = 0; i0 < nreg; i0 += 4) { SEL_LOAD4(s4, row, i0);
#pragma unroll
        for (int k = 0; k < 4; ++k) { const unsigned kk = fkey(s4[k]); const int idx = 64 * (i0 + k) + lane;
            const unsigned long long m = __ballot(kk > T || (kk == T && idx <= istar));
            if (lane < 2 && i0 + k < nreg) mrow[2 * (i0 + k) + lane] = lane ? (unsigned)(m >> 32) : (unsigned)m; } }
}
__device__ __forceinline__ int zbin(float s, float scn, float scp) {
    const bool neg = s < 0.f; const int b = (int)__builtin_fmaf(s, neg ? scn : scp, neg ? 126.5f : 128.0f);
    return s == 0.f ? 127 : b;
}
__device__ __forceinline__ unsigned wave_prefix_sum(unsigned v) {
    v += (unsigned)__builtin_amdgcn_update_dpp(0, (int)v, 0x111, 0xF, 0xF, false);
    v += (unsigned)__builtin_amdgcn_update_dpp(0, (int)v, 0x112, 0xF, 0xF, false);
    v += (unsigned)__builtin_amdgcn_update_dpp(0, (int)v, 0x114, 0xF, 0xF, false);
    v += (unsigned)__builtin_amdgcn_update_dpp(0, (int)v, 0x118, 0xF, 0xF, false);
    v += (unsigned)__builtin_amdgcn_update_dpp(0, (int)v, 0x142, 0xA, 0xF, false);
    v += (unsigned)__builtin_amdgcn_update_dpp(0, (int)v, 0x143, 0xC, 0xF, false);
    return v;
}
template <bool TIE0, bool TIE1> __device__ __forceinline__ void count_pass(const LAS float* rowA, const LAS float* rowB, int nreg, const float (&scn)[2], const float (&scp)[2], const int (&bstar)[2], const int (&rr)[2],
                                                                           LAS unsigned long long* cand, LAS unsigned* mrowA, LAS unsigned* mrowB, int (&n1)[2], int lane) {
    for (int i0 = 0; i0 < nreg; i0 += 4) { SEL_LOAD4(sa, rowA, i0); SEL_LOAD4(sb, rowB, i0);
        unsigned wv_[2] = {0u, 0u};
#pragma unroll
        for (int k = 0; k < 4; ++k) {
#pragma unroll
            for (int e = 0; e < 2; ++e) { const float s = e ? sb[k] : sa[k]; const bool tie = e ? TIE1 : TIE0;
                const int bin = zbin(s, scn[e], scp[e]); const bool valid = i0 + k < nreg;
                unsigned long long ms = __ballot(valid && bin > bstar[e]); const unsigned long long mc = __ballot(valid && bin == bstar[e]);
                if (mc != 0ull) {
                    const int pos = n1[e] + __builtin_amdgcn_mbcnt_hi((unsigned)(mc >> 32), __builtin_amdgcn_mbcnt_lo((unsigned)mc, 0u)); const bool isc = (mc >> lane) & 1ull;
                    if (tie) ms |= __ballot(isc && pos < rr[e]);
                    else if (isc && pos < 64) cand[64 * e + pos] = ((unsigned long long)fkey(s) << 32) | (unsigned long long)(0xFFFFu - (unsigned)(64 * (i0 + k) + lane));
                    n1[e] += __popcll(mc); }
                { const unsigned mlo_ = (unsigned)ms, mhi_ = (unsigned)(ms >> 32);
                  asm volatile("v_writelane_b32 %0, %1, %2" : "+v"(wv_[e]) : "s"(mlo_), "n"(2 * k)); asm volatile("v_writelane_b32 %0, %1, %2" : "+v"(wv_[e]) : "s"(mhi_), "n"(2 * k + 1)); } } }
        if (lane < 8) { mrowA[2 * i0 + lane] = wv_[0]; mrowB[2 * i0 + lane] = wv_[1]; } }
}
__device__ __attribute__((noinline)) void select2(const LAS float* rowA, const LAS float* rowB, int nreg, LAS unsigned* hist, LAS unsigned* mrowA, LAS unsigned* mrowB, const LAS unsigned* qmm, int lane) {
    LAS unsigned long long* cand = (LAS unsigned long long*)hist;
    const LAS float* row[2] = {rowA, rowB}; LAS unsigned* mrow[2] = {mrowA, mrowB};
    float scn[2], scp[2];
#pragma unroll
    for (int e = 0; e < 2; ++e) { const float lo = ikey(qmm[2 * e]), hv = ikey(qmm[2 * e + 1]); scn[e] = lo < 0.f ? 126.5f / (0.f - lo) : 0.f; scp[e] = hv > 0.f ? 127.5f / hv : 0.f; }
    *(LAS u32x4*)(hist + 4 * lane) = (u32x4){0u, 0u, 0u, 0u};
    asm volatile("s_waitcnt lgkmcnt(0)" ::: "memory");
    for (int i0 = 0; i0 < nreg; i0 += 4) { SEL_LOAD4(sa, rowA, i0); SEL_LOAD4(sb, rowB, i0);
#pragma unroll
        for (int k = 0; k < 4; ++k) if (i0 + k < nreg) {
            __hip_atomic_fetch_add(hist + zbin(sa[k], scn[0], scp[0]), 1u, __ATOMIC_RELAXED, __HIP_MEMORY_SCOPE_WORKGROUP);
            __hip_atomic_fetch_add(hist + zbin(sb[k], scn[1], scp[1]), 0x10000u, __ATOMIC_RELAXED, __HIP_MEMORY_SCOPE_WORKGROUP); } }
    asm volatile("s_waitcnt lgkmcnt(0)" ::: "memory");
    const u32x4 cvp = *(const LAS u32x4*)(hist + 4 * lane);
    asm volatile("s_waitcnt lgkmcnt(0)" ::: "memory");
    int bstar[2], rr[2];
#pragma unroll
    for (int e = 0; e < 2; ++e) { unsigned cv[4];
#pragma unroll
        for (int k = 0; k < 4; ++k) cv[k] = (cvp[k] >> (16 * e)) & 0xFFFFu;
        const unsigned tot = cv[0] + cv[1] + cv[2] + cv[3]; const unsigned pre = wave_prefix_sum(tot);
        const unsigned S = (unsigned)__builtin_amdgcn_readlane((int)pre, 63) - pre + tot;
        const unsigned above = S - tot; const bool isit = (above < 256u) && (S >= 256u);
        int bl = -1; unsigned Gl = 0, cum = above;
#pragma unroll
        for (int k = 3; k >= 0; --k) { if (bl < 0) { if (cum + cv[k] >= 256u) { bl = 4 * lane + k; Gl = cum; } else cum += cv[k]; } }
        const int src = __ffsll((unsigned long long)__ballot(isit)) - 1;
        bstar[e] = __builtin_amdgcn_readlane(bl, src); rr[e] = 256 - __builtin_amdgcn_readlane((int)Gl, src); }
    int n1[2] = {0, 0};
    const bool t0 = bstar[0] == 127, t1 = bstar[1] == 127;
    if (!t0 && !t1) count_pass<false, false>(rowA, rowB, nreg, scn, scp, bstar, rr, cand, mrowA, mrowB, n1, lane);
    else if (t0 && !t1) count_pass<true, false>(rowA, rowB, nreg, scn, scp, bstar, rr, cand, mrowA, mrowB, n1, lane);
    else if (!t0 && t1) count_pass<false, true>(rowA, rowB, nreg, scn, scp, bstar, rr, cand, mrowA, mrowB, n1, lane);
    else count_pass<true, true>(rowA, rowB, nreg, scn, scp, bstar, rr, cand, mrowA, mrowB, n1, lane);
    asm volatile("s_waitcnt lgkmcnt(0)" ::: "memory");
#ifndef SEL_FAST_MAX
#define SEL_FAST_MAX 64
#endif
#pragma unroll
    for (int e = 0; e < 2; ++e) if (bstar[e] != 127 && n1[e] <= SEL_FAST_MAX) {
        const unsigned long long mine = lane < n1[e] ? cand[64 * e + lane] : 0ull; const unsigned mh = (unsigned)(mine >> 32), ml = (unsigned)mine;
        const int cnt = rank64(mh, ml, n1[e]);
        if (lane < n1[e] && cnt < rr[e]) { const unsigned idx = 0xFFFFu - (ml & 0xFFFFu); __hip_atomic_fetch_or(mrow[e] + (idx >> 5), 1u << (idx & 31u), __ATOMIC_RELAXED, __HIP_MEMORY_SCOPE_WORKGROUP); } }
    asm volatile("s_waitcnt lgkmcnt(0)" ::: "memory");
#pragma unroll
    for (int e = 0; e < 2; ++e) if (bstar[e] != 127 && n1[e] > SEL_FAST_MAX) {
        float clo = __builtin_inff(), chi = -__builtin_inff();
        for (int i0 = 0; i0 < nreg; i0 += 4) { SEL_LOAD4(s4, row[e], i0);
#pragma unroll
            for (int k = 0; k < 4; ++k) if (i0 + k < nreg && zbin(s4[k], scn[e], scp[e]) == bstar[e]) { clo = fminf(clo, s4[k]); chi = fmaxf(chi, s4[k]); } }
#pragma unroll
        for (int o = 1; o < 64; o <<= 1) { clo = fminf(clo, __shfl_xor(clo, o)); chi = fmaxf(chi, __shfl_xor(chi, o)); }
        select_slow(row[e], nreg, hist, cand, mrow[e], clo, chi, rr[e], lane); }
}
#undef SEL_LOAD4

__device__ __forceinline__ void build_relb(const float* relb, LAS unsigned char* lds, int tid) {
    LAS float* rb = (LAS float*)(lds + L_RELB);
    for (int e = tid; e < 8 * 224; e += 512) { const int h = e / 224, rel = e % 224 - 160; rb[e] = (relb[t5_bucket(rel) * 8 + h] - relb[15 * 8 + h]) * LOG2E; }
}
#ifdef TIMING_VARIANT
#define TV(bit) (variant & (bit))
#else
#define TV(bit) 0
#endif
__device__ __forceinline__ void attn_unit(const P& A, int b, int c, LAS unsigned char* lds, int tid, int variant) {
    const int lane = tid & 63, wv = __builtin_amdgcn_readfirstlane(tid >> 6), col = lane & 31, hi = lane >> 5;
    const int L = 64 * (c + 1), ntile = L / 32;
    const size_t tokb = (size_t)b * SEQ;
    LAS unsigned* maskw = (LAS unsigned*)(lds + L_MASK);
    LAS float* fb = (LAS float*)(lds + L_FBUF) + wv * 64;
    __syncthreads();
    if (c < 4 || TV(1)) {
        for (int e = tid; e < 64 * ntile; e += 512) { const int q = e / ntile, j = e % ntile; maskw[q * 65 + j] = 0xFFFFFFFFu; }
    } else {
        LAS float* sc = (LAS float*)lds; LAS unsigned* qmm = (LAS unsigned*)(lds + L_QMM);
        const int l15 = lane & 15, l4 = lane >> 4;
        h16x8 af[4][2]; f32x4 w4[4]; h16x8 bf[2][2], bn[2][2];
#define SC_LOAD_Q(rd_) do { _Pragma("unroll") for (int rt = 0; rt < 4; ++rt) { const size_t tqa = tokb + 64 * c + 16 * (rd_) + 4 * rt + (l15 >> 2); \
            _Pragma("unroll") for (int ks = 0; ks < 2; ++ks) af[rt][ks] = *(const h16x8*)(A.qidx() + tqa * 256 + (l15 & 3) * 64 + 32 * ks + 8 * l4); \
            w4[rt] = *(const f32x4*)(A.widx() + (tokb + 64 * c + 16 * (rd_) + 4 * rt + l4) * 4); } \
          { const h16* kp = A.kidx() + (tokb + 32 * wv + l15) * 64 + 8 * l4; \
            _Pragma("unroll") for (int u = 0; u < 2; ++u) _Pragma("unroll") for (int ks = 0; ks < 2; ++ks) bf[u][ks] = *(const h16x8*)(kp + u * 16 * 64 + 32 * ks); } } while (0)
        SC_LOAD_Q(0);
        for (int rd = 0; rd < 4; ++rd) {
            if (tid < 32) qmm[tid] = (tid & 1) ? 0u : 0xFFFFFFFFu;
            __syncthreads();
            float smn[4], smx[4];
#pragma unroll
            for (int rt = 0; rt < 4; ++rt) { smn[rt] = __builtin_inff(); smx[rt] = -__builtin_inff(); }
            for (int j = wv; j < ntile; j += 8) {
                if (j + 8 < ntile) { const h16* kp = A.kidx() + (tokb + 32 * (j + 8) + l15) * 64 + 8 * l4;
#pragma unroll
                    for (int u = 0; u < 2; ++u)
#pragma unroll
                        for (int ks = 0; ks < 2; ++ks) bn[u][ks] = *(const h16x8*)(kp + u * 16 * 64 + 32 * ks); }
#pragma unroll
                for (int u = 0; u < 2; ++u)
#pragma unroll
                    for (int rt = 0; rt < 4; ++rt) {
                        f32x4 acc = {0.f, 0.f, 0.f, 0.f};
                        acc = __builtin_amdgcn_mfma_f32_16x16x32_f16(af[rt][0], bf[u][0], acc, 0, 0, 0);
                        acc = __builtin_amdgcn_mfma_f32_16x16x32_f16(af[rt][1], bf[u][1], acc, 0, 0, 0);
                        float sv = fmaxf(acc[0], 0.f) * w4[rt][0]; sv += fmaxf(acc[1], 0.f) * w4[rt][1]; sv += fmaxf(acc[2], 0.f) * w4[rt][2]; sv += fmaxf(acc[3], 0.f) * w4[rt][3];
                        sv += 0.0f;
                        smn[rt] = fminf(smn[rt], sv); smx[rt] = fmaxf(smx[rt], sv);
                        sc[(4 * rt + l4) * SC_STRIDE + 32 * j + 16 * u + l15] = sv;
                    }
#pragma unroll
                for (int u = 0; u < 2; ++u)
#pragma unroll
                    for (int ks = 0; ks < 2; ++ks) bf[u][ks] = bn[u][ks];
            }
#pragma unroll
            for (int rt = 0; rt < 4; ++rt) { __hip_atomic_fetch_min(qmm + 2 * (4 * rt + l4), fkey(smn[rt]), __ATOMIC_RELAXED, __HIP_MEMORY_SCOPE_WORKGROUP); __hip_atomic_fetch_max(qmm + 2 * (4 * rt + l4) + 1, fkey(smx[rt]), __ATOMIC_RELAXED, __HIP_MEMORY_SCOPE_WORKGROUP); }
            if (rd + 1 < 4) SC_LOAD_Q(rd + 1);
            __syncthreads();
            if (!TV(16))
            select2(sc + (2 * wv) * SC_STRIDE, sc + (2 * wv + 1) * SC_STRIDE, L / 64, (LAS unsigned*)(lds + L_HIST) + wv * 256, maskw + (16 * rd + 2 * wv) * 65, maskw + (16 * rd + 2 * wv + 1) * 65, qmm + 4 * wv, lane);
            __syncthreads();
        }
    }
    if (!TV(2)) {
        const int h = wv;
        LAS h16* Ks = (LAS h16*)(lds + L_KS); LAS h16* Vs = (LAS h16*)(lds + L_VS);
        build_relb(A.relb, lds, tid);
        const LAS float* rb = (const LAS float*)(lds + L_RELB) + h * 224;
        h16x8 qf[2][4];
#pragma unroll
        for (int ct = 0; ct < 2; ++ct)
#pragma unroll
            for (int s = 0; s < 4; ++s) qf[ct][s] = *(const h16x8*)(A.qa() + (tokb + 64 * c + 32 * ct + col) * 512 + h * 64 + 16 * s + 8 * hi);
        f32x16 O[2][2]; float lsum[2], cref[2]; bool started[2] = {false, false};
        const h16 b15h = (h16)(A.relb[15 * 8 + h] * LOG2E);
#pragma unroll
        for (int ct = 0; ct < 2; ++ct) { O[ct][0] = (f32x16){}; O[ct][1] = (f32x16){}; lsum[ct] = 0.f; cref[ct] = (float)b15h; }
        const int srow = tid >> 3, spc = tid & 7;
        const h16* gk = A.ka() + (tokb + srow) * 64 + 8 * spc; const h16* gv = A.va() + (tokb + srow) * 64 + 8 * spc;
        LAS h16* kdst = Ks + srow * 72 + 8 * spc; LAS h16* vdst = Vs + srow * 72 + 8 * spc;
#define ATT_STAGE_K(stage, vk) do { *(LAS u32x4*)(kdst + (stage) * (64 * 72)) = (vk); } while (0)
#define ATT_STAGE_V(stage, vv) do { *(LAS u32x4*)(vdst + (stage) * (64 * 72)) = (vv); } while (0)
        const int nst = ntile / 2;
        u32x4 sreg = *(const u32x4*)gk; ATT_STAGE_K(0, sreg); sreg = *(const u32x4*)gv; ATT_STAGE_V(0, sreg);
        __syncthreads();
        for (int js = 0; js < nst; ++js) {
            const int st = js & 1;
            if (js + 1 < nst) sreg = *(const u32x4*)(gk + (size_t)(js + 1) * (64 * 64));
#pragma unroll 1
            for (int t2 = 0; t2 < 2; ++t2) {
            const int j = 2 * js + t2;
            const LAS h16* kb = Ks + st * (64 * 72) + (32 * t2 + col) * 72 + 8 * hi;
            h16x8 kf[4];
#pragma unroll
            for (int s = 0; s < 4; ++s) kf[s] = *(const LAS h16x8*)(kb + 16 * s);
            const bool far = j <= 2 * c - 4;
            const LAS h16* vb = Vs + st * (64 * 72) + (32 * t2 + 4 * hi + ((lane & 15) >> 2)) * 72 + 16 * ((lane >> 4) & 1) + 4 * (lane & 3);
            f32x16 sa[2];
#pragma unroll
            for (int ct = 0; ct < 2; ++ct) { const h16x8 qxt = {hi == 0 ? (h16)cref[ct] : (h16)0.0f, 0, 0, 0, 0, 0, 0, 0};
                const h16x8 kxt = {hi == 0 ? (h16)1.0f : (h16)0.0f, 0, 0, 0, 0, 0, 0, 0};
                sa[ct] = __builtin_amdgcn_mfma_f32_32x32x16_f16(kxt, qxt, (f32x16){}, 0, 0, 0);
#pragma unroll
                for (int s = 0; s < 4; ++s) sa[ct] = __builtin_amdgcn_mfma_f32_32x32x16_f16(kf[s], qf[ct][s], sa[ct], 0, 0, 0); }
            if (!far) {
#pragma unroll
                for (int ct = 0; ct < 2; ++ct) { const int rel0 = 32 * j - (64 * c + 32 * ct + col) + 160 + 4 * hi;
#pragma unroll
                    for (int r = 0; r < 16; ++r) sa[ct][r] += rb[rel0 + (r & 3) + 8 * (r >> 2)]; } }
#pragma unroll
            for (int ct = 0; ct < 2; ++ct) { const unsigned word = maskw[(32 * ct + col) * 65 + j] >> (4 * hi);
#pragma unroll
                for (int r = 0; r < 16; ++r) { const int neg = __builtin_amdgcn_sbfe((int)word, (r & 3) + 8 * (r >> 2), 1);
                    sa[ct][r] = __int_as_float((neg & __float_as_int(sa[ct][r])) | (~neg & (int)0xFF800000)); } }
            h16x8 p0[2], p1[2];
            if (TV(64)) {
#pragma unroll
                for (int ct = 0; ct < 2; ++ct) { p0[ct] = (h16x8){(h16)sa[ct][0], (h16)sa[ct][1], (h16)sa[ct][2], (h16)sa[ct][3], (h16)sa[ct][4], (h16)sa[ct][5], (h16)sa[ct][6], (h16)sa[ct][7]};
                    p1[ct] = (h16x8){(h16)sa[ct][8], (h16)sa[ct][9], (h16)sa[ct][10], (h16)sa[ct][11], (h16)sa[ct][12], (h16)sa[ct][13], (h16)sa[ct][14], (h16)sa[ct][15]}; } }
            else
            softmax_tile2(sa, cref, started, lsum, O, fb, lane, hi, p0, p1);
#pragma unroll
            for (int db = 0; db < 2; ++db) {
                const LAS h16* vp = vb + 32 * db;
                const h16x4 a0 = vtr(vp), a1 = vtr(vp + 8 * 72), c0 = vtr(vp + 16 * 72), c1 = vtr(vp + 24 * 72);
                const h16x8 v0 = {a0[0], a0[1], a0[2], a0[3], a1[0], a1[1], a1[2], a1[3]}, v1 = {c0[0], c0[1], c0[2], c0[3], c1[0], c1[1], c1[2], c1[3]};
#pragma unroll
                for (int ct = 0; ct < 2; ++ct) { O[ct][db] = __builtin_amdgcn_mfma_f32_32x32x16_f16(p0[ct], v0, O[ct][db], 0, 0, 0); O[ct][db] = __builtin_amdgcn_mfma_f32_32x32x16_f16(p1[ct], v1, O[ct][db], 0, 0, 0); }
            }
            if (js + 1 < nst) { if (t2 == 0) { ATT_STAGE_K(st ^ 1, sreg); sreg = *(const u32x4*)(gv + (size_t)(js + 1) * (64 * 64)); } else ATT_STAGE_V(st ^ 1, sreg); }
            }
            if (!TV(32)) __syncthreads();
#ifdef ATT_SKEW
            if (wv >= 4) __builtin_amdgcn_s_sleep(ATT_SKEW);
#endif
        }
#pragma unroll
        for (int ct = 0; ct < 2; ++ct) store_o(O[ct][0], O[ct][1], lsum[ct], fb + 32 * ct, lane, hi, A.out, tokb + 64 * c + 32 * ct, h * 64);
    }
    if (!TV(4)) {
        const int qg = wv >> 2, hm = wv & 3; const size_t tok0 = tokb + 64 * c + 32 * qg;
        h16x8 qf[4];
#pragma unroll
        for (int s = 0; s < 4; ++s) qf[s] = *(const h16x8*)(A.qm() + (tok0 + col) * 256 + hm * 64 + 16 * s + 8 * hi);
        f32x16 O0 = {}, O1 = {}; float lsum = 0.f, cref = 0.f; h16x8 qx = {0, 0, 0, 0, 0, 0, 0, 0}; bool started = false;
        const h16x8 kx = {hi == 0 ? (h16)1.0f : (h16)0.0f, 0, 0, 0, 0, 0, 0, 0};
        const h16* kbase = A.mk() + ((size_t)b * MEMT + col) * 256 + hm * 64 + 8 * hi;
        const h16* vbase = A.mvT() + (((size_t)b * 4 + hm) * 64 + col) * MEMT + 4 * hi;
        h16x8 kf[4], kn[4]; h16x4 vf[8], vn[8];
#pragma unroll
        for (int s = 0; s < 4; ++s) kf[s] = *(const h16x8*)(kbase + 16 * s);
#pragma unroll
        for (int db = 0; db < 2; ++db)
#pragma unroll
            for (int q4 = 0; q4 < 4; ++q4) vf[4 * db + q4] = *(const h16x4*)(vbase + (size_t)db * 32 * MEMT + 8 * q4);
        for (int j = 0; j < MEMT / 32; ++j) {
            if (j + 1 < MEMT / 32) {
#pragma unroll
                for (int s = 0; s < 4; ++s) kn[s] = *(const h16x8*)(kbase + (size_t)(j + 1) * 32 * 256 + 16 * s);
#pragma unroll
                for (int db = 0; db < 2; ++db)
#pragma unroll
                    for (int q4 = 0; q4 < 4; ++q4) vn[4 * db + q4] = *(const h16x4*)(vbase + (size_t)db * 32 * MEMT + 32 * (j + 1) + 8 * q4); }
            f32x16 sa = __builtin_amdgcn_mfma_f32_32x32x16_f16(kx, qx, (f32x16){}, 0, 0, 0);
#pragma unroll
            for (int s = 0; s < 4; ++s) sa = __builtin_amdgcn_mfma_f32_32x32x16_f16(kf[s], qf[s], sa, 0, 0, 0);
            h16x8 p0, p1;
            softmax_tile(sa, cref, qx, started, lsum, O0, O1, fb, lane, hi, p0, p1);
#pragma unroll
            for (int db = 0; db < 2; ++db) {
                const h16x4 a0 = vf[4 * db], a1 = vf[4 * db + 1], c0 = vf[4 * db + 2], c1 = vf[4 * db + 3];
                const h16x8 v0 = {a0[0], a0[1], a0[2], a0[3], a1[0], a1[1], a1[2], a1[3]}, v1 = {c0[0], c0[1], c0[2], c0[3], c1[0], c1[1], c1[2], c1[3]};
                if (db == 0) { O0 = __builtin_amdgcn_mfma_f32_32x32x16_f16(p0, v0, O0, 0, 0, 0); O0 = __builtin_amdgcn_mfma_f32_32x32x16_f16(p1, v1, O0, 0, 0, 0); }
                else { O1 = __builtin_amdgcn_mfma_f32_32x32x16_f16(p0, v0, O1, 0, 0, 0); O1 = __builtin_amdgcn_mfma_f32_32x32x16_f16(p1, v1, O1, 0, 0, 0); }
            }
#pragma unroll
            for (int s = 0; s < 4; ++s) kf[s] = kn[s];
#pragma unroll
            for (int q8 = 0; q8 < 8; ++q8) vf[q8] = vn[q8];
        }
        store_o(O0, O1, lsum, fb, lane, hi, A.out, tok0, 512 + hm * 64);
    }
}

}
#ifndef MK_N_LAUNCHES
#define MK_N_LAUNCHES 1
#endif
constexpr int N_PHASES = 12;
constexpr int NWAVES = 8;
constexpr size_t MiB = 1u << 20;
constexpr size_t WS_CTL = 0, CTL_ZERO_BYTES = 1 * MiB;
constexpr size_t WS_W1A = 1 * MiB, WS_W1B = 12 * MiB, WS_WIN = 18 * MiB, WS_WMKV = 27 * MiB, WS_WGLU = 28 * MiB, WS_WOA = 29 * MiB, WS_WOM = 30 * MiB, WS_WOUT = 31 * MiB,
                 WS_W2A = 33 * MiB, WS_W2B = 44 * MiB, WS_TCAT = 50 * MiB, WS_WST = 90 * MiB;
constexpr size_t WS_RSTD0 = 98 * MiB, WS_SSQ1 = 99 * MiB, WS_SSQ2 = 103 * MiB, WS_SSQ3 = 107 * MiB, WS_MEMH = 111 * MiB, WS_MK = 127 * MiB, WS_MVT = 131 * MiB, WS_A64 = 135 * MiB;
constexpr size_t WS_ABUF = 136 * MiB;
constexpr size_t WS_CBUF = 264 * MiB;
constexpr size_t WS_YS = WS_CBUF + 96 * MiB;
constexpr size_t WS_BIG = 392 * MiB;
constexpr size_t WS_QA = WS_BIG, WS_QIDX = WS_BIG + 64 * MiB, WS_QM = WS_BIG + 96 * MiB, WS_OB = WS_BIG  ,
                 WS_KA = WS_BIG + 128 * MiB, WS_VAT = WS_BIG + 136 * MiB, WS_KIDX = WS_BIG + 144 * MiB, WS_WIDX = WS_BIG + 152 * MiB, WS_ACAT = WS_BIG + 153 * MiB, WS_GATES = WS_BIG + 193 * MiB;
constexpr size_t WS_END = WS_GATES + 384 * MiB;
static_assert(WS_END <= 1024 * MiB, "workspace map");
constexpr int CW_BAR = 4096, CW_FIN = 16384;

constexpr int LDS_BYTES = 163840;
constexpr int MISC_OFF = LDS_BYTES - 256;

#define XB_TMO      128
#define XB_XCNT(j)  (256  + 64 * (j))
#define XB_XSUB(j)  (1280 + 64 * (j))
#define XB_XGEN(j)  (2304 + 64 * (j))
#define XB_TOP      3328
#define XB_TOPGEN   3392
#define XCD_BAR_WORDS 3456
#define XB_SPIN_CAP (1u << 18)
__device__ __forceinline__ unsigned xb_ld(unsigned* p)              { return __hip_atomic_load(p, __ATOMIC_RELAXED, __HIP_MEMORY_SCOPE_AGENT); }
__device__ __forceinline__ unsigned xb_add(unsigned* p, unsigned v) { return __hip_atomic_fetch_add(p, v, __ATOMIC_RELAXED, __HIP_MEMORY_SCOPE_AGENT); }
__device__ __forceinline__ unsigned xb_xcc_id() { return (unsigned)__builtin_amdgcn_s_getreg((3 << 11) | 20) & 0xFu; }
#define XB_SPIN(cond, bar) do { unsigned _sp = 0; while (cond) { __builtin_amdgcn_s_sleep(1); \
    if ((++_sp & 255u) == 0u) { if (xb_ld(&(bar)[XB_TMO])) break; if (_sp > XB_SPIN_CAP) { atomicAdd(&(bar)[XB_TMO], 1u); break; } } } } while (0)
struct XcdBarrier { unsigned* bar; unsigned x; volatile LAS unsigned* st; };
__device__ __forceinline__ XcdBarrier xcd_barrier_post(unsigned* bar, volatile LAS unsigned* st) {
    XcdBarrier b; b.bar = bar; b.x = xb_xcc_id(); b.st = st;
    if (threadIdx.x == 0) (void)xb_add(&bar[XB_XCNT(b.x)], 1u);
    return b;
}
__device__ __forceinline__ void xcd_barrier_complete(unsigned* bar, unsigned x, unsigned& nloc, unsigned& nx) {
    const unsigned G = gridDim.x * gridDim.y * gridDim.z;
    unsigned sum, cnt, mine, sp = 0u;
    for (;;) {
        sum = 0u; cnt = 0u; mine = 0u;
#pragma unroll
        for (unsigned j = 0; j < 16; ++j) { const unsigned c = xb_ld(&bar[XB_XCNT(j)]); sum += c; cnt += (c > 0u) ? 1u : 0u; mine = (j == x) ? c : mine; }
        if (sum == G) break;
        __builtin_amdgcn_s_sleep(1);
        if ((++sp & 255u) == 0u) { if (xb_ld(&bar[XB_TMO])) break; if (sp > XB_SPIN_CAP) { atomicAdd(&bar[XB_TMO], 1u); break; } }
    }
    nloc = mine > 0u ? mine : 1u; nx = cnt > 0u ? cnt : 1u;
}
__device__ __forceinline__ void xcd_barrier(const XcdBarrier& b) {
    asm volatile("s_waitcnt vmcnt(0)" ::: "memory");
    __syncthreads();
    if (threadIdx.x == 0) {
        unsigned* bar = b.bar;
        __builtin_amdgcn_s_waitcnt(0);
        unsigned nloc = b.st[0], nx = b.st[1];
        if (nloc == 0u) { xcd_barrier_complete(bar, b.x, nloc, nx); b.st[0] = nloc; b.st[1] = nx; }
        const unsigned old = xb_add(&bar[XB_XSUB(b.x)], 1u);
        const unsigned gen = old / nloc;
        if (old + 1u == (gen + 1u) * nloc) {
            __builtin_amdgcn_fence(__ATOMIC_RELEASE, "agent");
            asm volatile("s_waitcnt vmcnt(0)" ::: "memory");
            const unsigned og = xb_add(&bar[XB_TOP], 1u);
            const unsigned tg = og / nx;
            if (og + 1u == (tg + 1u) * nx) xb_add(&bar[XB_TOPGEN], 1u);
            else XB_SPIN(xb_ld(&bar[XB_TOPGEN]) == tg, bar);
            __builtin_amdgcn_fence(__ATOMIC_ACQUIRE, "agent");
            xb_add(&bar[XB_XGEN(b.x)], 1u);
            asm volatile("s_waitcnt vmcnt(0)" ::: "memory");
        } else {
            XB_SPIN(xb_ld(&bar[XB_XGEN(b.x)]) == gen, bar);
            __builtin_amdgcn_fence(__ATOMIC_ACQUIRE, "agent");
            asm volatile("s_waitcnt vmcnt(0)" ::: "memory");
        }
    }
    __syncthreads();
}

enum { I_X = 0, I_MEM, I_FFN1_NORM, I_FFN1_WIN, I_FFN1_WOUT, I_MIX_NORM, I_W_IN, I_AQG, I_AKG, I_RELB, I_WOA, I_LRE, I_LIM, I_LOGDT, I_BRE, I_BIM, I_CRE, I_CIM, I_SSMD, I_WGLU,
       I_MEM_NORM, I_WMKV, I_MQG, I_MKG, I_WOM, I_WOUT, I_FFN2_NORM, I_FFN2_WIN, I_FFN2_WOUT, I_FINAL_NORM, N_IN };
struct Args { const float* in[N_IN]; float* out; unsigned char* ws; int ph_lo, ph_hi, variant, pad; };
static_assert(sizeof(Args) == (N_IN + 2) * 8 + 16, "Args has no padding");

__global__ void __launch_bounds__(NWAVES * 64, 2) mega_fwd(Args args) {
    extern __shared__ __attribute__((aligned(16))) unsigned char lds_raw[];
    LAS unsigned char* lds = (LAS unsigned char*)lds_raw;
    volatile LAS unsigned* MISC = (volatile LAS unsigned*)(lds + MISC_OFF);
    const int tid = threadIdx.x, lane = tid & 63, wave = __builtin_amdgcn_readfirstlane(tid >> 6);
    const int G = gridDim.x; const int bx = blockIdx.x; const int vcu = (G % 8 == 0) ? (bx % 8) * (G / 8) + bx / 8 : bx;
    unsigned char* ws = args.ws;
    unsigned* ctl = (unsigned*)(ws + WS_CTL);
    for (int u = tid; u < 64; u += NWAVES * 64) MISC[u] = 0u;
    __syncthreads();
    const int lo = args.ph_lo, hi = args.ph_hi;
    XcdBarrier bar; bar.bar = ctl + CW_BAR; bar.x = 0; bar.st = nullptr;
    if (hi - lo > 1) bar = xcd_barrier_post(ctl + CW_BAR, MISC + 8);
#ifdef ONLY_PHASE
#define IN(k) ((k) == ONLY_PHASE && lo <= (k) && (k) < hi)
#else
#define IN(k) (lo <= (k) && (k) < hi)
#endif
#ifdef DBG_SPIN
#define SEAM(k) do { if (IN(k) && IN((k) + 1)) xcd_barrier(bar); if (bx == 0 && tid == 0) ((unsigned long long*)(ctl + 9100))[(k) + 1] = __builtin_amdgcn_s_memrealtime(); } while (0)
#else
#define SEAM(k) do { if (IN(k) && IN((k) + 1)) xcd_barrier(bar); } while (0)
#endif

    float* const xres = args.out;
#define WSP(T, off) ((T*)(ws + (off)))
#define W1A WSP(h16, WS_W1A)
#define W1B WSP(h16, WS_W1B)
#define WIN WSP(h16, WS_WIN)
#define WMKV WSP(h16, WS_WMKV)
#define WGLU WSP(h16, WS_WGLU)
#define WOA WSP(h16, WS_WOA)
#define WOM WSP(h16, WS_WOM)
#define WOUT WSP(h16, WS_WOUT)
#define W2A WSP(h16, WS_W2A)
#define W2B WSP(h16, WS_W2B)
#define TCAT WSP(h16, WS_TCAT)
#define WST WSP(h16, WS_WST)
#define rstd0 WSP(float, WS_RSTD0)
#define ssq1 WSP(float, WS_SSQ1)
#define ssq2 WSP(float, WS_SSQ2)
#define ssq3 WSP(float, WS_SSQ3)
#define memh WSP(h16, WS_MEMH)
#define mk WSP(h16, WS_MK)
#define mvT WSP(h16, WS_MVT)
#define a64 WSP(float, WS_A64)
#define abuf WSP(h16, WS_ABUF)
#define mergedb ((h16*)args.out)
#define acatt WSP(h16, WS_CBUF)
#define ys WSP(h16, WS_YS)
#define x2h WSP(h16, WS_CBUF)
#define hidden WSP(h16, WS_BIG)
#define qa WSP(h16, WS_QA)
#define qidx WSP(h16, WS_QIDX)
#define qm WSP(h16, WS_QM)
#define ob WSP(h16, WS_OB)
#define ka WSP(h16, WS_KA)
#define va WSP(h16, WS_VAT)
#define kidx WSP(h16, WS_KIDX)
#define widx WSP(float, WS_WIDX)
#define acat WSP(h16, WS_ACAT)
#define gates WSP(h16, WS_GATES)
#ifdef DBG_SPIN
    if (bx == 0 && tid == 0) ((unsigned long long*)(ctl + 9100))[0] = __builtin_amdgcn_s_memrealtime();
#endif
    if (IN(0)) {
        const int gw = vcu * NWAVES + wave, NGW = G * NWAVES;
        LAS float* scr = (LAS float*)(lds + wave * 16384);
        pro::WPtrs WP{args.in[I_FFN1_WIN], args.in[I_FFN1_WOUT], args.in[I_W_IN], args.in[I_WMKV], args.in[I_WGLU], args.in[I_WOA], args.in[I_WOM], args.in[I_WOUT], args.in[I_FFN2_WIN], args.in[I_FFN2_WOUT],
                      args.in[I_FFN1_NORM], args.in[I_MIX_NORM], args.in[I_FFN2_NORM], W1A, W1B, WIN, WMKV, WGLU, WOA, WOM, WOUT, W2A, W2B};
        for (int it = gw; it < pro::IT_TOTAL; it += NGW) pro::weight_item(WP, it, scr, lane);
        for (int m = gw; m < MTOK; m += 4 * NGW) pro::rows_to_h16<4>(args.in[I_X], abuf, m, NGW, MTOK, nullptr, rstd0, lane);
        for (int m = gw; m < BATCH * MEMT; m += 4 * NGW) pro::rows_to_h16<4>(args.in[I_MEM], memh, m, NGW, BATCH * MEMT, args.in[I_MEM_NORM], nullptr, lane);
        for (int i = (vcu * NWAVES + wave) * 64 + lane; i < MTOK; i += G * NWAVES * 64) { ssq1[i] = 0.f; ssq2[i] = 0.f; ssq3[i] = 0.f; }
        pro::S5In SI{args.in[I_LRE], args.in[I_LIM], args.in[I_LOGDT], args.in[I_BRE], args.in[I_BIM], args.in[I_CRE], args.in[I_CIM], args.in[I_SSMD]};
        for (int it = vcu; it < 16 * 64; it += G) pro::s5_item(SI, it >> 6, it & 63, TCAT, WST, a64, (LAS float*)lds, tid);
        __syncthreads();
    }
    SEAM(0);
    if (IN(1)) {
#ifdef DBG_CLOCK
        unsigned long long t0w_ = __builtin_amdgcn_s_memrealtime();
        if (bx == 0 && tid == 0) { ((unsigned long long*)(ctl + 9000))[0] = __builtin_amdgcn_s_memtime(); ((unsigned long long*)(ctl + 9000))[1] = t0w_; }
#endif
        pg8::Gemm g{abuf, W1A, 1024, 1024, 1024}; pg8::StaticOrder S; S.init(MTOK, 2 * FFN, G, bx);
        epi::EpiSwiglu<0> E{hidden, rstd0};
        pg8::gemm_phase<epi::EpiSwiglu<0>, pg8::StaticOrder, true, true>(lds, g, S, E);
#ifdef DBG_CLOCK
        if (tid == 0) { const unsigned d_ = (unsigned)(__builtin_amdgcn_s_memrealtime() - t0w_); atomicMax(ctl + 9016, d_); atomicMin(ctl + 9017, ~0u - d_ == 0 ? 0 : d_ ); atomicMax(ctl + 9018, ~d_); }
        if (bx == 0 && tid == 0) { ((unsigned long long*)(ctl + 9000))[2] = __builtin_amdgcn_s_memtime(); ((unsigned long long*)(ctl + 9000))[3] = __builtin_amdgcn_s_memrealtime(); }
#endif
    }
    SEAM(1);
    if (IN(2)) {
        { pg8::Gemm g{hidden, W1B, FFN, FFN, FFN}; pg8::StaticOrder S; S.init(MTOK, DM, G, bx);
          epi::EpiResid<false> E{args.in[I_X], abuf, ssq1, 0.5f};
          pg8::gemm_phase<epi::EpiResid<false>, pg8::StaticOrder, true, true>(lds, g, S, E); }
        { pg8::Gemm g{memh, WMKV, 1024, 1024, 1024}; pg8::StaticOrder S; S.init(BATCH * MEMT, 512, G, bx);
          epi::EpiMemKV E{args.in[I_MKG], mk, mvT};
          pg8::gemm_phase<epi::EpiMemKV, pg8::StaticOrder, true, true>(lds, g, S, E); }
    }
    SEAM(2);
    if (IN(3)) {
        pg8::Gemm g{abuf, WIN, 1024, 1024, 1024}; pg8::StaticOrder S; S.init(MTOK, NWIN, G, bx);
        epi::EpiWin E{ssq1, args.in[I_AQG], args.in[I_AKG], args.in[I_MQG], qa, ka, va, qidx, kidx, acat, qm, gates, widx};
        pg8::gemm_phase<epi::EpiWin, pg8::StaticOrder, true, true>(lds, g, S, E);
    }
    SEAM(3);
    if (IN(4)) {
        const int variant = args.variant;
        if (!TV(8)) { pg8::Gemm g{acat, WST, 1024, 1280, 1024}; pg8::DiagOrder S; S.init(16, 4, 1, G, bx);
          epi::EpiS5State E{args.in[I_LOGDT], a64, acat};
          pg8::gemm_phase<epi::EpiS5State, pg8::DiagOrder, false, true>(lds, g, S, E); }
        __syncthreads();
        static_assert(WS_QIDX == WS_QA + 64 * MiB && WS_QM == WS_QA + 96 * MiB && WS_KA == WS_QA + 128 * MiB && WS_VAT == WS_QA + 136 * MiB && WS_KIDX == WS_QA + 144 * MiB && WS_WIDX == WS_QA + 152 * MiB && WS_MVT == WS_MK + 4 * MiB, "att::P offsets");
        att::P AP{ws + WS_QA, ws + WS_MK, args.in[I_RELB], variant ? mergedb : acatt};
        if (G == 256) {
            const int b = vcu >> 3, s = vcu & 7;
            for (int i = 0; i < 4; ++i) { const int c = i == 0 ? s : i == 1 ? 31 - s : i == 2 ? 8 + s : 23 - s; att::attn_unit(AP, b, c, lds, tid, variant); }
        } else {
            for (int u = vcu; u < BATCH * 32; u += G) att::attn_unit(AP, u >> 5, u & 31, lds, tid, variant);
        }
        __syncthreads();
    }
    SEAM(4);
    if (IN(5)) {
        pg8::Gemm g{acat, TCAT, 1280, 1280, 1280}; pg8::DiagOrder S; S.init(16, 4, 4, G, bx);
        epi::EpiS5Main E{args.in[I_LOGDT], ys};
        pg8::gemm_phase<epi::EpiS5Main, pg8::DiagOrder, true, true>(lds, g, S, E);
    }
    SEAM(5);
    if (IN(6)) {
        pg8::Gemm g{ys, WGLU, 256, 256, 256}; pg8::StaticOrder S; S.init(MTOK, 2048, G, bx);
        epi::EpiGlu E{ob};
        pg8::gemm_phase<epi::EpiGlu, pg8::StaticOrder, true, true>(lds, g, S, E);
    }
    SEAM(6);
    if (IN(7)) {
#ifdef STAGGER_US
        if (vcu & 1) { const unsigned long long t0 = __builtin_amdgcn_s_memrealtime(); while (__builtin_amdgcn_s_memrealtime() - t0 < (unsigned long long)(STAGGER_US * 100)) __builtin_amdgcn_s_sleep(16); }
#endif
        pg8::Gemm ga{acatt, WOA, 512, 768, 512}, gm{acatt + 512, WOM, 256, 768, 256}; pg8::StaticOrder S; S.init(MTOK, DM, G, bx);
        epi::EpiMerge2 E{gates, ob, mergedb};
        pg8::gemm_phase<epi::EpiMerge2, pg8::StaticOrder, true, true, true>(lds, ga, S, E, gm);
    }
    SEAM(7);
    if (IN(8)) {
        pg8::Gemm g{mergedb, WOUT, 1024, 1024, 1024}; pg8::StaticOrder S; S.init(MTOK, DM, G, bx);
        epi::EpiResid<true> E{abuf, x2h, ssq2, 1.0f};
        pg8::gemm_phase<epi::EpiResid<true>, pg8::StaticOrder, true, true>(lds, g, S, E);
    }
    SEAM(8);
#ifdef DBG_P1AGAIN
    if (IN(9)) {
        pg8::Gemm g{abuf, W1A, 1024, 1024, 1024}; pg8::StaticOrder S; S.init(MTOK, 2 * FFN, G, bx);
        epi::EpiSwiglu<0> E{hidden, rstd0};
        pg8::gemm_phase<epi::EpiSwiglu<0>, pg8::StaticOrder, true, true>(lds, g, S, E);
        if (hi - lo > 1) xcd_barrier(bar);
    }
#endif
    if (IN(9)) {
        pg8::Gemm g{x2h, W2A, 1024, 1024, 1024}; pg8::StaticOrder S; S.init(MTOK, 2 * FFN, G, bx);
        epi::EpiSwiglu<1> E{hidden, ssq2};
        pg8::gemm_phase<epi::EpiSwiglu<1>, pg8::StaticOrder, true, true>(lds, g, S, E);
    }
    SEAM(9);
    if (IN(10)) {
        pg8::Gemm g{hidden, W2B, FFN, FFN, FFN}; pg8::StaticOrder S; S.init(MTOK, DM, G, bx);
        epi::EpiFinal E{x2h, xres, ssq3, ctl + CW_FIN, args.in[I_FINAL_NORM], 0.5f};
        pg8::gemm_phase<epi::EpiFinal, pg8::StaticOrder, true, true>(lds, g, S, E);
    }
#ifdef DBG_SPIN
    if (bx == 0 && tid == 0) { const unsigned long long te = __builtin_amdgcn_s_memrealtime(); volatile unsigned long long* st = (volatile unsigned long long*)(ctl + 9100);
        const unsigned long long tb = DBG_SPIN == 11 ? te : st[DBG_SPIN + 1]; const unsigned long long d = tb - st[DBG_SPIN];
        while (__builtin_amdgcn_s_memrealtime() - te < 9ull * d) __builtin_amdgcn_s_sleep(32); }
#endif
#undef IN
#undef SEAM
#undef WSP
#undef W1A
#undef W1B
#undef WIN
#undef WMKV
#undef WGLU
#undef WOA
#undef WOM
#undef WOUT
#undef W2A
#undef W2B
#undef TCAT
#undef WST
#undef rstd0
#undef ssq1
#undef ssq2
#undef ssq3
#undef memh
#undef mk
#undef mvT
#undef a64
#undef abuf
#undef mergedb
#undef acatt
#undef ys
#undef x2h
#undef hidden
#undef qa
#undef qidx
#undef qm
#undef ob
#undef ka
#undef va
#undef kidx
#undef widx
#undef acat
#undef gates
}

#ifdef DBG_CLOCK
#ifndef DBG_Q
#define DBG_Q 3.0f
#endif
__global__ void clk_report(float* out, unsigned* ctl) {
    const unsigned long long* t = (const unsigned long long*)(ctl + 9000);
    const double cyc = (double)(t[2] - t[0]), wall = (double)(t[3] - t[1]) * 10.0;
#if DBG_CLOCK == 1
    const float code = (float)(cyc / 352.0 / 100.0);
#elif DBG_CLOCK == 2
    const float code = (float)(wall / 352.0 / 100.0);
#elif DBG_CLOCK == 3
    const float code = (float)(cyc / wall * 10.0);
#elif DBG_CLOCK == 4
    const float code = (float)((double)ctl[9016] * 10.0 / 352.0 / 25.0);
#else
    const float code = (float)((double)(~ctl[9018]) * 10.0 / 352.0 / 25.0);
#endif
    const float c = sqrtf(fmaxf(floorf(code / DBG_Q) * DBG_Q - 1.0f, 0.0f));
    for (size_t i = (size_t)blockIdx.x * blockDim.x + threadIdx.x; i < (size_t)MTOK * DM; i += (size_t)gridDim.x * blockDim.x) out[i] = c;
}
#endif
#ifndef DBG_TOL
#define DBG_TOL 0.03f
#endif
extern "C" void kernel_launch(void* const* d_in, const int* in_sizes, int n_in, void* d_out, int out_size, void* d_ws, size_t ws_size, hipStream_t stream) {
    static int grid = 0;
    if (grid == 0) {
        if (n_in != N_IN || in_sizes[0] != MTOK * DM || out_size != MTOK * DM || ws_size < WS_END) { fprintf(stderr, "kernel_launch: unexpected shapes (n_in %d, ws %zu)\n", n_in, ws_size); grid = -1; return; }
        int dev = 0, cus = 0, per_cu = 0;
        if (hipGetDevice(&dev) != hipSuccess || hipDeviceGetAttribute(&cus, hipDeviceAttributeMultiprocessorCount, dev) != hipSuccess) { grid = -1; return; }
        if (hipFuncSetAttribute((const void*)mega_fwd, hipFuncAttributeMaxDynamicSharedMemorySize, LDS_BYTES) != hipSuccess) { fprintf(stderr, "kernel_launch: hipFuncSetAttribute failed\n"); grid = -1; return; }
        if (hipOccupancyMaxActiveBlocksPerMultiprocessor(&per_cu, (const void*)mega_fwd, NWAVES * 64, LDS_BYTES) != hipSuccess || per_cu < 1) fprintf(stderr, "kernel_launch: occupancy query reports %d\n", per_cu);
        (void)hipGetLastError();
        grid = cus;
    }
    if (grid < 0) return;
    (void)hipMemsetAsync((char*)d_ws + WS_CTL, 0, CTL_ZERO_BYTES, stream);
    Args a{};
    for (int i = 0; i < N_IN; ++i) a.in[i] = (const float*)d_in[i];
    a.out = (float*)d_out; a.ws = (unsigned char*)d_ws;
#if MK_N_LAUNCHES == 1
    a.ph_lo = 0; a.ph_hi = N_PHASES;
    hipLaunchKernelGGL(mega_fwd, dim3(grid), dim3(NWAVES * 64), LDS_BYTES, stream, a);
#else
    for (int p = 0; p < N_PHASES; ++p) { a.ph_lo = p; a.ph_hi = p + 1; hipLaunchKernelGGL(mega_fwd, dim3(grid), dim3(NWAVES * 64), LDS_BYTES, stream, a);
#ifdef REP_PHASE
        if (p == REP_PHASE) for (int rep_ = 1; rep_ < REP_COUNT; ++rep_) { Args a2 = a;
#ifdef TIMING_VARIANT
            a2.variant = TIMING_VARIANT;
#endif
            hipLaunchKernelGGL(mega_fwd, dim3(grid), dim3(NWAVES * 64), LDS_BYTES, stream, a2); }
#endif
#ifdef DBG_CLOCK
        if (p == N_PHASES - 1) hipLaunchKernelGGL(clk_report, dim3(1024), dim3(256), 0, stream, (float*)d_out, (unsigned*)d_ws);
#endif
#ifdef DBG_CHECK
        unsigned char* ws = (unsigned char*)d_ws; unsigned* ctl = (unsigned*)ws; const float* const* in = a.in; float* out = (float*)d_out;
        dbg::ProjBufs PB{(h16*)(ws + WS_QA), (h16*)(ws + WS_KA), (h16*)(ws + WS_VAT), (h16*)(ws + WS_QIDX), (h16*)(ws + WS_KIDX), (h16*)(ws + WS_ACAT), (h16*)(ws + WS_QM), (h16*)(ws + WS_GATES), (float*)(ws + WS_WIDX)};
        if (p == 2) { hipLaunchKernelGGL(dbg::chk_ffn, dim3(8), dim3(256), 0, stream, in[I_X], in[I_FFN1_NORM], in[I_FFN1_WIN], in[I_FFN1_WOUT], (const float*)out, ctl, 1);
                      hipLaunchKernelGGL(dbg::chk_memkv, dim3(4), dim3(256), 0, stream, in[I_MEM], in[I_MEM_NORM], in[I_WMKV], in[I_MKG], (const h16*)(ws + WS_MK), (const h16*)(ws + WS_MVT), ctl); }
        if (p == 3) hipLaunchKernelGGL(dbg::chk_proj, dim3(4), dim3(256), 0, stream, (const float*)out, in[I_MIX_NORM], in[I_W_IN], in[I_AQG], in[I_AKG], in[I_MQG], PB, ctl);
        if (p == 4) { hipLaunchKernelGGL(dbg::chk_attn, dim3(8), dim3(256), 0, stream, PB, in[I_RELB], (const h16*)(ws + WS_CBUF), ctl);
                      hipLaunchKernelGGL(dbg::chk_mem, dim3(8), dim3(256), 0, stream, (const h16*)(ws + WS_QM), (const h16*)(ws + WS_MK), (const h16*)(ws + WS_MVT), (const h16*)(ws + WS_CBUF), ctl); }
        if (p == 5) hipLaunchKernelGGL(dbg::chk_s5, dim3(8), dim3(64), 0, stream, (const h16*)(ws + WS_ACAT), in[I_LRE], in[I_LIM], in[I_LOGDT], in[I_BRE], in[I_BIM], in[I_CRE], in[I_CIM], in[I_SSMD], (const h16*)(ws + WS_YS), ctl);
        if (p == 6) hipLaunchKernelGGL(dbg::chk_glu, dim3(4), dim3(256), 0, stream, (const h16*)(ws + WS_YS), in[I_WGLU], (const h16*)(ws + WS_OB), ctl);
        if (p == 7) hipLaunchKernelGGL(dbg::chk_merge, dim3(8), dim3(256), 0, stream, (const h16*)(ws + WS_CBUF), (const h16*)(ws + WS_OB), (const h16*)(ws + WS_GATES), in[I_WOA], in[I_WOM], (const h16*)(ws + WS_ABUF), (const float*)out, in[I_WOUT], ctl);
        if (p == 8) hipLaunchKernelGGL(dbg::chk_x2, dim3(8), dim3(256), 0, stream, (const float*)out, ctl);
        if (p == N_PHASES - 1) hipLaunchKernelGGL(dbg::chk_report, dim3(1024), dim3(256), 0, stream, out, ctl, DBG_TOL);
#endif
    }
#endif
}
```

```cpp
#define MK_N_LAUNCHES 1
#include <hip/hip_runtime.h>
#include <cstdio>
#include <cstdint>

#define GAS __attribute__((address_space(1)))
#define LAS __attribute__((address_space(3)))
typedef _Float16 h16;
typedef _Float16 h16x8 __attribute__((ext_vector_type(8)));
typedef _Float16 h16x4 __attribute__((ext_vector_type(4)));
typedef _Float16 h16x2 __attribute__((ext_vector_type(2)));
typedef float f32x2 __attribute__((ext_vector_type(2)));
typedef float f32x4 __attribute__((ext_vector_type(4)));
typedef float f32x16 __attribute__((ext_vector_type(16)));
typedef unsigned u32x4 __attribute__((ext_vector_type(4)));
typedef unsigned u32x2 __attribute__((ext_vector_type(2)));

constexpr int BATCH = 32, SEQ = 2048, DM = 1024, MTOK = BATCH * SEQ, FFN = 2816;
constexpr int NWIN = 4608;
constexpr int MEMT = 256;
constexpr float NORM_EPS = 1e-6f;
constexpr float LOG2E = 1.4426950408889634f;

__device__ __forceinline__ unsigned pk2h(float lo, float hi) { f32x2 v = {lo, hi}; h16x2 p = __builtin_convertvector(v, h16x2); return __builtin_bit_cast(unsigned, p); }
__device__ __forceinline__ u32x4 pk8h(f32x4 a, f32x4 b) { u32x4 w; w.x = pk2h(a[0], a[1]); w.y = pk2h(a[2], a[3]); w.z = pk2h(b[0], b[1]); w.w = pk2h(b[2], b[3]); return w; }
__device__ __forceinline__ void unpk8h(u32x4 w, f32x4& a, f32x4& b) {
    h16x8 h = __builtin_bit_cast(h16x8, w);
    a = (f32x4){(float)h[0], (float)h[1], (float)h[2], (float)h[3]}; b = (f32x4){(float)h[4], (float)h[5], (float)h[6], (float)h[7]};
}
__device__ __forceinline__ float fast_sigmoid(float x) { return __builtin_amdgcn_rcpf(1.0f + __builtin_amdgcn_exp2f(-x * LOG2E)); }

namespace pg8 {
constexpr int BM = 256, BK = 64, HALF = 128, HTB = HALF * BK * 2  , STAGE_BYTES = 8 * HTB, NXCD = 8, WGM = 8;

__host__ __device__ __forceinline__ int lds_byte(int r, int c) { const int st = (r >> 4) * 2 + (c >> 5), rr = r & 15, cc = c & 31, ob = rr * 64 + cc * 2; return st * 1024 + (ob ^ (((ob >> 9) & 1) << 5)); }
__host__ __device__ __forceinline__ void stage_rc(int b, int& R, int& C) { const int st = b / 1024, sb = b % 1024, swz = sb ^ (((sb >> 9) & 1) << 5); R = (st >> 1) * 16 + swz / 64; C = (st & 1) * 32 + (swz % 64) / 2; }

struct Unit { int pm, pn; };
struct Gemm { const h16* A; const h16* Bt; int K, lda, ldb; };

struct StaticOrder {
    int nM, nN, nwg, G, c;
    __host__ __device__ void init(int M, int N, int G_, int c_) { nM = M / BM; nN = N / BM; nwg = nM * nN; G = G_; c = c_; }
    __host__ __device__ bool next(int i, Unit& u) const {
        const long L = (long)i * G + c; if (L >= nwg) return false;
        int wgid = (int)L; { const int q = nwg / NXCD, r = nwg % NXCD, xcd = wgid % NXCD, off = wgid / NXCD; wgid = (xcd < r ? xcd * (q + 1) : r * (q + 1) + (xcd - r) * q) + off; }
        const int nig = WGM * nN, gid = wgid / nig, fm = gid * WGM, gsz = (nM - fm) < WGM ? (nM - fm) : WGM;
        u.pm = fm + ((wgid % nig) % gsz); u.pn = (wgid % nig) / gsz; return true;
    }
};
struct PairedOrder {
    StaticOrder base;
    __host__ __device__ void init(int M, int Ncons, int G_, int c_) { base.init(M, Ncons, G_, c_); }
    __host__ __device__ bool next(int i, Unit& u) const { Unit t; if (!base.next(i >> 1, t)) return false; u.pm = t.pm; u.pn = 2 * t.pn + (i & 1); return true; }
};
struct DiagOrder {
    int tm, tn, ng, G, c;
    __host__ __device__ void init(int ng_, int tm_, int tn_, int G_, int c_) { ng = ng_; tm = tm_; tn = tn_; G = G_; c = c_; }
    __host__ __device__ bool next(int i, Unit& u) const {
        const long L = (long)i * G + c; if (L >= (long)ng * tm * tn) return false;
        const int per = tm * tn, g = (int)L / per, r = (int)L % per;
        u.pm = g * tm + r / tn; u.pn = g * tn + r % tn; return true;
    }
};

template <class Epi, class Sched, bool ALIGN_EPI = false, bool SP2 = false, bool TWO = false>
__device__ __forceinline__ void gemm_phase(LAS unsigned char* lds, const Gemm g, const Sched& S, const Epi& E, const Gemm g2 = Gemm{nullptr, nullptr, 0, 0, 0}) {
    const int tid = threadIdx.x, wid = __builtin_amdgcn_readfirstlane(tid >> 6), lane = tid & 63, wr = wid >> 2, wc = wid & 3, fr = lane & 15, fq = lane >> 4;
    const int nt0 = g.K / BK, nt1 = TWO ? g2.K / BK : nt0;
    unsigned voffA[2], voffB0[2], voffB1[2];
#pragma unroll
    for (int i = 0; i < 2; ++i) { int R, C; stage_rc(tid * 16 + i * 8192, R, C);
        voffA[i] = (unsigned)(R * g.lda + C) * 2u; voffB0[i] = (unsigned)(R * g.ldb + C) * 2u; voffB1[i] = TWO ? (unsigned)(R * g2.ldb + C) * 2u : voffB0[i]; }
    const size_t kstep = (size_t)(BK * 2);
    const size_t hstepA = (size_t)HALF * g.lda * 2, hstepB0 = (size_t)HALF * g.ldb * 2, hstepB1 = TWO ? (size_t)HALF * g2.ldb * 2 : hstepB0;
    const size_t tstepA = 2 * hstepA;
#define PG8_NEXT(i, u, part) (TWO ? ((part) = (i) & 1, S.next((i) >> 1, (u))) : ((part) = 0, S.next((i), (u))))
#define PG8_ABASE(u, part) ((const char*)((TWO && (part)) ? g2.A : g.A) + (size_t)(u).pm * tstepA)
#define PG8_BBASE(u, part) ((TWO && (part)) ? (const char*)g2.Bt + (size_t)(u).pn * 2 * hstepB1 : (const char*)g.Bt + (size_t)(u).pn * 2 * hstepB0)
    const unsigned ldsw = (unsigned)wid * 1024u;
    const int aoff = lds_byte(wr * 64 + fr, fq * 8), boff = lds_byte(wc * 32 + fr, fq * 8);
#define PG8_SA(b, h) (((b) * 2 + (h)) * HTB)
#define PG8_SB(b, h) ((4 + (b) * 2 + (h)) * HTB)
#define PG8_STAGE(bufoff, gbase, voff) do { _Pragma("unroll") for (int _i = 0; _i < 2; ++_i) \
        __builtin_amdgcn_global_load_lds((const unsigned*)((const char*)(gbase) + (voff)[_i]), (LAS unsigned*)(lds + (bufoff) + ldsw + _i * 8192), 16, 0, 0); } while (0)
#define PG8_LDA(dst, b, h) do { _Pragma("unroll") for (int m = 0; m < 4; ++m) _Pragma("unroll") for (int k = 0; k < 2; ++k) dst[m][k] = *(const LAS h16x8*)(lds + PG8_SA(b, h) + aoff + m * 2048 + k * 1024); } while (0)
#define PG8_LDB(dst, b, h) do { _Pragma("unroll") for (int n = 0; n < 2; ++n) _Pragma("unroll") for (int k = 0; k < 2; ++k) dst[n][k] = *(const LAS h16x8*)(lds + PG8_SB(b, h) + boff + n * 2048 + k * 1024); } while (0)
#define PG8_MMA(ai, bj, At, Bt) do { __builtin_amdgcn_s_setprio(1); _Pragma("unroll") for (int m = 0; m < 4; ++m) _Pragma("unroll") for (int n = 0; n < 2; ++n) _Pragma("unroll") for (int k = 0; k < 2; ++k) \
        acc[ai][bj][m][n] = __builtin_amdgcn_mfma_f32_16x16x32_f16(Bt[n][k], At[m][k], acc[ai][bj][m][n], 0, 0, 0); __builtin_amdgcn_s_setprio(0); } while (0)
#define PG8_WAIT_V(n) asm volatile("s_waitcnt vmcnt(" #n ")" ::: "memory")
#define PG8_WAIT_L(n) asm volatile("s_waitcnt lgkmcnt(" #n ")" ::: "memory")
#define PG8_BAR __builtin_amdgcn_s_barrier()
#define PG8_SCHED __builtin_amdgcn_sched_barrier(0)
    Unit cur, nxt; int ui = 0, pcur = 0, pnxt = 0;
    if (!PG8_NEXT(0, cur, pcur)) return;
    f32x4 acc[2][2][4][2];
#pragma unroll
    for (int a = 0; a < 2; ++a)
#pragma unroll
        for (int b = 0; b < 2; ++b)
#pragma unroll
            for (int m = 0; m < 4; ++m)
#pragma unroll
                for (int n = 0; n < 2; ++n) acc[a][b][m][n] = (f32x4){0.f, 0.f, 0.f, 0.f};
    h16x8 At[4][2], B0[2][2], B1[2][2];
    const char* cA = PG8_ABASE(cur, pcur); const char* cB = PG8_BBASE(cur, pcur);
    unsigned voffB[2] = {voffB0[0], voffB0[1]}; size_t hstepB = hstepB0;
    if constexpr (SP2) {
        PG8_STAGE(PG8_SB(0, 0), cB, voffB); PG8_STAGE(PG8_SB(0, 1), cB + hstepB, voffB); PG8_STAGE(PG8_SA(0, 0), cA, voffA); PG8_STAGE(PG8_SA(0, 1), cA + hstepA, voffA);
        if (wr == 1) PG8_BAR;
        PG8_WAIT_V(2); PG8_BAR;
        PG8_STAGE(PG8_SB(1, 0), cB + kstep, voffB); PG8_STAGE(PG8_SA(1, 0), cA + kstep, voffA); PG8_STAGE(PG8_SB(1, 1), cB + hstepB + kstep, voffB);
        PG8_WAIT_V(6); PG8_BAR;
    } else {
        PG8_STAGE(PG8_SB(0, 0), cB, voffB); PG8_STAGE(PG8_SA(0, 0), cA, voffA); PG8_STAGE(PG8_SB(0, 1), cB + hstepB, voffB); PG8_STAGE(PG8_SA(0, 1), cA + hstepA, voffA);
        if (wr == 1) PG8_BAR;
        PG8_WAIT_V(4); PG8_BAR;
        PG8_STAGE(PG8_SB(1, 0), cB + kstep, voffB); PG8_STAGE(PG8_SA(1, 0), cA + kstep, voffA); PG8_STAGE(PG8_SB(1, 1), cB + hstepB + kstep, voffB);
        PG8_WAIT_V(6); PG8_BAR;
    }
    for (;;) {
        const bool has_next = PG8_NEXT(ui + 1, nxt, pnxt);
        const char* nA = has_next ? PG8_ABASE(nxt, pnxt) : cA; const char* nB = has_next ? PG8_BBASE(nxt, pnxt) : cB;
        const int nt = pcur ? nt1 : nt0;
        const unsigned vBc0 = voffB[0], vBc1 = voffB[1]; const size_t hBc = hstepB;
        const bool np1 = has_next ? (pnxt != 0) : (pcur != 0);
        const unsigned vBn0 = np1 ? voffB1[0] : voffB0[0], vBn1 = np1 ? voffB1[1] : voffB0[1]; const size_t hBn = np1 ? hstepB1 : hstepB0;
#pragma unroll 1
        for (int t = 0; t < nt; t += 2) {
            const bool last = (t == nt - 2);
            const char* a1 = cA + (size_t)(t + 1) * kstep;
            const char* a2 = last ? nA : cA + (size_t)(t + 2) * kstep; const char* b2 = last ? nB : cB + (size_t)(t + 2) * kstep;
            const char* a3 = a2 + kstep; const char* b3 = b2 + kstep;
            if constexpr (TWO) { voffB[0] = last ? vBn0 : vBc0; voffB[1] = last ? vBn1 : vBc1; hstepB = last ? hBn : hBc; }
            if constexpr (SP2) {
            PG8_LDB(B0, 0, 0); PG8_LDB(B1, 0, 1); PG8_SCHED; PG8_LDA(At, 0, 0); PG8_STAGE(PG8_SA(1, 1), a1 + hstepA, voffA);
            PG8_WAIT_V(8); PG8_WAIT_L(0); PG8_BAR; PG8_MMA(0, 0, At, B0); PG8_MMA(0, 1, At, B1); PG8_BAR; PG8_SCHED;
            PG8_LDA(At, 0, 1); PG8_STAGE(PG8_SB(0, 0), b2, voffB); PG8_STAGE(PG8_SB(0, 1), b2 + hstepB, voffB); PG8_STAGE(PG8_SA(0, 0), a2, voffA);
            PG8_WAIT_V(8); PG8_WAIT_L(0); PG8_BAR; PG8_MMA(1, 0, At, B0); PG8_MMA(1, 1, At, B1); PG8_BAR; PG8_SCHED;
            PG8_LDB(B0, 1, 0); PG8_LDB(B1, 1, 1); PG8_SCHED; PG8_LDA(At, 1, 0); PG8_STAGE(PG8_SA(0, 1), a2 + hstepA, voffA);
            PG8_WAIT_V(8); PG8_WAIT_L(0); PG8_BAR; PG8_MMA(0, 0, At, B0); PG8_MMA(0, 1, At, B1); PG8_BAR; PG8_SCHED;
            PG8_LDA(At, 1, 1); PG8_STAGE(PG8_SB(1, 0), b3, voffB); PG8_STAGE(PG8_SB(1, 1), b3 + hstepB, voffB); PG8_STAGE(PG8_SA(1, 0), a3, voffA);
            PG8_WAIT_V(8); PG8_WAIT_L(0); PG8_BAR; PG8_MMA(1, 0, At, B0); PG8_MMA(1, 1, At, B1); PG8_BAR; PG8_SCHED;
            } else {
            PG8_LDB(B0, 0, 0); PG8_SCHED; PG8_LDA(At, 0, 0); PG8_STAGE(PG8_SA(1, 1), a1 + hstepA, voffA);
            PG8_WAIT_L(8); PG8_BAR; PG8_WAIT_L(0); PG8_MMA(0, 0, At, B0); PG8_BAR; PG8_SCHED;
            PG8_LDB(B1, 0, 1); PG8_STAGE(PG8_SB(0, 0), b2, voffB);
            PG8_BAR; PG8_WAIT_L(0); PG8_MMA(0, 1, At, B1); PG8_BAR;
            PG8_LDA(At, 0, 1); PG8_STAGE(PG8_SA(0, 0), a2, voffA);
            PG8_BAR; PG8_WAIT_L(0); PG8_MMA(1, 0, At, B0); PG8_BAR; PG8_SCHED;
            PG8_STAGE(PG8_SB(0, 1), b2 + hstepB, voffB);
            PG8_WAIT_V(6); PG8_BAR; PG8_MMA(1, 1, At, B1); PG8_BAR;
            PG8_LDB(B0, 1, 0); PG8_SCHED; PG8_LDA(At, 1, 0); PG8_STAGE(PG8_SA(0, 1), a2 + hstepA, voffA);
            PG8_WAIT_L(8); PG8_BAR; PG8_WAIT_L(0); PG8_MMA(0, 0, At, B0); PG8_BAR; PG8_SCHED;
            PG8_LDB(B1, 1, 1); PG8_STAGE(PG8_SB(1, 0), b3, voffB);
            PG8_BAR; PG8_WAIT_L(0); PG8_MMA(0, 1, At, B1); PG8_BAR;
            PG8_LDA(At, 1, 1); PG8_STAGE(PG8_SA(1, 0), a3, voffA);
            PG8_BAR; PG8_WAIT_L(0); PG8_MMA(1, 0, At, B0); PG8_BAR; PG8_SCHED;
            PG8_STAGE(PG8_SB(1, 1), b3 + hstepB, voffB);
            PG8_WAIT_V(6); PG8_BAR; PG8_MMA(1, 1, At, B1); PG8_BAR;
            }
        }
        if constexpr (ALIGN_EPI) { if (wr == 0) PG8_BAR; }
        bool zero = true;
        if constexpr (TWO) { if (pcur == 0) { E.mid(acc, cur, wr, wc, fr, fq); zero = false; } else E(acc, cur, wr, wc, fr, fq); }
        else if constexpr (!Epi::AFTER_DRAIN) { E(acc, cur, wr, wc, fr, fq); }
        if (!has_next) break;
        if (zero) {
#pragma unroll
        for (int a = 0; a < 2; ++a)
#pragma unroll
            for (int b = 0; b < 2; ++b)
#pragma unroll
                for (int m = 0; m < 4; ++m)
#pragma unroll
                    for (int n = 0; n < 2; ++n) acc[a][b][m][n] = (f32x4){0.f, 0.f, 0.f, 0.f};
        }
        cur = nxt; pcur = pnxt; cA = nA; cB = nB; ++ui;
        if constexpr (TWO) { voffB[0] = vBn0; voffB[1] = vBn1; hstepB = hBn; }
        if constexpr (ALIGN_EPI) { if (wr == 1) PG8_BAR; }
    }
    PG8_WAIT_V(0);
    if constexpr (!ALIGN_EPI) { if (wr == 0) PG8_BAR; }
    PG8_BAR;
    if constexpr (Epi::AFTER_DRAIN) { E.fused(acc, cur, wr, wc, fr, fq, lds); }
#undef PG8_NEXT
#undef PG8_ABASE
#undef PG8_BBASE
#undef PG8_SA
#undef PG8_SB
#undef PG8_STAGE
#undef PG8_LDA
#undef PG8_LDB
#undef PG8_MMA
#undef PG8_WAIT_V
#undef PG8_WAIT_L
#undef PG8_BAR
#undef PG8_SCHED
}
}
namespace epi {
using pg8::Unit;
typedef f32x4 Acc[2][2][4][2];

__device__ __forceinline__ float quad16(float s) {
    auto a = __builtin_amdgcn_permlane16_swap(__float_as_uint(s), __float_as_uint(s), false, false); s = __uint_as_float(a[0]) + __uint_as_float(a[1]);
    auto b = __builtin_amdgcn_permlane32_swap(__float_as_uint(s), __float_as_uint(s), false, false); return __uint_as_float(b[0]) + __uint_as_float(b[1]);
}

__device__ __forceinline__ float rstd_from_ssq(const float* ssq, int r) {
    const f32x4* p = (const f32x4*)(ssq + (size_t)r * 16); const f32x4 a = p[0], b = p[1], c = p[2], d = p[3];
    const float s = ((a[0] + a[1]) + (a[2] + a[3])) + ((b[0] + b[1]) + (b[2] + b[3])) + ((c[0] + c[1]) + (c[2] + c[3])) + ((d[0] + d[1]) + (d[2] + d[3]));
    return __builtin_amdgcn_rsqf(s * (1.0f / DM) + NORM_EPS);
}
__device__ __forceinline__ float rstd_from_sum(const float* ssum, int r) { return __builtin_amdgcn_rsqf(ssum[r] * (1.0f / DM) + NORM_EPS); }
__device__ __forceinline__ float rstd_from_ssq_q(const float* ssq, int r, int fq) {
    const f32x4 a = ((const f32x4*)(ssq + (size_t)r * 16))[fq];
    const float s = quad16((a[0] + a[1]) + (a[2] + a[3]));
    return __builtin_amdgcn_rsqf(s * (1.0f / DM) + NORM_EPS);
}
template <int SRC  > struct EpiSwiglu {
    static constexpr bool AFTER_DRAIN = false;
    h16* H; const float* rsrc;
    __device__ __forceinline__ void operator()(const Acc& acc, const Unit& u, int wr, int wc, int fr, int fq) const {
        const int row0 = u.pm * 256 + wr * 64 + fr, col = u.pn * 128 + wc * 32 + fq * 8;
#pragma unroll
        for (int ai = 0; ai < 2; ++ai)
#pragma unroll
            for (int m = 0; m < 4; ++m) {
                const int r = row0 + ai * 128 + m * 16; const float rs = SRC == 0 ? rsrc[r] : rstd_from_sum(rsrc, r);
                f32x4 o[2];
#pragma unroll
                for (int n = 0; n < 2; ++n)
#pragma unroll
                    for (int j = 0; j < 4; ++j) { const float g = acc[ai][0][m][n][j] * rs, up = acc[ai][1][m][n][j] * rs; o[n][j] = g * fast_sigmoid(g) * up; }
                *(u32x4*)(H + (size_t)r * FFN + col) = pk8h(o[0], o[1]);
            }
    }
};

template <bool BASEH> struct EpiResid {
    static constexpr bool AFTER_DRAIN = false;
    const void* base; h16* outh; float* ssq; float alpha;
    __device__ __forceinline__ void operator()(const Acc& acc, const Unit& u, int wr, int wc, int fr, int fq) const {
        const int row0 = u.pm * 256 + wr * 64 + fr, col0 = u.pn * 256 + wc * 32 + fq * 8;
#pragma unroll
        for (int ai = 0; ai < 2; ++ai)
#pragma unroll
            for (int m = 0; m < 4; ++m) {
                const int r = row0 + ai * 128 + m * 16; float sq = 0.f;
#pragma unroll
                for (int bj = 0; bj < 2; ++bj) {
                    const size_t off = (size_t)r * DM + col0 + bj * 128;
                    f32x4 b0, b1;
                    if (BASEH) unpk8h(*(const u32x4*)((const h16*)base + off), b0, b1); else { b0 = *(const f32x4*)((const float*)base + off); b1 = *(const f32x4*)((const float*)base + off + 4); }
                    const f32x4 v0 = b0 + alpha * acc[ai][bj][m][0], v1 = b1 + alpha * acc[ai][bj][m][1];
                    *(u32x4*)(outh + off) = pk8h(v0, v1);
                    sq += (v0[0] * v0[0] + v0[1] * v0[1]) + (v0[2] * v0[2] + v0[3] * v0[3]) + (v1[0] * v1[0] + v1[1] * v1[1]) + (v1[2] * v1[2] + v1[3] * v1[3]);
                }
                sq = quad16(sq);
                if (fq == 0) __hip_atomic_fetch_add(ssq + r, sq, __ATOMIC_RELAXED, __HIP_MEMORY_SCOPE_AGENT);
            }
    }
};

struct EpiFinal {
    static constexpr bool AFTER_DRAIN = false;
    const h16* base; float* out; float* ssq; unsigned* cnt; const float* gain; float alpha;
    __device__ __forceinline__ void operator()(Acc& acc, const Unit& u, int wr, int wc, int fr, int fq) const {
        const int row0 = u.pm * 256 + wr * 64 + fr, col0 = u.pn * 256 + wc * 32 + fq * 8;
#pragma unroll
        for (int ai = 0; ai < 2; ++ai)
#pragma unroll
            for (int m = 0; m < 4; ++m) {
                const int r = row0 + ai * 128 + m * 16; float sq = 0.f;
#pragma unroll
                for (int bj = 0; bj < 2; ++bj) {
                    f32x4 b0, b1; unpk8h(*(const u32x4*)(base + (size_t)r * DM + col0 + bj * 128), b0, b1);
                    const f32x4 v0 = b0 + alpha * acc[ai][bj][m][0], v1 = b1 + alpha * acc[ai][bj][m][1];
                    acc[ai][bj][m][0] = v0; acc[ai][bj][m][1] = v1;
                    sq += (v0[0] * v0[0] + v0[1] * v0[1]) + (v0[2] * v0[2] + v0[3] * v0[3]) + (v1[0] * v1[0] + v1[1] * v1[1]) + (v1[2] * v1[2] + v1[3] * v1[3]);
                }
                sq = quad16(sq);
                if (fq == 0) __hip_atomic_fetch_add(ssq + r, sq, __ATOMIC_RELAXED, __HIP_MEMORY_SCOPE_AGENT);
            }
        asm volatile("s_waitcnt vmcnt(0)" ::: "memory");
        unsigned* c = cnt + 64 * u.pm;
        if ((threadIdx.x & 63) == 0) __hip_atomic_fetch_add(c, 1u, __ATOMIC_RELAXED, __HIP_MEMORY_SCOPE_AGENT);
        { unsigned spins = 0;
          while ((unsigned)__builtin_amdgcn_readfirstlane(__hip_atomic_load(c, __ATOMIC_RELAXED, __HIP_MEMORY_SCOPE_AGENT)) < 32u) { __builtin_amdgcn_s_sleep(2); if (++spins > (1u << 22)) break; } }
        f32x4 gv[2][2];
#pragma unroll
        for (int bj = 0; bj < 2; ++bj) { gv[bj][0] = *(const f32x4*)(gain + col0 + bj * 128); gv[bj][1] = *(const f32x4*)(gain + col0 + bj * 128 + 4); }
#pragma unroll
        for (int ai = 0; ai < 2; ++ai)
#pragma unroll
            for (int m = 0; m < 4; ++m) {
                const int r = row0 + ai * 128 + m * 16;
                const float rs = __builtin_amdgcn_rsqf(__hip_atomic_load(ssq + r, __ATOMIC_RELAXED, __HIP_MEMORY_SCOPE_AGENT) * (1.0f / DM) + NORM_EPS);
#pragma unroll
                for (int bj = 0; bj < 2; ++bj) { float* o = out + (size_t)r * DM + col0 + bj * 128;
                    *(f32x4*)o = acc[ai][bj][m][0] * rs * gv[bj][0]; *(f32x4*)(o + 4) = acc[ai][bj][m][1] * rs * gv[bj][1]; }
            }
    }
};

__device__ __forceinline__ void head_norm_store(const Acc& acc, int ai, int m, float rs, const float* gain, float oscale, h16* dst  , int fq) {
    float sq = 0.f;
#pragma unroll
    for (int bj = 0; bj < 2; ++bj)
#pragma unroll
        for (int n = 0; n < 2; ++n)
#pragma unroll
            for (int j = 0; j < 4; ++j) { const float v = acc[ai][bj][m][n][j] * rs; sq += v * v; }
    sq = quad16(sq);
    const float r = oscale * __builtin_amdgcn_rsqf(sq * (1.0f / 64.0f) + NORM_EPS);
#pragma unroll
    for (int bj = 0; bj < 2; ++bj) {
        const f32x4 g0 = *(const f32x4*)(gain + 32 * bj + 8 * fq), g1 = *(const f32x4*)(gain + 32 * bj + 8 * fq + 4);
        const f32x4 v0 = acc[ai][bj][m][0] * (rs * r) * g0, v1 = acc[ai][bj][m][1] * (rs * r) * g1;
        *(u32x4*)(dst + 32 * bj + 8 * fq) = pk8h(v0, v1);
    }
}

struct EpiWin {
    static constexpr bool AFTER_DRAIN = false;
    const float* ssq;
    const float *gq, *gk, *gmq;
    h16 *qa, *ka, *va, *qidx, *kidx, *acat, *qm, *gates; float* widx;
    __device__ __forceinline__ void operator()(const Acc& acc, const Unit& u, int wr, int wc, int fr, int fq) const {
        const int row0 = u.pm * 256 + wr * 64 + fr; const int pn = u.pn;
        float rs[2][4];
#pragma unroll
        for (int ai = 0; ai < 2; ++ai)
#pragma unroll
            for (int m = 0; m < 4; ++m) rs[ai][m] = rstd_from_sum(ssq, row0 + ai * 128 + m * 16);
        if (pn < 2) {
#pragma unroll
            for (int ai = 0; ai < 2; ++ai)
#pragma unroll
                for (int m = 0; m < 4; ++m) { const int r = row0 + ai * 128 + m * 16;
                    head_norm_store(acc, ai, m, rs[ai][m], gq, 0.125f * LOG2E, qa + (size_t)r * 512 + (4 * pn + wc) * 64, fq); }
        } else if (pn == 2) {
            if (wc == 0) {
#pragma unroll
                for (int ai = 0; ai < 2; ++ai)
#pragma unroll
                    for (int m = 0; m < 4; ++m) { const int r = row0 + ai * 128 + m * 16; head_norm_store(acc, ai, m, rs[ai][m], gk, 1.0f, ka + (size_t)r * 64, fq); }
            } else if (wc == 1) {
#pragma unroll
                for (int ai = 0; ai < 2; ++ai)
#pragma unroll
                    for (int m = 0; m < 4; ++m) { const int r = row0 + ai * 128 + m * 16;
#pragma unroll
                        for (int bj = 0; bj < 2; ++bj) *(u32x4*)(va + (size_t)r * 64 + 32 * bj + 8 * fq) = pk8h(acc[ai][bj][m][0] * rs[ai][m], acc[ai][bj][m][1] * rs[ai][m]); }
            } else if (wc == 2) {
#pragma unroll
                for (int ai = 0; ai < 2; ++ai)
#pragma unroll
                    for (int m = 0; m < 4; ++m) { const int r = row0 + ai * 128 + m * 16;
#pragma unroll
                        for (int bj = 0; bj < 2; ++bj) *(u32x4*)(kidx + (size_t)r * 64 + 32 * bj + 8 * fq) = pk8h(acc[ai][bj][m][0] * rs[ai][m], acc[ai][bj][m][1] * rs[ai][m]); }
            } else {
                if (fq == 0) {
#pragma unroll
                    for (int ai = 0; ai < 2; ++ai)
#pragma unroll
                        for (int m = 0; m < 4; ++m) { const int r = row0 + ai * 128 + m * 16; *(f32x4*)(widx + (size_t)r * 4) = acc[ai][0][m][0] * (rs[ai][m] * 0.0625f); }
                }
            }
        } else if (pn == 3) {
#pragma unroll
            for (int ai = 0; ai < 2; ++ai)
#pragma unroll
                for (int m = 0; m < 4; ++m) { const int r = row0 + ai * 128 + m * 16;
#pragma unroll
                    for (int bj = 0; bj < 2; ++bj) *(u32x4*)(qidx + (size_t)r * 256 + 128 * bj + 32 * wc + 8 * fq) = pk8h(acc[ai][bj][m][0] * rs[ai][m], acc[ai][bj][m][1] * rs[ai][m]); }
        } else if (pn == 4) {
#pragma unroll
            for (int ai = 0; ai < 2; ++ai)
#pragma unroll
                for (int m = 0; m < 4; ++m) { const int r = row0 + ai * 128 + m * 16; const int bc = r >> 6, s = r & 63;
#pragma unroll
                    for (int bj = 0; bj < 2; ++bj) { const int col = 128 * bj + 32 * wc + 8 * fq, g = col >> 4, c0 = col & 15;
                        *(u32x4*)(acat + ((size_t)g * 1024 + bc) * 1280 + 16 * s + c0) = pk8h(acc[ai][bj][m][0] * rs[ai][m], acc[ai][bj][m][1] * rs[ai][m]); } }
        } else if (pn == 5) {
#pragma unroll
            for (int ai = 0; ai < 2; ++ai)
#pragma unroll
                for (int m = 0; m < 4; ++m) { const int r = row0 + ai * 128 + m * 16;
                    head_norm_store(acc, ai, m, rs[ai][m], gmq, 0.125f * LOG2E, qm + (size_t)r * 256 + wc * 64, fq); }
        } else {
#pragma unroll
            for (int ai = 0; ai < 2; ++ai)
#pragma unroll
                for (int m = 0; m < 4; ++m) { const int r = row0 + ai * 128 + m * 16;
#pragma unroll
                    for (int bj = 0; bj < 2; ++bj) { f32x4 v0 = acc[ai][bj][m][0] * rs[ai][m], v1 = acc[ai][bj][m][1] * rs[ai][m];
#pragma unroll
                        for (int j = 0; j < 4; ++j) { v0[j] = fast_sigmoid(v0[j]); v1[j] = fast_sigmoid(v1[j]); }
                        *(u32x4*)(gates + (size_t)r * 3072 + (pn - 6) * 256 + 128 * bj + 32 * wc + 8 * fq) = pk8h(v0, v1); } }
        }
    }
};

struct EpiMemKV {
    static constexpr bool AFTER_DRAIN = false;
    const float* gmk; h16* mk; h16* mvT;
    __device__ __forceinline__ void operator()(const Acc& acc, const Unit& u, int wr, int wc, int fr, int fq) const {
        const int row0 = u.pm * 256 + wr * 64 + fr;
        if (u.pn == 0) {
#pragma unroll
            for (int ai = 0; ai < 2; ++ai)
#pragma unroll
                for (int m = 0; m < 4; ++m) { const int r = row0 + ai * 128 + m * 16; head_norm_store(acc, ai, m, 1.0f, gmk, 1.0f, mk + (size_t)r * 256 + wc * 64, fq); }
        } else {
#pragma unroll
            for (int ai = 0; ai < 2; ++ai)
#pragma unroll
                for (int m = 0; m < 4; ++m) { const int r = row0 + ai * 128 + m * 16; const int b = r >> 8, kv = r & 255;
                    h16* dst = mvT + ((size_t)(b * 4 + wc) * 64) * MEMT + kv;
#pragma unroll
                    for (int bj = 0; bj < 2; ++bj)
#pragma unroll
                        for (int n = 0; n < 2; ++n)
#pragma unroll
                            for (int j = 0; j < 4; ++j) dst[(size_t)(32 * bj + 8 * fq + 4 * n + j) * MEMT] = (h16)acc[ai][bj][m][n][j]; }
        }
    }
};

struct EpiGlu {
    static constexpr bool AFTER_DRAIN = false;
    h16* ob;
    __device__ __forceinline__ void operator()(const Acc& acc, const Unit& u, int wr, int wc, int fr, int fq) const {
        const int row0 = u.pm * 256 + wr * 64 + fr, col = u.pn * 128 + wc * 32 + fq * 8;
#pragma unroll
        for (int ai = 0; ai < 2; ++ai)
#pragma unroll
            for (int m = 0; m < 4; ++m) { const int r = row0 + ai * 128 + m * 16; f32x4 o[2];
#pragma unroll
                for (int n = 0; n < 2; ++n)
#pragma unroll
                    for (int j = 0; j < 4; ++j) o[n][j] = acc[ai][0][m][n][j] * fast_sigmoid(acc[ai][1][m][n][j]);
                *(u32x4*)(ob + (size_t)r * DM + col) = pk8h(o[0], o[1]); }
    }
};

struct EpiMerge2 {
    static constexpr bool AFTER_DRAIN = false; static constexpr float GMIN = 5.9604645e-8f;
    const h16* gates; const h16* ob; h16* merged;
    __device__ __forceinline__ void mid(Acc& acc, const Unit& u, int wr, int wc, int fr, int fq) const {
        const int row0 = u.pm * 256 + wr * 64 + fr, col0 = u.pn * 256 + wc * 32 + fq * 8;
#pragma unroll
        for (int ai = 0; ai < 2; ++ai)
#pragma unroll
            for (int m = 0; m < 4; ++m) { const int r = row0 + ai * 128 + m * 16;
#pragma unroll
                for (int bj = 0; bj < 2; ++bj) { const int col = col0 + bj * 128; f32x4 a0, a1, c0, c1;
                    unpk8h(*(const u32x4*)(gates + (size_t)r * 3072 + col), a0, a1); unpk8h(*(const u32x4*)(gates + (size_t)r * 3072 + 2048 + col), c0, c1);
#pragma unroll
                    for (int j = 0; j < 4; ++j) { acc[ai][bj][m][0][j] *= a0[j] * __builtin_amdgcn_rcpf(fmaxf(c0[j], GMIN)); acc[ai][bj][m][1][j] *= a1[j] * __builtin_amdgcn_rcpf(fmaxf(c1[j], GMIN)); } } }
    }
    __device__ __forceinline__ void operator()(const Acc& acc, const Unit& u, int wr, int wc, int fr, int fq) const {
        const int row0 = u.pm * 256 + wr * 64 + fr, col0 = u.pn * 256 + wc * 32 + fq * 8;
#pragma unroll
        for (int ai = 0; ai < 2; ++ai)
#pragma unroll
            for (int m = 0; m < 4; ++m) { const int r = row0 + ai * 128 + m * 16;
#pragma unroll
                for (int bj = 0; bj < 2; ++bj) { const int col = col0 + bj * 128; f32x4 b0, b1, c0, c1, o0, o1;
                    unpk8h(*(const u32x4*)(gates + (size_t)r * 3072 + 1024 + col), b0, b1); unpk8h(*(const u32x4*)(gates + (size_t)r * 3072 + 2048 + col), c0, c1);
                    unpk8h(*(const u32x4*)(ob + (size_t)r * DM + col), o0, o1);
#pragma unroll
                    for (int j = 0; j < 4; ++j) { c0[j] = fmaxf(c0[j], GMIN); c1[j] = fmaxf(c1[j], GMIN); }
                    *(u32x4*)(merged + (size_t)r * DM + col) = pk8h(c0 * acc[ai][bj][m][0] + b0 * o0, c1 * acc[ai][bj][m][1] + b1 * o1); } }
    }
};

struct EpiS5Main {
    static constexpr bool AFTER_DRAIN = false;
    const float* logdt; h16* ys;
    __device__ __forceinline__ void operator()(const Acc& acc, const Unit& u, int wr, int wc, int fr, int fq) const {
        const int g = u.pm >> 2, pmm = u.pm & 3, pnn = u.pn & 3; const float dt = __expf(logdt[g]);
        const int row0 = pmm * 256 + wr * 64 + fr;
#pragma unroll
        for (int ai = 0; ai < 2; ++ai)
#pragma unroll
            for (int m = 0; m < 4; ++m) { const int bc = row0 + ai * 128 + m * 16;
#pragma unroll
                for (int bj = 0; bj < 2; ++bj) { const int tc = pnn * 256 + 128 * bj + 32 * wc + 8 * fq, t = tc >> 4, c0 = tc & 15;
                    f32x4 v[2];
#pragma unroll
                    for (int n = 0; n < 2; ++n)
#pragma unroll
                        for (int j = 0; j < 4; ++j) { const float y = acc[ai][bj][m][n][j] * dt; const float z = 1.5957691216f * (y + 0.044715f * y * y * y); v[n][j] = y * fast_sigmoid(z); }
                    *(u32x4*)(ys + ((size_t)bc * 64 + t) * 256 + 16 * g + c0) = pk8h(v[0], v[1]); } }
    }
};

struct EpiS5State {
    static constexpr bool AFTER_DRAIN = true;
    const float* logdt; const float* a64;
    h16* acat;
    __device__ __forceinline__ void fused(const Acc& acc, const Unit& u, int wr, int wc, int fr, int fq, LAS unsigned char* lds) const {
        const int g = u.pn, pmm = u.pm & 3; const float dt = __expf(logdt[g]);
        LAS float* sb = (LAS float*)lds;
#pragma unroll
        for (int ai = 0; ai < 2; ++ai)
#pragma unroll
            for (int m = 0; m < 4; ++m) { const int r = ai * 128 + wr * 64 + m * 16 + fr;
                *(LAS f32x4*)(sb + r * 132 + 32 * wc + 8 * fq) = acc[ai][0][m][0] * dt; *(LAS f32x4*)(sb + r * 132 + 32 * wc + 8 * fq + 4) = acc[ai][0][m][1] * dt; }
        __syncthreads();
        const int tid = threadIdx.x, bl = tid >> 6, p = tid & 63;
        const float ar = a64[(g * 64 + p) * 2], ai_ = a64[(g * 64 + p) * 2 + 1];
        float xr = 0.f, xi = 0.f;
        h16* dst = acat + ((size_t)g * 1024 + (size_t)(pmm * 8 + bl) * 32) * 1280;
        for (int ch = 0; ch < 32; ++ch) {
            dst[(size_t)ch * 1280 + 1024 + p] = (h16)xr; dst[(size_t)ch * 1280 + 1088 + p] = (h16)xi;
            dst[(size_t)ch * 1280 + 1152 + p] = (h16)0.f; dst[(size_t)ch * 1280 + 1216 + p] = (h16)0.f;
            const float sr = sb[(bl * 32 + ch) * 132 + p], si = sb[(bl * 32 + ch) * 132 + 64 + p];
            const float nr = ar * xr - ai_ * xi + sr, ni = ar * xi + ai_ * xr + si; xr = nr; xi = ni;
        }
        __syncthreads();
    }
};
}
namespace pro {
#define LDS_WAIT() asm volatile("s_waitcnt lgkmcnt(0)" ::: "memory")

__device__ __forceinline__ float wave_sum(float v) {
#pragma unroll
    for (int o = 1; o < 64; o <<= 1) v += __shfl_xor(v, o);
    return v;
}

__device__ __forceinline__ void tr_item(const float* W, int ldw, int src0, int nvalid, const float* gain, h16* Bt, int K, int row0, int k0, LAS float* scr, int lane) {
    { const int c = lane & 31, kh = lane >> 5; const bool ok = c < nvalid;
      const float* wp = W + (size_t)(k0 + kh) * ldw + src0 + c; const size_t st2 = (size_t)2 * ldw;
#pragma unroll
      for (int hb = 0; hb < 2; ++hb) { float v[16];
#pragma unroll
          for (int i = 0; i < 16; ++i) { v[i] = ok ? *wp : 0.f; wp += st2; }
#pragma unroll
          for (int i = 0; i < 16; ++i) { const int kk = 2 * (16 * hb + i) + kh; scr[kk * 33 + c] = gain ? v[i] * gain[k0 + kk] : v[i]; } } }
    LDS_WAIT(); asm volatile("" ::: "memory");
    const int c8 = lane & 7;
#pragma unroll
    for (int jj = 0; jj < 4; ++jj) { const int q = (lane >> 3) + 8 * jj; const int o = 8 * ((q >> 2) & 3) + 4 * (q >> 4) + (q & 3);
        const LAS float* s = scr + (8 * c8) * 33 + o;
        u32x4 w; w.x = pk2h(s[0 * 33], s[1 * 33]); w.y = pk2h(s[2 * 33], s[3 * 33]); w.z = pk2h(s[4 * 33], s[5 * 33]); w.w = pk2h(s[6 * 33], s[7 * 33]);
        *(u32x4*)(Bt + (size_t)(row0 + q) * K + k0 + 8 * c8) = w; }
    LDS_WAIT(); asm volatile("" ::: "memory");
}

__device__ __forceinline__ int win_src0(int gi, int& nv) {
    const int pn = gi >> 3, bj = (gi >> 2) & 1, wc = gi & 3; nv = 32;
    if (pn < 2) return 64 * (4 * pn + wc) + 32 * bj;
    if (pn == 2) { if (wc == 0) return 512 + 32 * bj; if (wc == 1) return 576 + 32 * bj; if (wc == 2) return 896 + 32 * bj; nv = bj ? 0 : 4; return 960; }
    if (pn == 3) return 640 + 128 * bj + 32 * wc;
    if (pn == 4) return 964 + 128 * bj + 32 * wc;
    if (pn == 5) return 1220 + 64 * wc + 32 * bj;
    return 1476 + 256 * (pn - 6) + 128 * bj + 32 * wc;
}

struct WPtrs { const float *w1a, *w1b, *win, *wmkv, *wglu, *woa, *wom, *wout, *w2a, *w2b, *g1, *gmix, *g2;
               h16 *W1A, *W1B, *WIN, *WMKV, *WGLU, *WOA, *WOM, *WOUT, *W2A, *W2B; };

constexpr int IT_1A = 176 * 16, IT_1B = 32 * 44, IT_IN = 144 * 16, IT_MKV = 16 * 16, IT_GLU = 64 * 4, IT_OA = 32 * 8, IT_OM = 32 * 4, IT_OUT = 32 * 16;
constexpr int IT_TOTAL = 2 * IT_1A + 2 * IT_1B + IT_IN + IT_MKV + IT_GLU + IT_OA + IT_OM + IT_OUT;

__device__ __forceinline__ void weight_item(const WPtrs& P, int it, LAS float* scr, int lane) {
    int r = it;
    if (r < 2 * IT_1A) { const bool second = r >= IT_1A; if (second) r -= IT_1A; const int gi = r >> 4, kb = r & 15; const int pn = gi >> 3, bj = (gi >> 2) & 1, wc = gi & 3;
        tr_item(second ? P.w2a : P.w1a, 2 * FFN, (bj ? FFN : 0) + 128 * pn + 32 * wc, 32, second ? P.g2 : P.g1, second ? P.W2A : P.W1A, 1024, 32 * gi, 64 * kb, scr, lane); return; }
    r -= 2 * IT_1A;
    if (r < 2 * IT_1B) { const bool second = r >= IT_1B; if (second) r -= IT_1B; const int gi = r / 44, kb = r % 44;
        tr_item(second ? P.w2b : P.w1b, DM, 32 * gi, 32, nullptr, second ? P.W2B : P.W1B, FFN, 32 * gi, 64 * kb, scr, lane); return; }
    r -= 2 * IT_1B;
    if (r < IT_IN) { const int gi = r >> 4, kb = r & 15; int nv; const int s0 = win_src0(gi, nv);
        tr_item(P.win, 4548, s0, nv, P.gmix, P.WIN, 1024, 32 * gi, 64 * kb, scr, lane); return; }
    r -= IT_IN;
    if (r < IT_MKV) { const int gi = r >> 4, kb = r & 15; const int pn = gi >> 3, bj = (gi >> 2) & 1, wc = gi & 3;
        tr_item(P.wmkv, 512, 256 * pn + 64 * wc + 32 * bj, 32, nullptr, P.WMKV, 1024, 32 * gi, 64 * kb, scr, lane); return; }
    r -= IT_MKV;
    if (r < IT_GLU) { const int gi = r >> 2, kb = r & 3; const int pn = gi >> 3, bj = (gi >> 2) & 1, wc = gi & 3;
        tr_item(P.wglu, 2048, (bj ? 1024 : 0) + 128 * pn + 32 * wc, 32, nullptr, P.WGLU, 256, 32 * gi, 64 * kb, scr, lane); return; }
    r -= IT_GLU;
    if (r < IT_OA) { const int gi = r >> 3, kb = r & 7; tr_item(P.woa, DM, 32 * gi, 32, nullptr, P.WOA, 512, 32 * gi, 64 * kb, scr, lane); return; }
    r -= IT_OA;
    if (r < IT_OM) { const int gi = r >> 2, kb = r & 3; tr_item(P.wom, DM, 32 * gi, 32, nullptr, P.WOM, 256, 32 * gi, 64 * kb, scr, lane); return; }
    r -= IT_OM;
    { const int gi = r >> 4, kb = r & 15; tr_item(P.wout, DM, 32 * gi, 32, nullptr, P.WOUT, 1024, 32 * gi, 64 * kb, scr, lane); }
}

template <int NR> __device__ __forceinline__ void rows_to_h16(const float* x, h16* o, int m0, int mstep, int mend, const float* gain, float* rstd_out, int lane) {
    f32x4 v[NR][4];
#pragma unroll
    for (int r = 0; r < NR; ++r) { const int m = m0 + r * mstep; if (m < mend) {
#pragma unroll
        for (int j = 0; j < 4; ++j) v[r][j] = ((const f32x4*)(x + (size_t)m * DM))[lane + 64 * j]; } }
#pragma unroll
    for (int r = 0; r < NR; ++r) { const int m = m0 + r * mstep; if (m < mend) {
        float s = 0.f;
#pragma unroll
        for (int j = 0; j < 4; ++j) s += (v[r][j][0] * v[r][j][0] + v[r][j][1] * v[r][j][1]) + (v[r][j][2] * v[r][j][2] + v[r][j][3] * v[r][j][3]);
        const float rstd = 1.0f / sqrtf(wave_sum(s) * (1.0f / DM) + NORM_EPS);
        if (rstd_out && lane == 0) rstd_out[m] = rstd;
        u32x2* o8 = (u32x2*)(o + (size_t)m * DM) + lane;
#pragma unroll
        for (int j = 0; j < 4; ++j) { f32x4 w = v[r][j];
            if (gain) { const f32x4 gv = ((const f32x4*)gain)[lane + 64 * j]; w = w * rstd * gv; }
            u32x2 p; p.x = pk2h(w[0], w[1]); p.y = pk2h(w[2], w[3]); o8[64 * j] = p; } } }
}

struct S5In { const float *lre, *lim, *logdt, *bre, *bim, *cre, *cim, *dd; };
__device__ __forceinline__ int slot_row(int c) { const int o = c & 31; return (c & ~31) + 16 * ((o >> 2) & 1) + 4 * (o >> 3) + (o & 3); }
__device__ __forceinline__ void cpow(float ar, float ai, int n, float& pr, float& pi) {
    pr = 1.f; pi = 0.f;
    for (int i = 0; i < n; ++i) { const float t = pr * ar - pi * ai; pi = pr * ai + pi * ar; pr = t; }
}
__device__ __forceinline__ void s5_item(const S5In& I, int g, int j, h16* tcat, h16* wst, float* a64, LAS float* L, int tid) {
    LAS float* Pj = L;
    LAS float* Pj1 = L + 128;
    LAS float* P63 = L + 256;
    LAS float* Bb = L + 384;
    LAS float* CP = L + 384 + 2048;
    LAS float* Kb = L + 384 + 4096;
    const float dt = __expf(I.logdt[g]); const float sig = 1.0f / dt;
    __syncthreads();
    if (tid < 64) { const int p = tid; const float lr = I.lre[g * 64 + p], li = I.lim[g * 64 + p];
        const float mag = __expf(lr * dt); const float ar = mag * cosf(li * dt), ai = mag * sinf(li * dt);
        const float den = lr * lr + li * li; const float fr = ((ar - 1.0f) * lr + ai * li) / den, fi = (ai * lr - (ar - 1.0f) * li) / den;
        float pr, pi; cpow(ar, ai, j, pr, pi); Pj[2 * p] = pr; Pj[2 * p + 1] = pi;
        { const float t = pr * ar - pi * ai; const float u = pr * ai + pi * ar; Pj1[2 * p] = t; Pj1[2 * p + 1] = u; }
        cpow(ar, ai, 63 - j, pr, pi); P63[2 * p] = pr; P63[2 * p + 1] = pi;
        if (j == 0) { cpow(ar, ai, 64, pr, pi); a64[(g * 64 + p) * 2] = pr; a64[(g * 64 + p) * 2 + 1] = pi; }
#pragma unroll 4
        for (int c = 0; c < 16; ++c) { const float br = I.bre[(g * 64 + p) * 16 + c], bi = I.bim[(g * 64 + p) * 16 + c];
            Bb[(p * 16 + c) * 2] = fr * br - fi * bi; Bb[(p * 16 + c) * 2 + 1] = fr * bi + fi * br; }
    }
    __syncthreads();
    for (int e = tid; e < 1024; e += 512) { const int cp = e >> 6, p = e & 63;
        const float cr = I.cre[(g * 16 + cp) * 64 + p], ci = I.cim[(g * 16 + cp) * 64 + p], pr = Pj[2 * p], pi = Pj[2 * p + 1];
        CP[e * 2] = cr * pr - ci * pi; CP[e * 2 + 1] = cr * pi + ci * pr; }
    __syncthreads();
    if (tid < 256) { const int cp = tid >> 4, c = tid & 15; float s = 0.f;
        for (int p = 0; p < 64; ++p) s += CP[(cp * 64 + p) * 2] * Bb[(p * 16 + c) * 2] - CP[(cp * 64 + p) * 2 + 1] * Bb[(p * 16 + c) * 2 + 1];
        if (j == 0 && cp == c) s += I.dd[g * 16 + c];
        Kb[tid] = s * sig; }
    __syncthreads();
    h16* T = tcat + (size_t)g * 1024 * 1280;
    for (int e = tid; e < (64 - j) * 32; e += 512) { const int d = e >> 5, cp = (e >> 1) & 15, h = e & 1;
        const LAS float* k = Kb + cp * 16 + 8 * h;
        u32x4 w; w.x = pk2h(k[0], k[1]); w.y = pk2h(k[2], k[3]); w.z = pk2h(k[4], k[5]); w.w = pk2h(k[6], k[7]);
        *(u32x4*)(T + (size_t)slot_row((j + d) * 16 + cp) * 1280 + 16 * d + 8 * h) = w;
        if (j > 0) *(u32x4*)(T + (size_t)slot_row(d * 16 + cp) * 1280 + 16 * (j + d) + 8 * h) = (u32x4){0u, 0u, 0u, 0u}; }
    for (int e = tid; e < 1024; e += 512) { const int cp = e >> 6, p = e & 63;
        const float cr = I.cre[(g * 16 + cp) * 64 + p], ci = I.cim[(g * 16 + cp) * 64 + p], pr = Pj1[2 * p], pi = Pj1[2 * p + 1];
        h16* row = T + (size_t)slot_row(j * 16 + cp) * 1280;
        row[1024 + p] = (h16)((cr * pr - ci * pi) * sig); row[1088 + p] = (h16)(-(cr * pi + ci * pr) * sig); row[1152 + p] = (h16)0.f; row[1216 + p] = (h16)0.f; }
    h16* Wg = wst + (size_t)g * 256 * 1024;
    for (int e = tid; e < 1024; e += 512) { const int p = e >> 4, c = e & 15;
        const float pr = P63[2 * p], pi = P63[2 * p + 1], br = Bb[(p * 16 + c) * 2], bi = Bb[(p * 16 + c) * 2 + 1];
        Wg[(size_t)slot_row(p) * 1024 + 16 * j + c] = (h16)((pr * br - pi * bi) * sig); Wg[(size_t)slot_row(64 + p) * 1024 + 16 * j + c] = (h16)((pr * bi + pi * br) * sig); }
    for (int e = tid; e < 128 * 16; e += 512) { const int rr = 128 + (e >> 4), c = e & 15; Wg[(size_t)rr * 1024 + 16 * j + c] = (h16)0.f; }
}
}
namespace att {
constexpr int SC_STRIDE = 2080;
constexpr int L_KS = 0, L_VS = 18432, L_RELB = 36864, L_FBUF = 44032, L_MASK = 133120, L_HIST = 149760, L_QMM = 157952, L_TROW = 158080, L_END = 162176;
constexpr float NEG_INF = -__builtin_inff();
constexpr float THR = 6.0f;

struct P {
    const unsigned char* big; const unsigned char* small; const float* relb;
    h16* out;
    static constexpr size_t MB = 1u << 20;
    __device__ __forceinline__ const h16* qa() const { return (const h16*)big; }
    __device__ __forceinline__ const h16* qidx() const { return (const h16*)(big + 64 * MB); }
    __device__ __forceinline__ const h16* qm() const { return (const h16*)(big + 96 * MB); }
    __device__ __forceinline__ const h16* ka() const { return (const h16*)(big + 128 * MB); }
    __device__ __forceinline__ const h16* va() const { return (const h16*)(big + 136 * MB); }
    __device__ __forceinline__ const h16* kidx() const { return (const h16*)(big + 144 * MB); }
    __device__ __forceinline__ const float* widx() const { return (const float*)(big + 152 * MB); }
    __device__ __forceinline__ const h16* mk() const { return (const h16*)small; }
    __device__ __forceinline__ const h16* mvT() const { return (const h16*)(small + 4 * MB); }
};

__device__ __forceinline__ int crow(int r, int hi) { return (r & 3) + 8 * (r >> 2) + 4 * hi; }
__device__ __forceinline__ unsigned fkey(float f) { const unsigned u = __float_as_uint(f); return u ^ ((unsigned)((int)u >> 31) | 0x80000000u); }
__device__ __forceinline__ float swapmax(float m) { auto rr = __builtin_amdgcn_permlane32_swap(__float_as_uint(m), __float_as_uint(m), false, false); return fmaxf(__uint_as_float(rr[0]), __uint_as_float(rr[1])); }
__device__ __forceinline__ float swapsum(float m) { auto rr = __builtin_amdgcn_permlane32_swap(__float_as_uint(m), __float_as_uint(m), false, false); return __uint_as_float(rr[0]) + __uint_as_float(rr[1]); }
__device__ __forceinline__ float qperm_b1(float v) { return __int_as_float(__builtin_amdgcn_mov_dpp(__float_as_int(v), 0xB1, 0xF, 0xF, true)); }
__device__ __forceinline__ float qperm_4e(float v) { return __int_as_float(__builtin_amdgcn_mov_dpp(__float_as_int(v), 0x4E, 0xF, 0xF, true)); }

__device__ __forceinline__ int t5_bucket(int rel) {
    const int n = rel < 0 ? -rel : rel; int v;
    if (n < 8) v = n; else if (n < 12) v = 8; else if (n < 16) v = 9; else if (n < 23) v = 10; else if (n < 32) v = 11; else if (n < 46) v = 12; else if (n < 64) v = 13; else if (n < 91) v = 14; else v = 15;
    return (rel > 0 ? 16 : 0) + v;
}

typedef short v4i16_t __attribute__((ext_vector_type(4)));
__device__ __forceinline__ h16x4 vtr(const LAS h16* p) { return __builtin_bit_cast(h16x4, __builtin_amdgcn_ds_read_tr16_b64_v4i16((LAS v4i16_t*)p)); }
__device__ __forceinline__ float max3f(float a, float b, float c) { float r; asm("v_max3_f32 %0, %1, %2, %3" : "=v"(r) : "v"(a), "v"(b), "v"(c)); return r; }
__device__ __forceinline__ void softmax_tile(f32x16& s, float& cref, h16x8& qx, bool& started, float& lsum, f32x16& O0, f32x16& O1, LAS float* fb  , int lane, int hi, h16x8& p0, h16x8& p1) {
    float tm = max3f(s[0], s[1], s[2]); tm = max3f(tm, s[3], s[4]); tm = max3f(tm, s[5], s[6]); tm = max3f(tm, s[7], s[8]); tm = max3f(tm, s[9], s[10]); tm = max3f(tm, s[11], s[12]);
    tm = max3f(tm, s[13], s[14]); tm = max3f(tm, s[15], s[15]);
    tm = swapmax(tm);
    const bool live = tm > -__builtin_inff();
    const bool need = tm > THR || (!started && live && tm < -THR);
    if (__any(need)) {
        const float newc = need ? (float)(h16)(cref - tm) : cref; const float d = cref - newc;
        const float f = (need && started) ? __builtin_amdgcn_exp2f(-d) : 1.0f;
        cref = newc; if (hi == 0) qx[0] = (h16)newc;
        lsum *= f;
        if (hi == 0) fb[lane] = f;
        asm volatile("s_waitcnt lgkmcnt(0)" ::: "memory");
#pragma unroll
        for (int g = 0; g < 4; ++g) { const f32x4 fv = *(const LAS f32x4*)(fb + 8 * g + 4 * hi);
#pragma unroll
            for (int i = 0; i < 4; ++i) { O0[4 * g + i] *= fv[i]; O1[4 * g + i] *= fv[i]; } }
        asm volatile("s_waitcnt lgkmcnt(0)" ::: "memory");
#pragma unroll
        for (int r = 0; r < 16; ++r) s[r] -= d;
    }
    started = started || live;
    float ps = 0.f;
#pragma unroll
    for (int r = 0; r < 16; ++r) { s[r] = __builtin_amdgcn_exp2f(s[r]); ps += s[r]; }
    lsum += ps;
    p0 = (h16x8){(h16)s[0], (h16)s[1], (h16)s[2], (h16)s[3], (h16)s[4], (h16)s[5], (h16)s[6], (h16)s[7]};
    p1 = (h16x8){(h16)s[8], (h16)s[9], (h16)s[10], (h16)s[11], (h16)s[12], (h16)s[13], (h16)s[14], (h16)s[15]};
}
__device__ __forceinline__ void softmax_tile2(f32x16 (&s)[2], float (&cref)[2], bool (&started)[2], float (&lsum)[2], f32x16 (&O)[2][2], LAS float* fb  , int lane, int hi, h16x8 (&p0)[2], h16x8 (&p1)[2]) {
    float tm[2];
#pragma unroll
    for (int ct = 0; ct < 2; ++ct) { float t = max3f(s[ct][0], s[ct][1], s[ct][2]); t = max3f(t, s[ct][3], s[ct][4]); t = max3f(t, s[ct][5], s[ct][6]); t = max3f(t, s[ct][7], s[ct][8]);
        t = max3f(t, s[ct][9], s[ct][10]); t = max3f(t, s[ct][11], s[ct][12]); t = max3f(t, s[ct][13], s[ct][14]); tm[ct] = max3f(t, s[ct][15], s[ct][15]); }
    tm[0] = swapmax(tm[0]); tm[1] = swapmax(tm[1]);
    bool live[2], need[2];
#pragma unroll
    for (int ct = 0; ct < 2; ++ct) { live[ct] = tm[ct] > -__builtin_inff(); need[ct] = tm[ct] > THR || (!started[ct] && live[ct] && tm[ct] < -THR); }
    if (__any(need[0] || need[1])) {
        float d[2];
#pragma unroll
        for (int ct = 0; ct < 2; ++ct) { const float newc = need[ct] ? (float)(h16)(cref[ct] - tm[ct]) : cref[ct]; d[ct] = cref[ct] - newc;
            const float f = (need[ct] && started[ct]) ? __builtin_amdgcn_exp2f(-d[ct]) : 1.0f;
            cref[ct] = newc; if (hi == 0) fb[32 * ct + lane] = f;
            lsum[ct] *= f; }
        asm volatile("s_waitcnt lgkmcnt(0)" ::: "memory");
#pragma unroll
        for (int ct = 0; ct < 2; ++ct)
#pragma unroll
            for (int g = 0; g < 4; ++g) { const f32x4 fv = *(const LAS f32x4*)(fb + 32 * ct + 8 * g + 4 * hi);
#pragma unroll
                for (int i = 0; i < 4; ++i) { O[ct][0][4 * g + i] *= fv[i]; O[ct][1][4 * g + i] *= fv[i]; } }
        asm volatile("s_waitcnt lgkmcnt(0)" ::: "memory");
#pragma unroll
        for (int ct = 0; ct < 2; ++ct)
#pragma unroll
            for (int r = 0; r < 16; ++r) s[ct][r] -= d[ct];
    }
#pragma unroll
    for (int ct = 0; ct < 2; ++ct) { started[ct] = started[ct] || live[ct];
        float ps = 0.f;
#pragma unroll
        for (int r = 0; r < 16; ++r) { s[ct][r] = __builtin_amdgcn_exp2f(s[ct][r]); ps += s[ct][r]; }
        lsum[ct] += ps;
        p0[ct] = (h16x8){(h16)s[ct][0], (h16)s[ct][1], (h16)s[ct][2], (h16)s[ct][3], (h16)s[ct][4], (h16)s[ct][5], (h16)s[ct][6], (h16)s[ct][7]};
        p1[ct] = (h16x8){(h16)s[ct][8], (h16)s[ct][9], (h16)s[ct][10], (h16)s[ct][11], (h16)s[ct][12], (h16)s[ct][13], (h16)s[ct][14], (h16)s[ct][15]}; }
}
__device__ __forceinline__ void store_o(const f32x16& O0, const f32x16& O1, float lsum, LAS float* fb, int lane, int hi, h16* out, size_t tok0, int col0) {
    const float lt = swapsum(lsum);
    if (hi == 0) fb[lane] = 1.0f / lt;
    asm volatile("s_waitcnt lgkmcnt(0)" ::: "memory");
#pragma unroll
    for (int g = 0; g < 4; ++g) { const f32x4 fv = *(const LAS f32x4*)(fb + 8 * g + 4 * hi);
#pragma unroll
        for (int i = 0; i < 4; ++i) { const int q = 8 * g + 4 * hi + i; h16* o = out + (tok0 + q) * 768 + col0 + (lane & 31);
            o[0] = (h16)(O0[4 * g + i] * fv[i]); o[32] = (h16)(O1[4 * g + i] * fv[i]); } }
    asm volatile("s_waitcnt lgkmcnt(0)" ::: "memory");
}

#define SEL_LOAD4(dst, rowp, i0) float dst[4]; _Pragma("unroll") for (int k_ = 0; k_ < 4; ++k_) dst[k_] = ((i0) + k_ < nreg) ? (rowp)[64 * ((i0) + k_) + lane] : __builtin_nanf("");
__device__ __forceinline__ float ikey(unsigned k) { return __uint_as_float((k & 0x80000000u) ? (k ^ 0x80000000u) : ~k); }
__device__ __forceinline__ int rank64(unsigned mh, unsigned ml, int n1) {
    int cnt = 0;
#pragma unroll 1
    for (int jx = 0; jx < n1; ++jx) { const unsigned oh = __builtin_amdgcn_readlane(mh, jx), ol = __builtin_amdgcn_readlane(ml, jx); cnt += (oh > mh || (oh == mh && ol > ml)) ? 1 : 0; }
    return cnt;
}
__device__ __forceinline__ void select_slow(const LAS float* row, int nreg, LAS unsigned* hist, LAS unsigned long long* cand, LAS unsigned* mrow, float lo, float hv, int rr, int lane) {
    unsigned T = 0u; int istar = 0;
    for (int level = 0; level < 40; ++level) {
        if (hv == lo) {
            int cnt = 0; T = fkey(lo);
            for (int i0 = 0; i0 < nreg; i0 += 4) { SEL_LOAD4(s4, row, i0);
#pragma unroll
                for (int k = 0; k < 4; ++k) { unsigned long long m = __ballot(s4[k] == lo); const int pc = __popcll(m);
                    if (cnt < rr && cnt + pc >= rr) { for (int z = rr - cnt - 1; z > 0; --z) m &= m - 1ull; istar = 64 * (i0 + k) + __ffsll(m) - 1; }
                    cnt += pc; } }
            break;
        }
        const float scale = 256.0f / (hv - lo);
        *(LAS u32x4*)(hist + 4 * lane) = (u32x4){0u, 0u, 0u, 0u};
        asm volatile("s_waitcnt lgkmcnt(0)" ::: "memory");
        for (int i0 = 0; i0 < nreg; i0 += 4) { SEL_LOAD4(s4, row, i0);
#pragma unroll
            for (int k = 0; k < 4; ++k) if (s4[k] >= lo && s4[k] <= hv) { int bin = (int)((s4[k] - lo) * scale); bin = bin > 255 ? 255 : bin; __hip_atomic_fetch_add(hist + bin, 1u, __ATOMIC_RELAXED, __HIP_MEMORY_SCOPE_WORKGROUP); } }
        asm volatile("s_waitcnt lgkmcnt(0)" ::: "memory");
        const u32x4 cv = *(const LAS u32x4*)(hist + 4 * lane);
        asm volatile("s_waitcnt lgkmcnt(0)" ::: "memory");
        const unsigned tot = cv[0] + cv[1] + cv[2] + cv[3];
        unsigned S = tot;
#pragma unroll
        for (int off = 1; off < 64; off <<= 1) { const unsigned t = __shfl_down(S, off); if (lane + off < 64) S += t; }
        const unsigned above = S - tot; const bool isit = (above < (unsigned)rr) && (S >= (unsigned)rr);
        int bl = -1; unsigned Gl = 0, cum = above;
#pragma unroll
        for (int k = 3; k >= 0; --k) { if (bl < 0) { if (cum + cv[k] >= (unsigned)rr) { bl = 4 * lane + k; Gl = cum; } else cum += cv[k]; } }
        const int src = __ffsll((unsigned long long)__ballot(isit)) - 1;
        const int bstar = __shfl(bl, src); rr -= (int)__shfl(Gl, src);
        int n1 = 0; float clo = __builtin_inff(), chi = -__builtin_inff();
        for (int i0 = 0; i0 < nreg; i0 += 4) { SEL_LOAD4(s4, row, i0);
#pragma unroll
            for (int k = 0; k < 4; ++k) { bool isc = false;
                if (s4[k] >= lo && s4[k] <= hv) { int bin = (int)((s4[k] - lo) * scale); bin = bin > 255 ? 255 : bin; isc = (bin == bstar); }
                const unsigned long long m = __ballot(isc); const int pos = n1 + __builtin_amdgcn_mbcnt_hi((unsigned)(m >> 32), __builtin_amdgcn_mbcnt_lo((unsigned)m, 0u));
                if (isc) { clo = fminf(clo, s4[k]); chi = fmaxf(chi, s4[k]); if (pos < 64) cand[pos] = ((unsigned long long)fkey(s4[k]) << 32) | (unsigned long long)(0xFFFFu - (unsigned)(64 * (i0 + k) + lane)); }
                n1 += __popcll(m); } }
#pragma unroll
        for (int o = 1; o < 64; o <<= 1) { clo = fminf(clo, __shfl_xor(clo, o)); chi = fmaxf(chi, __shfl_xor(chi, o)); }
        if (n1 <= 64 && clo != chi) {
            asm volatile("s_waitcnt lgkmcnt(0)" ::: "memory");
            const unsigned long long mine = lane < n1 ? cand[lane] : 0ull;
            const unsigned mh = (unsigned)(mine >> 32), ml = (unsigned)mine;
            const int cnt = rank64(mh, ml, n1);
            const int src2 = __ffsll((unsigned long long)__ballot(lane < n1 && cnt == rr - 1)) - 1;
            T = __shfl(mh, src2); istar = 0xFFFF - (int)(__shfl(ml, src2) & 0xFFFFu);
            asm volatile("s_waitcnt lgkmcnt(0)" ::: "memory");
            break;
        }
        lo = clo; hv = chi;
    }
    for (int i0 = 0; i0 < nreg; i0 += 4) { SEL_LOAD4(s4, row, i0);
#pragma unroll
        for (int k = 0; k < 4; ++k) { const unsigned kk = fkey(s4[k]); const int idx = 64 * (i0 + k) + lane;
            const unsigned long long m = __ballot(kk > T || (kk == T && idx <= istar));
            if (lane < 2 && i0 + k < nreg) mrow[2 * (i0 + k) + lane] = lane ? (unsigned)(m >> 32) : (unsigned)m; } }
}
__device__ __forceinline__ int zbin(float s, float scn, float scp) {
    const bool neg = s < 0.f; const int b = (int)__builtin_fmaf(s, neg ? scn : scp, neg ? 126.5f : 128.0f);
    return s == 0.f ? 127 : b;
}
__device__ __forceinline__ unsigned wave_prefix_sum(unsigned v) {
    v += (unsigned)__builtin_amdgcn_update_dpp(0, (int)v, 0x111, 0xF, 0xF, false);
    v += (unsigned)__builtin_amdgcn_update_dpp(0, (int)v, 0x112, 0xF, 0xF, false);
    v += (unsigned)__builtin_amdgcn_update_dpp(0, (int)v, 0x114, 0xF, 0xF, false);
    v += (unsigned)__builtin_amdgcn_update_dpp(0, (int)v, 0x118, 0xF, 0xF, false);
    v += (unsigned)__builtin_amdgcn_update_dpp(0, (int)v, 0x142, 0xA, 0xF, false);
    v += (unsigned)__builtin_amdgcn_update_dpp(0, (int)v, 0x143, 0xC, 0xF, false);
    return v;
}
template <bool TIE0, bool TIE1> __device__ __forceinline__ void count_pass(const LAS float* rowA, const LAS float* rowB, int nreg, const float (&scn)[2], const float (&scp)[2], const int (&bstar)[2], const int (&rr)[2],
                                                                           LAS unsigned long long* cand, LAS unsigned* mrowA, LAS unsigned* mrowB, int (&n1)[2], int lane) {
    for (int i0 = 0; i0 < nreg; i0 += 4) { SEL_LOAD4(sa, rowA, i0); SEL_LOAD4(sb, rowB, i0);
        unsigned wv_[2] = {0u, 0u};
#pragma unroll
        for (int k = 0; k < 4; ++k) {
#pragma unroll
            for (int e = 0; e < 2; ++e) { const float s = e ? sb[k] : sa[k]; const bool tie = e ? TIE1 : TIE0;
                const int bin = zbin(s, scn[e], scp[e]); const bool valid = i0 + k < nreg;
                unsigned long long ms = __ballot(valid && bin > bstar[e]); const unsigned long long mc = __ballot(valid && bin == bstar[e]);
                if (mc != 0ull) {
                    const int pos = n1[e] + __builtin_amdgcn_mbcnt_hi((unsigned)(mc >> 32), __builtin_amdgcn_mbcnt_lo((unsigned)mc, 0u)); const bool isc = (mc >> lane) & 1ull;
                    if (tie) ms |= __ballot(isc && pos < rr[e]);
                    else if (isc && pos < 64) cand[64 * e + pos] = ((unsigned long long)fkey(s) << 32) | (unsigned long long)(0xFFFFu - (unsigned)(64 * (i0 + k) + lane));
                    n1[e] += __popcll(mc); }
                { const unsigned mlo_ = (unsigned)ms, mhi_ = (unsigned)(ms >> 32);
                  asm volatile("v_writelane_b32 %0, %1, %2" : "+v"(wv_[e]) : "s"(mlo_), "n"(2 * k)); asm volatile("v_writelane_b32 %0, %1, %2" : "+v"(wv_[e]) : "s"(mhi_), "n"(2 * k + 1)); } } }
        if (lane < 8) { mrowA[2 * i0 + lane] = wv_[0]; mrowB[2 * i0 + lane] = wv_[1]; } }
}
__device__ __attribute__((noinline)) void select2(const LAS float* rowA, const LAS float* rowB, int nreg, LAS unsigned* hist, LAS unsigned* mrowA, LAS unsigned* mrowB, const LAS unsigned* qmm, int lane) {
    LAS unsigned long long* cand = (LAS unsigned long long*)hist;
    const LAS float* row[2] = {rowA, rowB}; LAS unsigned* mrow[2] = {mrowA, mrowB};
    float scn[2], scp[2];
#pragma unroll
    for (int e = 0; e < 2; ++e) { const float lo = ikey(qmm[2 * e]), hv = ikey(qmm[2 * e + 1]); scn[e] = lo < 0.f ? 126.5f / (0.f - lo) : 0.f; scp[e] = hv > 0.f ? 127.5f / hv : 0.f; }
    *(LAS u32x4*)(hist + 4 * lane) = (u32x4){0u, 0u, 0u, 0u};
    asm volatile("s_waitcnt lgkmcnt(0)" ::: "memory");
    for (int i0 = 0; i0 < nreg; i0 += 4) { SEL_LOAD4(sa, rowA, i0); SEL_LOAD4(sb, rowB, i0);
#pragma unroll
        for (int k = 0; k < 4; ++k) if (i0 + k < nreg) {
            __hip_atomic_fetch_add(hist + zbin(sa[k], scn[0], scp[0]), 1u, __ATOMIC_RELAXED, __HIP_MEMORY_SCOPE_WORKGROUP);
            __hip_atomic_fetch_add(hist + zbin(sb[k], scn[1], scp[1]), 0x10000u, __ATOMIC_RELAXED, __HIP_MEMORY_SCOPE_WORKGROUP); } }
    asm volatile("s_waitcnt lgkmcnt(0)" ::: "memory");
    const u32x4 cvp = *(const LAS u32x4*)(hist + 4 * lane);
    asm volatile("s_waitcnt lgkmcnt(0)" ::: "memory");
    int bstar[2], rr[2];
#pragma unroll
    for (int e = 0; e < 2; ++e) { unsigned cv[4];
#pragma unroll
        for (int k = 0; k < 4; ++k) cv[k] = (cvp[k] >> (16 * e)) & 0xFFFFu;
        const unsigned tot = cv[0] + cv[1] + cv[2] + cv[3]; const unsigned pre = wave_prefix_sum(tot);
        const unsigned S = (unsigned)__builtin_amdgcn_readlane((int)pre, 63) - pre + tot;
        const unsigned above = S - tot; const bool isit = (above < 256u) && (S >= 256u);
        int bl = -1; unsigned Gl = 0, cum = above;
#pragma unroll
        for (int k = 3; k >= 0; --k) { if (bl < 0) { if (cum + cv[k] >= 256u) { bl = 4 * lane + k; Gl = cum; } else cum += cv[k]; } }
        const int src = __ffsll((unsigned long long)__ballot(isit)) - 1;
        bstar[e] = __builtin_amdgcn_readlane(bl, src); rr[e] = 256 - __builtin_amdgcn_readlane((int)Gl, src); }
    int n1[2] = {0, 0};
    const bool t0 = bstar[0] == 127, t1 = bstar[1] == 127;
    if (!t0 && !t1) count_pass<false, false>(rowA, rowB, nreg, scn, scp, bstar, rr, cand, mrowA, mrowB, n1, lane);
    else if (t0 && !t1) count_pass<true, false>(rowA, rowB, nreg, scn, scp, bstar, rr, cand, mrowA, mrowB, n1, lane);
    else if (!t0 && t1) count_pass<false, true>(rowA, rowB, nreg, scn, scp, bstar, rr, cand, mrowA, mrowB, n1, lane);
    else count_pass<true, true>(rowA, rowB, nreg, scn, scp, bstar, rr, cand, mrowA, mrowB, n1, lane);
    asm volatile("s_waitcnt lgkmcnt(0)" ::: "memory");
#ifndef SEL_FAST_MAX
#define SEL_FAST_MAX 64
#endif
#pragma unroll
    for (int e = 0; e < 2; ++e) if (bstar[e] != 127 && n1[e] <= SEL_FAST_MAX) {
        const unsigned long long mine = lane < n1[e] ? cand[64 * e + lane] : 0ull; const unsigned mh = (unsigned)(mine >> 32), ml = (unsigned)mine;
        const int cnt = rank64(mh, ml, n1[e]);
        if (lane < n1[e] && cnt < rr[e]) { const unsigned idx = 0xFFFFu - (ml & 0xFFFFu); __hip_atomic_fetch_or(mrow[e] + (idx >> 5), 1u << (idx & 31u), __ATOMIC_RELAXED, __HIP_MEMORY_SCOPE_WORKGROUP); } }
    asm volatile("s_waitcnt lgkmcnt(0)" ::: "memory");
#pragma unroll
    for (int e = 0; e < 2; ++e) if (bstar[e] != 127 && n1[e] > SEL_FAST_MAX) {
        float clo = __builtin_inff(), chi = -__builtin_inff();
        for (int i0 = 0; i0 < nreg; i0 += 4) { SEL_LOAD4(s4, row[e], i0);
#pragma unroll
            for (int k = 0; k < 4; ++k) if (i0 + k < nreg && zbin(s4[k], scn[e], scp[e]) == bstar[e]) { clo = fminf(clo, s4[k]); chi = fmaxf(chi, s4[k]); } }
#pragma unroll
        for (int o = 1; o < 64; o <<= 1) { clo = fminf(clo, __shfl_xor(clo, o)); chi = fmaxf(chi, __shfl_xor(chi, o)); }
        select_slow(row[e], nreg, hist, cand, mrow[e], clo, chi, rr[e], lane); }
}
#undef SEL_LOAD4

__device__ __forceinline__ void build_relb(const float* relb, LAS unsigned char* lds, int tid) {
    LAS float* rb = (LAS float*)(lds + L_RELB);
    for (int e = tid; e < 8 * 224; e += 512) { const int h = e / 224, rel = e % 224 - 160; rb[e] = (relb[t5_bucket(rel) * 8 + h] - relb[15 * 8 + h]) * LOG2E; }
}
#ifdef TIMING_VARIANT
#define TV(bit) (variant & (bit))
#else
#define TV(bit) 0
#endif
__device__ __forceinline__ void attn_unit(const P& A, int b, int c, LAS unsigned char* lds, int tid, int variant) {
    const int lane = tid & 63, wv = __builtin_amdgcn_readfirstlane(tid >> 6), col = lane & 31, hi = lane >> 5;
    const int L = 64 * (c + 1), ntile = L / 32;
    const size_t tokb = (size_t)b * SEQ;
    LAS unsigned* maskw = (LAS unsigned*)(lds + L_MASK);
    LAS float* fb = (LAS float*)(lds + L_FBUF) + wv * 64;
    __syncthreads();
    if (c < 4 || TV(1)) {
        for (int e = tid; e < 64 * ntile; e += 512) { const int q = e / ntile, j = e % ntile; maskw[q * 65 + j] = 0xFFFFFFFFu; }
    } else {
        LAS float* sc = (LAS float*)lds; LAS unsigned* qmm = (LAS unsigned*)(lds + L_QMM);
        const int l15 = lane & 15, l4 = lane >> 4;
        h16x8 af[4][2]; f32x4 w4[4]; h16x8 bf[2][2], bn[2][2];
#define SC_LOAD_Q(rd_) do { _Pragma("unroll") for (int rt = 0; rt < 4; ++rt) { const size_t tqa = tokb + 64 * c + 16 * (rd_) + 4 * rt + (l15 >> 2); \
            _Pragma("unroll") for (int ks = 0; ks < 2; ++ks) af[rt][ks] = *(const h16x8*)(A.qidx() + tqa * 256 + (l15 & 3) * 64 + 32 * ks + 8 * l4); \
            w4[rt] = *(const f32x4*)(A.widx() + (tokb + 64 * c + 16 * (rd_) + 4 * rt + l4) * 4); } \
          { const h16* kp = A.kidx() + (tokb + 32 * wv + l15) * 64 + 8 * l4; \
            _Pragma("unroll") for (int u = 0; u < 2; ++u) _Pragma("unroll") for (int ks = 0; ks < 2; ++ks) bf[u][ks] = *(const h16x8*)(kp + u * 16 * 64 + 32 * ks); } } while (0)
        SC_LOAD_Q(0);
        for (int rd = 0; rd < 4; ++rd) {
            if (tid < 32) qmm[tid] = (tid & 1) ? 0u : 0xFFFFFFFFu;
            __syncthreads();
            float smn[4], smx[4];
#pragma unroll
            for (int rt = 0; rt < 4; ++rt) { smn[rt] = __builtin_inff(); smx[rt] = -__builtin_inff(); }
            for (int j = wv; j < ntile; j += 8) {
                if (j + 8 < ntile) { const h16* kp = A.kidx() + (tokb + 32 * (j + 8) + l15) * 64 + 8 * l4;
#pragma unroll
                    for (int u = 0; u < 2; ++u)
#pragma unroll
                        for (int ks = 0; ks < 2; ++ks) bn[u][ks] = *(const h16x8*)(kp + u * 16 * 64 + 32 * ks); }
#pragma unroll
                for (int u = 0; u < 2; ++u)
#pragma unroll
                    for (int rt = 0; rt < 4; ++rt) {
                        f32x4 acc = {0.f, 0.f, 0.f, 0.f};
                        acc = __builtin_amdgcn_mfma_f32_16x16x32_f16(af[rt][0], bf[u][0], acc, 0, 0, 0);
                        acc = __builtin_amdgcn_mfma_f32_16x16x32_f16(af[rt][1], bf[u][1], acc, 0, 0, 0);
                        float sv = fmaxf(acc[0], 0.f) * w4[rt][0]; sv += fmaxf(acc[1], 0.f) * w4[rt][1]; sv += fmaxf(acc[2], 0.f) * w4[rt][2]; sv += fmaxf(acc[3], 0.f) * w4[rt][3];
                        sv += 0.0f;
                        smn[rt] = fminf(smn[rt], sv); smx[rt] = fmaxf(smx[rt], sv);
                        sc[(4 * rt + l4) * SC_STRIDE + 32 * j + 16 * u + l15] = sv;
                    }
#pragma unroll
                for (int u = 0; u < 2; ++u)
#pragma unroll
                    for (int ks = 0; ks < 2; ++ks) bf[u][ks] = bn[u][ks];
            }
#pragma unroll
            for (int rt = 0; rt < 4; ++rt) { __hip_atomic_fetch_min(qmm + 2 * (4 * rt + l4), fkey(smn[rt]), __ATOMIC_RELAXED, __HIP_MEMORY_SCOPE_WORKGROUP); __hip_atomic_fetch_max(qmm + 2 * (4 * rt + l4) + 1, fkey(smx[rt]), __ATOMIC_RELAXED, __HIP_MEMORY_SCOPE_WORKGROUP); }
            if (rd + 1 < 4) SC_LOAD_Q(rd + 1);
            __syncthreads();
            if (!TV(16))
            select2(sc + (2 * wv) * SC_STRIDE, sc + (2 * wv + 1) * SC_STRIDE, L / 64, (LAS unsigned*)(lds + L_HIST) + wv * 256, maskw + (16 * rd + 2 * wv) * 65, maskw + (16 * rd + 2 * wv + 1) * 65, qmm + 4 * wv, lane);
            __syncthreads();
        }
    }
    if (!TV(2)) {
        const int h = wv;
        LAS h16* Ks = (LAS h16*)(lds + L_KS); LAS h16* Vs = (LAS h16*)(lds + L_VS);
        build_relb(A.relb, lds, tid);
        const LAS float* rb = (const LAS float*)(lds + L_RELB) + h * 224;
        h16x8 qf[2][4];
#pragma unroll
        for (int ct = 0; ct < 2; ++ct)
#pragma unroll
            for (int s = 0; s < 4; ++s) qf[ct][s] = *(const h16x8*)(A.qa() + (tokb + 64 * c + 32 * ct + col) * 512 + h * 64 + 16 * s + 8 * hi);
        f32x16 O[2][2]; float lsum[2], cref[2]; bool started[2] = {false, false};
        const h16 b15h = (h16)(A.relb[15 * 8 + h] * LOG2E);
#pragma unroll
        for (int ct = 0; ct < 2; ++ct) { O[ct][0] = (f32x16){}; O[ct][1] = (f32x16){}; lsum[ct] = 0.f; cref[ct] = (float)b15h; }
        const int srow = tid >> 3, spc = tid & 7;
        const h16* gk = A.ka() + (tokb + srow) * 64 + 8 * spc; const h16* gv = A.va() + (tokb + srow) * 64 + 8 * spc;
        LAS h16* kdst = Ks + srow * 72 + 8 * spc; LAS h16* vdst = Vs + srow * 72 + 8 * spc;
#define ATT_STAGE_K(stage, vk) do { *(LAS u32x4*)(kdst + (stage) * (64 * 72)) = (vk); } while (0)
#define ATT_STAGE_V(stage, vv) do { *(LAS u32x4*)(vdst + (stage) * (64 * 72)) = (vv); } while (0)
        const int nst = ntile / 2;
        u32x4 sreg = *(const u32x4*)gk; ATT_STAGE_K(0, sreg); sreg = *(const u32x4*)gv; ATT_STAGE_V(0, sreg);
        __syncthreads();
        for (int js = 0; js < nst; ++js) {
            const int st = js & 1;
            if (js + 1 < nst) sreg = *(const u32x4*)(gk + (size_t)(js + 1) * (64 * 64));
#pragma unroll 1
            for (int t2 = 0; t2 < 2; ++t2) {
            const int j = 2 * js + t2;
            const LAS h16* kb = Ks + st * (64 * 72) + (32 * t2 + col) * 72 + 8 * hi;
            h16x8 kf[4];
#pragma unroll
            for (int s = 0; s < 4; ++s) kf[s] = *(const LAS h16x8*)(kb + 16 * s);
            const bool far = j <= 2 * c - 4;
            const LAS h16* vb = Vs + st * (64 * 72) + (32 * t2 + 4 * hi + ((lane & 15) >> 2)) * 72 + 16 * ((lane >> 4) & 1) + 4 * (lane & 3);
            f32x16 sa[2];
#pragma unroll
            for (int ct = 0; ct < 2; ++ct) { const h16x8 qxt = {hi == 0 ? (h16)cref[ct] : (h16)0.0f, 0, 0, 0, 0, 0, 0, 0};
                const h16x8 kxt = {hi == 0 ? (h16)1.0f : (h16)0.0f, 0, 0, 0, 0, 0, 0, 0};
                sa[ct] = __builtin_amdgcn_mfma_f32_32x32x16_f16(kxt, qxt, (f32x16){}, 0, 0, 0);
#pragma unroll
                for (int s = 0; s < 4; ++s) sa[ct] = __builtin_amdgcn_mfma_f32_32x32x16_f16(kf[s], qf[ct][s], sa[ct], 0, 0, 0); }
            if (!far) {
#pragma unroll
                for (int ct = 0; ct < 2; ++ct) { const int rel0 = 32 * j - (64 * c + 32 * ct + col) + 160 + 4 * hi;
#pragma unroll
                    for (int r = 0; r < 16; ++r) sa[ct][r] += rb[rel0 + (r & 3) + 8 * (r >> 2)]; } }
#pragma unroll
            for (int ct = 0; ct < 2; ++ct) { const unsigned word = maskw[(32 * ct + col) * 65 + j] >> (4 * hi);
#pragma unroll
                for (int r = 0; r < 16; ++r) { const int neg = __builtin_amdgcn_sbfe((int)word, (r & 3) + 8 * (r >> 2), 1);
                    sa[ct][r] = __int_as_float((neg & __float_as_int(sa[ct][r])) | (~neg & (int)0xFF800000)); } }
            h16x8 p0[2], p1[2];
            if (TV(64)) {
#pragma unroll
                for (int ct = 0; ct < 2; ++ct) { p0[ct] = (h16x8){(h16)sa[ct][0], (h16)sa[ct][1], (h16)sa[ct][2], (h16)sa[ct][3], (h16)sa[ct][4], (h16)sa[ct][5], (h16)sa[ct][6], (h16)sa[ct][7]};
                    p1[ct] = (h16x8){(h16)sa[ct][8], (h16)sa[ct][9], (h16)sa[ct][10], (h16)sa[ct][11], (h16)sa[ct][12], (h16)sa[ct][13], (h16)sa[ct][14], (h16)sa[ct][15]}; } }
            else
            softmax_tile2(sa, cref, started, lsum, O, fb, lane, hi, p0, p1);
#pragma unroll
            for (int db = 0; db < 2; ++db) {
                const LAS h16* vp = vb + 32 * db;
                const h16x4 a0 = vtr(vp), a1 = vtr(vp + 8 * 72), c0 = vtr(vp + 16 * 72), c1 = vtr(vp + 24 * 72);
                const h16x8 v0 = {a0[0], a0[1], a0[2], a0[3], a1[0], a1[1], a1[2], a1[3]}, v1 = {c0[0], c0[1], c0[2], c0[3], c1[0], c1[1], c1[2], c1[3]};
#pragma unroll
                for (int ct = 0; ct < 2; ++ct) { O[ct][db] = __builtin_amdgcn_mfma_f32_32x32x16_f16(p0[ct], v0, O[ct][db], 0, 0, 0); O[ct][db] = __builtin_amdgcn_mfma_f32_32x32x16_f16(p1[ct], v1, O[ct][db], 0, 0, 0); }
            }
            if (js + 1 < nst) { if (t2 == 0) { ATT_STAGE_K(st ^ 1, sreg); sreg = *(const u32x4*)(gv + (size_t)(js + 1) * (64 * 64)); } else ATT_STAGE_V(st ^ 1, sreg); }
            }
            if (!TV(32)) __syncthreads();
#ifdef ATT_SKEW
            if (wv >= 4) __builtin_amdgcn_s_sleep(ATT_SKEW);
#endif
        }
#pragma unroll
        for (int ct = 0; ct < 2; ++ct) store_o(O[ct][0], O[ct][1], lsum[ct], fb + 32 * ct, lane, hi, A.out, tokb + 64 * c + 32 * ct, h * 64);
    }
    if (!TV(4)) {
        const int qg = wv >> 2, hm = wv & 3; const size_t tok0 = tokb + 64 * c + 32 * qg;
        h16x8 qf[4];
#pragma unroll
        for (int s = 0; s < 4; ++s) qf[s] = *(const h16x8*)(A.qm() + (tok0 + col) * 256 + hm * 64 + 16 * s + 8 * hi);
        f32x16 O0 = {}, O1 = {}; float lsum = 0.f, cref = 0.f; h16x8 qx = {0, 0, 0, 0, 0, 0, 0, 0}; bool started = false;
        const h16x8 kx = {hi == 0 ? (h16)1.0f : (h16)0.0f, 0, 0, 0, 0, 0, 0, 0};
        const h16* kbase = A.mk() + ((size_t)b * MEMT + col) * 256 + hm * 64 + 8 * hi;
        const h16* vbase = A.mvT() + (((size_t)b * 4 + hm) * 64 + col) * MEMT + 4 * hi;
        h16x8 kf[4], kn[4]; h16x4 vf[8], vn[8];
#pragma unroll
        for (int s = 0; s < 4; ++s) kf[s] = *(const h16x8*)(kbase + 16 * s);
#pragma unroll
        for (int db = 0; db < 2; ++db)
#pragma unroll
            for (int q4 = 0; q4 < 4; ++q4) vf[4 * db + q4] = *(const h16x4*)(vbase + (size_t)db * 32 * MEMT + 8 * q4);
        for (int j = 0; j < MEMT / 32; ++j) {
            if (j + 1 < MEMT / 32) {
#pragma unroll
                for (int s = 0; s < 4; ++s) kn[s] = *(const h16x8*)(kbase + (size_t)(j + 1) * 32 * 256 + 16 * s);
#pragma unroll
                for (int db = 0; db < 2; ++db)
#pragma unroll
                    for (int q4 = 0; q4 < 4; ++q4) vn[4 * db + q4] = *(const h16x4*)(vbase + (size_t)db * 32 * MEMT + 32 * (j + 1) + 8 * q4); }
            f32x16 sa = __builtin_amdgcn_mfma_f32_32x32x16_f16(kx, qx, (f32x16){}, 0, 0, 0);
#pragma unroll
            for (int s = 0; s < 4; ++s) sa = __builtin_amdgcn_mfma_f32_32x32x16_f16(kf[s], qf[s], sa, 0, 0, 0);
            h16x8 p0, p1;
            softmax_tile(sa, cref, qx, started, lsum, O0, O1, fb, lane, hi, p0, p1);
#pragma unroll
            for (int db = 0; db < 2; ++db) {
                const h16x4 a0 = vf[4 * db], a1 = vf[4 * db + 1], c0 = vf[4 * db + 2], c1 = vf[4 * db + 3];
                const h16x8 v0 = {a0[0], a0[1], a0[2], a0[3], a1[0], a1[1], a1[2], a1[3]}, v1 = {c0[0], c0[1], c0[2], c0[3], c1[0], c1[1], c1[2], c1[3]};
                if (db == 0) { O0 = __builtin_amdgcn_mfma_f32_32x32x16_f16(p0, v0, O0, 0, 0, 0); O0 = __builtin_amdgcn_mfma_f32_32x32x16_f16(p1, v1, O0, 0, 0, 0); }
                else { O1 = __builtin_amdgcn_mfma_f32_32x32x16_f16(p0, v0, O1, 0, 0, 0); O1 = __builtin_amdgcn_mfma_f32_32x32x16_f16(p1, v1, O1, 0, 0, 0); }
            }
#pragma unroll
            for (int s = 0; s < 4; ++s) kf[s] = kn[s];
#pragma unroll
            for (int q8 = 0; q8 < 8; ++q8) vf[q8] = vn[q8];
        }
        store_o(O0, O1, lsum, fb, lane, hi, A.out, tok0, 512 + hm * 64);
    }
}

}
#ifndef GLU_ALIGN
#define GLU_ALIGN true
#endif
#ifndef MK_N_LAUNCHES
#define MK_N_LAUNCHES 1
#endif
constexpr int N_PHASES = 12;
constexpr int NWAVES = 8;
constexpr size_t MiB = 1u << 20;
constexpr size_t WS_CTL = 0, CTL_ZERO_BYTES = 1 * MiB;
constexpr size_t WS_W1A = 1 * MiB, WS_W1B = 12 * MiB, WS_WIN = 18 * MiB, WS_WMKV = 27 * MiB, WS_WGLU = 28 * MiB, WS_WOA = 29 * MiB, WS_WOM = 30 * MiB, WS_WOUT = 31 * MiB,
                 WS_W2A = 33 * MiB, WS_W2B = 44 * MiB, WS_TCAT = 50 * MiB, WS_WST = 90 * MiB;
constexpr size_t WS_RSTD0 = 98 * MiB, WS_SSQ1 = 99 * MiB, WS_SSQ2 = 103 * MiB, WS_SSQ3 = 107 * MiB, WS_MEMH = 111 * MiB, WS_MK = 127 * MiB, WS_MVT = 131 * MiB, WS_A64 = 135 * MiB;
constexpr size_t WS_ABUF = 136 * MiB;
constexpr size_t WS_CBUF = 264 * MiB;
constexpr size_t WS_YS = WS_CBUF + 96 * MiB;
constexpr size_t WS_BIG = 392 * MiB;
constexpr size_t WS_QA = WS_BIG, WS_QIDX = WS_BIG + 64 * MiB, WS_QM = WS_BIG + 96 * MiB, WS_OB = WS_BIG  ,
                 WS_KA = WS_BIG + 128 * MiB, WS_VAT = WS_BIG + 136 * MiB, WS_KIDX = WS_BIG + 144 * MiB, WS_WIDX = WS_BIG + 152 * MiB, WS_ACAT = WS_BIG + 153 * MiB, WS_GATES = WS_BIG + 193 * MiB;
constexpr size_t WS_END = WS_GATES + 384 * MiB;
static_assert(WS_END <= 1024 * MiB, "workspace map");
constexpr int CW_BAR = 4096, CW_FIN = 16384;

constexpr int LDS_BYTES = 163840;
constexpr int MISC_OFF = LDS_BYTES - 256;

#define XB_TMO      128
#define XB_XCNT(j)  (256  + 64 * (j))
#define XB_XSUB(j)  (1280 + 64 * (j))
#define XB_XGEN(j)  (2304 + 64 * (j))
#define XB_TOP      3328
#define XB_TOPGEN   3392
#define XCD_BAR_WORDS 3456
#define XB_SPIN_CAP (1u << 18)
__device__ __forceinline__ unsigned xb_ld(unsigned* p)              { return __hip_atomic_load(p, __ATOMIC_RELAXED, __HIP_MEMORY_SCOPE_AGENT); }
__device__ __forceinline__ unsigned xb_add(unsigned* p, unsigned v) { return __hip_atomic_fetch_add(p, v, __ATOMIC_RELAXED, __HIP_MEMORY_SCOPE_AGENT); }
__device__ __forceinline__ unsigned xb_xcc_id() { return (unsigned)__builtin_amdgcn_s_getreg((3 << 11) | 20) & 0xFu; }
#define XB_SPIN(cond, bar) do { unsigned _sp = 0; while (cond) { __builtin_amdgcn_s_sleep(1); \
    if ((++_sp & 255u) == 0u) { if (xb_ld(&(bar)[XB_TMO])) break; if (_sp > XB_SPIN_CAP) { atomicAdd(&(bar)[XB_TMO], 1u); break; } } } } while (0)
struct XcdBarrier { unsigned* bar; unsigned x; volatile LAS unsigned* st; };
__device__ __forceinline__ XcdBarrier xcd_barrier_post(unsigned* bar, volatile LAS unsigned* st) {
    XcdBarrier b; b.bar = bar; b.x = xb_xcc_id(); b.st = st;
    if (threadIdx.x == 0) (void)xb_add(&bar[XB_XCNT(b.x)], 1u);
    return b;
}
__device__ __forceinline__ void xcd_barrier_complete(unsigned* bar, unsigned x, unsigned& nloc, unsigned& nx) {
    const unsigned G = gridDim.x * gridDim.y * gridDim.z;
    unsigned sum, cnt, mine, sp = 0u;
    for (;;) {
        sum = 0u; cnt = 0u; mine = 0u;
#pragma unroll
        for (unsigned j = 0; j < 16; ++j) { const unsigned c = xb_ld(&bar[XB_XCNT(j)]); sum += c; cnt += (c > 0u) ? 1u : 0u; mine = (j == x) ? c : mine; }
        if (sum == G) break;
        __builtin_amdgcn_s_sleep(1);
        if ((++sp & 255u) == 0u) { if (xb_ld(&bar[XB_TMO])) break; if (sp > XB_SPIN_CAP) { atomicAdd(&bar[XB_TMO], 1u); break; } }
    }
    nloc = mine > 0u ? mine : 1u; nx = cnt > 0u ? cnt : 1u;
}
__device__ __forceinline__ void xcd_barrier(const XcdBarrier& b) {
    asm volatile("s_waitcnt vmcnt(0)" ::: "memory");
    __syncthreads();
    if (threadIdx.x == 0) {
        unsigned* bar = b.bar;
        __builtin_amdgcn_s_waitcnt(0);
        unsigned nloc = b.st[0], nx = b.st[1];
        if (nloc == 0u) { xcd_barrier_complete(bar, b.x, nloc, nx); b.st[0] = nloc; b.st[1] = nx; }
        const unsigned old = xb_add(&bar[XB_XSUB(b.x)], 1u);
        const unsigned gen = old / nloc;
        if (old + 1u == (gen + 1u) * nloc) {
            __builtin_amdgcn_fence(__ATOMIC_RELEASE, "agent");
            asm volatile("s_waitcnt vmcnt(0)" ::: "memory");
            const unsigned og = xb_add(&bar[XB_TOP], 1u);
            const unsigned tg = og / nx;
            if (og + 1u == (tg + 1u) * nx) xb_add(&bar[XB_TOPGEN], 1u);
            else XB_SPIN(xb_ld(&bar[XB_TOPGEN]) == tg, bar);
            __builtin_amdgcn_fence(__ATOMIC_ACQUIRE, "agent");
            xb_add(&bar[XB_XGEN(b.x)], 1u);
            asm volatile("s_waitcnt vmcnt(0)" ::: "memory");
        } else {
            XB_SPIN(xb_ld(&bar[XB_XGEN(b.x)]) == gen, bar);
            __builtin_amdgcn_fence(__ATOMIC_ACQUIRE, "agent");
            asm volatile("s_waitcnt vmcnt(0)" ::: "memory");
        }
    }
    __syncthreads();
}

enum { I_X = 0, I_MEM, I_FFN1_NORM, I_FFN1_WIN, I_FFN1_WOUT, I_MIX_NORM, I_W_IN, I_AQG, I_AKG, I_RELB, I_WOA, I_LRE, I_LIM, I_LOGDT, I_BRE, I_BIM, I_CRE, I_CIM, I_SSMD, I_WGLU,
       I_MEM_NORM, I_WMKV, I_MQG, I_MKG, I_WOM, I_WOUT, I_FFN2_NORM, I_FFN2_WIN, I_FFN2_WOUT, I_FINAL_NORM, N_IN };
struct Args { const float* in[N_IN]; float* out; unsigned char* ws; int ph_lo, ph_hi, variant, pad; };
static_assert(sizeof(Args) == (N_IN + 2) * 8 + 16, "Args has no padding");

__global__ void __launch_bounds__(NWAVES * 64, 2) mega_fwd(Args args) {
    extern __shared__ __attribute__((aligned(16))) unsigned char lds_raw[];
    LAS unsigned char* lds = (LAS unsigned char*)lds_raw;
    volatile LAS unsigned* MISC = (volatile LAS unsigned*)(lds + MISC_OFF);
    const int tid = threadIdx.x, lane = tid & 63, wave = __builtin_amdgcn_readfirstlane(tid >> 6);
    const int G = gridDim.x; const int bx = blockIdx.x; const int vcu = (G % 8 == 0) ? (bx % 8) * (G / 8) + bx / 8 : bx;
    unsigned char* ws = args.ws;
    unsigned* ctl = (unsigned*)(ws + WS_CTL);
    for (int u = tid; u < 64; u += NWAVES * 64) MISC[u] = 0u;
    __syncthreads();
    const int lo = args.ph_lo, hi = args.ph_hi;
    XcdBarrier bar; bar.bar = ctl + CW_BAR; bar.x = 0; bar.st = nullptr;
    if (hi - lo > 1) bar = xcd_barrier_post(ctl + CW_BAR, MISC + 8);
#ifdef ONLY_PHASE
#define IN(k) ((k) == ONLY_PHASE && lo <= (k) && (k) < hi)
#else
#define IN(k) (lo <= (k) && (k) < hi)
#endif
#ifdef DBG_SPIN
#define SEAM(k) do { if (IN(k) && IN((k) + 1)) xcd_barrier(bar); if (bx == 0 && tid == 0) ((unsigned long long*)(ctl + 9100))[(k) + 1] = __builtin_amdgcn_s_memrealtime(); } while (0)
#else
#define SEAM(k) do { if (IN(k) && IN((k) + 1)) xcd_barrier(bar); } while (0)
#endif

    float* const xres = args.out;
#define WSP(T, off) ((T*)(ws + (off)))
#define W1A WSP(h16, WS_W1A)
#define W1B WSP(h16, WS_W1B)
#define WIN WSP(h16, WS_WIN)
#define WMKV WSP(h16, WS_WMKV)
#define WGLU WSP(h16, WS_WGLU)
#define WOA WSP(h16, WS_WOA)
#define WOM WSP(h16, WS_WOM)
#define WOUT WSP(h16, WS_WOUT)
#define W2A WSP(h16, WS_W2A)
#define W2B WSP(h16, WS_W2B)
#define TCAT WSP(h16, WS_TCAT)
#define WST WSP(h16, WS_WST)
#define rstd0 WSP(float, WS_RSTD0)
#define ssq1 WSP(float, WS_SSQ1)
#define ssq2 WSP(float, WS_SSQ2)
#define ssq3 WSP(float, WS_SSQ3)
#define memh WSP(h16, WS_MEMH)
#define mk WSP(h16, WS_MK)
#define mvT WSP(h16, WS_MVT)
#define a64 WSP(float, WS_A64)
#define abuf WSP(h16, WS_ABUF)
#define mergedb ((h16*)args.out)
#define acatt WSP(h16, WS_CBUF)
#define ys WSP(h16, WS_YS)
#define x2h WSP(h16, WS_CBUF)
#define hidden WSP(h16, WS_BIG)
#define qa WSP(h16, WS_QA)
#define qidx WSP(h16, WS_QIDX)
#define qm WSP(h16, WS_QM)
#define ob WSP(h16, WS_OB)
#define ka WSP(h16, WS_KA)
#define va WSP(h16, WS_VAT)
#define kidx WSP(h16, WS_KIDX)
#define widx WSP(float, WS_WIDX)
#define acat WSP(h16, WS_ACAT)
#define gates WSP(h16, WS_GATES)
#ifdef DBG_SPIN
    if (bx == 0 && tid == 0) ((unsigned long long*)(ctl + 9100))[0] = __builtin_amdgcn_s_memrealtime();
#endif
    if (IN(0)) {
        const int gw = vcu * NWAVES + wave, NGW = G * NWAVES;
        LAS float* scr = (LAS float*)(lds + wave * 16384);
        pro::WPtrs WP{args.in[I_FFN1_WIN], args.in[I_FFN1_WOUT], args.in[I_W_IN], args.in[I_WMKV], args.in[I_WGLU], args.in[I_WOA], args.in[I_WOM], args.in[I_WOUT], args.in[I_FFN2_WIN], args.in[I_FFN2_WOUT],
                      args.in[I_FFN1_NORM], args.in[I_MIX_NORM], args.in[I_FFN2_NORM], W1A, W1B, WIN, WMKV, WGLU, WOA, WOM, WOUT, W2A, W2B};
        for (int it = gw; it < pro::IT_TOTAL; it += NGW) pro::weight_item(WP, it, scr, lane);
        for (int m = gw; m < MTOK; m += 4 * NGW) pro::rows_to_h16<4>(args.in[I_X], abuf, m, NGW, MTOK, nullptr, rstd0, lane);
        for (int m = gw; m < BATCH * MEMT; m += 4 * NGW) pro::rows_to_h16<4>(args.in[I_MEM], memh, m, NGW, BATCH * MEMT, args.in[I_MEM_NORM], nullptr, lane);
        for (int i = (vcu * NWAVES + wave) * 64 + lane; i < MTOK; i += G * NWAVES * 64) { ssq1[i] = 0.f; ssq2[i] = 0.f; ssq3[i] = 0.f; }
        pro::S5In SI{args.in[I_LRE], args.in[I_LIM], args.in[I_LOGDT], args.in[I_BRE], args.in[I_BIM], args.in[I_CRE], args.in[I_CIM], args.in[I_SSMD]};
        for (int it = vcu; it < 16 * 64; it += G) pro::s5_item(SI, it >> 6, it & 63, TCAT, WST, a64, (LAS float*)lds, tid);
        __syncthreads();
    }
    SEAM(0);
    if (IN(1)) {
#if defined(DBG_CLOCK)
        unsigned long long t0w_ = __builtin_amdgcn_s_memrealtime();
        if (DBG_CLOCK < 10 && bx == 0 && tid == 0) { ((unsigned long long*)(ctl + 9000))[0] = __builtin_amdgcn_s_memtime(); ((unsigned long long*)(ctl + 9000))[1] = t0w_; }
#endif
        pg8::Gemm g{abuf, W1A, 1024, 1024, 1024}; pg8::StaticOrder S; S.init(MTOK, 2 * FFN, G, bx);
        epi::EpiSwiglu<0> E{hidden, rstd0};
        pg8::gemm_phase<epi::EpiSwiglu<0>, pg8::StaticOrder, true, true>(lds, g, S, E);
#ifdef DBG_CLOCK
        if (tid == 0) { const unsigned d_ = (unsigned)(__builtin_amdgcn_s_memrealtime() - t0w_); atomicMax(ctl + 9016, d_); atomicMin(ctl + 9017, ~0u - d_ == 0 ? 0 : d_ ); atomicMax(ctl + 9018, ~d_); }
        if (DBG_CLOCK < 10 && bx == 0 && tid == 0) { ((unsigned long long*)(ctl + 9000))[2] = __builtin_amdgcn_s_memtime(); ((unsigned long long*)(ctl + 9000))[3] = __builtin_amdgcn_s_memrealtime(); }
#endif
    }
    SEAM(1);
    if (IN(2)) {
        { pg8::Gemm g{hidden, W1B, FFN, FFN, FFN}; pg8::StaticOrder S; S.init(MTOK, DM, G, bx);
          epi::EpiResid<false> E{args.in[I_X], abuf, ssq1, 0.5f};
          pg8::gemm_phase<epi::EpiResid<false>, pg8::StaticOrder, true, true>(lds, g, S, E); }
        { pg8::Gemm g{memh, WMKV, 1024, 1024, 1024}; pg8::StaticOrder S; S.init(BATCH * MEMT, 512, G, bx);
          epi::EpiMemKV E{args.in[I_MKG], mk, mvT};
          pg8::gemm_phase<epi::EpiMemKV, pg8::StaticOrder, true, true>(lds, g, S, E); }
    }
    SEAM(2);
    if (IN(3)) {
        pg8::Gemm g{abuf, WIN, 1024, 1024, 1024}; pg8::StaticOrder S; S.init(MTOK, NWIN, G, bx);
        epi::EpiWin E{ssq1, args.in[I_AQG], args.in[I_AKG], args.in[I_MQG], qa, ka, va, qidx, kidx, acat, qm, gates, widx};
        pg8::gemm_phase<epi::EpiWin, pg8::StaticOrder, true, true>(lds, g, S, E);
    }
    SEAM(3);
    if (IN(4)) {
        const int variant = args.variant;
        if (!TV(8)) { pg8::Gemm g{acat, WST, 1024, 1280, 1024}; pg8::DiagOrder S; S.init(16, 4, 1, G, bx);
          epi::EpiS5State E{args.in[I_LOGDT], a64, acat};
          pg8::gemm_phase<epi::EpiS5State, pg8::DiagOrder, false, true>(lds, g, S, E); }
        __syncthreads();
        static_assert(WS_QIDX == WS_QA + 64 * MiB && WS_QM == WS_QA + 96 * MiB && WS_KA == WS_QA + 128 * MiB && WS_VAT == WS_QA + 136 * MiB && WS_KIDX == WS_QA + 144 * MiB && WS_WIDX == WS_QA + 152 * MiB && WS_MVT == WS_MK + 4 * MiB, "att::P offsets");
        att::P AP{ws + WS_QA, ws + WS_MK, args.in[I_RELB], variant ? mergedb : acatt};
        if (G == 256) {
            const int b = vcu >> 3, s = vcu & 7;
            for (int i = 0; i < 4; ++i) { const int c = i == 0 ? s : i == 1 ? 31 - s : i == 2 ? 8 + s : 23 - s; att::attn_unit(AP, b, c, lds, tid, variant); }
        } else {
            for (int u = vcu; u < BATCH * 32; u += G) att::attn_unit(AP, u >> 5, u & 31, lds, tid, variant);
        }
        __syncthreads();
    }
    SEAM(4);
    if (IN(5)) {
        pg8::Gemm g{acat, TCAT, 1280, 1280, 1280}; pg8::DiagOrder S; S.init(16, 4, 4, G, bx);
        epi::EpiS5Main E{args.in[I_LOGDT], ys};
        pg8::gemm_phase<epi::EpiS5Main, pg8::DiagOrder, true, true>(lds, g, S, E);
    }
    SEAM(5);
    if (IN(6)) {
        pg8::Gemm g{ys, WGLU, 256, 256, 256}; pg8::PairedOrder S; S.init(MTOK, DM, G, bx);
        epi::EpiGlu E{ob};
        pg8::gemm_phase<epi::EpiGlu, pg8::PairedOrder, GLU_ALIGN, true>(lds, g, S, E);
    }
    if (IN(7)) {
#ifdef STAGGER_US
        if (vcu & 1) { const unsigned long long t0 = __builtin_amdgcn_s_memrealtime(); while (__builtin_amdgcn_s_memrealtime() - t0 < (unsigned long long)(STAGGER_US * 100)) __builtin_amdgcn_s_sleep(16); }
#endif
        pg8::Gemm ga{acatt, WOA, 512, 768, 512}, gm{acatt + 512, WOM, 256, 768, 256}; pg8::StaticOrder S; S.init(MTOK, DM, G, bx);
        epi::EpiMerge2 E{gates, ob, mergedb};
        pg8::gemm_phase<epi::EpiMerge2, pg8::StaticOrder, true, true, true>(lds, ga, S, E, gm);
    }
    SEAM(7);
    if (IN(8)) {
        pg8::Gemm g{mergedb, WOUT, 1024, 1024, 1024}; pg8::StaticOrder S; S.init(MTOK, DM, G, bx);
        epi::EpiResid<true> E{abuf, x2h, ssq2, 1.0f};
        pg8::gemm_phase<epi::EpiResid<true>, pg8::StaticOrder, true, true>(lds, g, S, E);
    }
    SEAM(8);
#ifdef DBG_P1AGAIN
    if (IN(9)) {
        pg8::Gemm g{abuf, W1A, 1024, 1024, 1024}; pg8::StaticOrder S; S.init(MTOK, 2 * FFN, G, bx);
        epi::EpiSwiglu<0> E{hidden, rstd0};
        pg8::gemm_phase<epi::EpiSwiglu<0>, pg8::StaticOrder, true, true>(lds, g, S, E);
        if (hi - lo > 1) xcd_barrier(bar);
    }
#endif
    if (IN(9)) {
#if defined(DBG_CLOCK) && DBG_CLOCK >= 10
        if (bx == 0 && tid == 0) { ((unsigned long long*)(ctl + 9000))[0] = __builtin_amdgcn_s_memtime(); ((unsigned long long*)(ctl + 9000))[1] = __builtin_amdgcn_s_memrealtime(); }
#endif
        pg8::Gemm g{x2h, W2A, 1024, 1024, 1024}; pg8::StaticOrder S; S.init(MTOK, 2 * FFN, G, bx);
        epi::EpiSwiglu<1> E{hidden, ssq2};
        pg8::gemm_phase<epi::EpiSwiglu<1>, pg8::StaticOrder, true, true>(lds, g, S, E);
#if defined(DBG_CLOCK) && DBG_CLOCK >= 10
        if (bx == 0 && tid == 0) { ((unsigned long long*)(ctl + 9000))[2] = __builtin_amdgcn_s_memtime(); ((unsigned long long*)(ctl + 9000))[3] = __builtin_amdgcn_s_memrealtime(); }
#endif
    }
    SEAM(9);
    if (IN(10)) {
        pg8::Gemm g{hidden, W2B, FFN, FFN, FFN}; pg8::StaticOrder S; S.init(MTOK, DM, G, bx);
        epi::EpiFinal E{x2h, xres, ssq3, ctl + CW_FIN, args.in[I_FINAL_NORM], 0.5f};
        pg8::gemm_phase<epi::EpiFinal, pg8::StaticOrder, true, true>(lds, g, S, E);
    }
#ifdef DBG_SPIN
    if (bx == 0 && tid == 0) { const unsigned long long te = __builtin_amdgcn_s_memrealtime(); volatile unsigned long long* st = (volatile unsigned long long*)(ctl + 9100);
        const unsigned long long tb = DBG_SPIN == 11 ? te : st[DBG_SPIN + 1]; const unsigned long long d = tb - st[DBG_SPIN];
        while (__builtin_amdgcn_s_memrealtime() - te < 9ull * d) __builtin_amdgcn_s_sleep(32); }
#endif
#undef IN
#undef SEAM
#undef WSP
#undef W1A
#undef W1B
#undef WIN
#undef WMKV
#undef WGLU
#undef WOA
#undef WOM
#undef WOUT
#undef W2A
#undef W2B
#undef TCAT
#undef WST
#undef rstd0
#undef ssq1
#undef ssq2
#undef ssq3
#undef memh
#undef mk
#undef mvT
#undef a64
#undef abuf
#undef mergedb
#undef acatt
#undef ys
#undef x2h
#undef hidden
#undef qa
#undef qidx
#undef qm
#undef ob
#undef ka
#undef va
#undef kidx
#undef widx
#undef acat
#undef gates
}

#ifdef DBG_CLOCK
#ifndef DBG_Q
#define DBG_Q 3.0f
#endif
__global__ void clk_report(float* out, unsigned* ctl) {
    const unsigned long long* t = (const unsigned long long*)(ctl + 9000);
    const double cyc = (double)(t[2] - t[0]), wall = (double)(t[3] - t[1]) * 10.0;
#if DBG_CLOCK == 1
    const float code = (float)(cyc / 352.0 / 100.0);
#elif DBG_CLOCK == 2
    const float code = (float)(wall / 352.0 / 100.0);
#elif DBG_CLOCK == 3 || DBG_CLOCK == 13
    const float code = (float)(cyc / wall * 20.0);
#elif DBG_CLOCK == 4
    const float code = (float)((double)ctl[9016] * 10.0 / 352.0 / 25.0);
#else
    const float code = (float)((double)(~ctl[9018]) * 10.0 / 352.0 / 25.0);
#endif
    const float c = sqrtf(fmaxf(floorf(code / DBG_Q) * DBG_Q - 1.0f, 0.0f));
    for (size_t i = (size_t)blockIdx.x * blockDim.x + threadIdx.x; i < (size_t)MTOK * DM; i += (size_t)gridDim.x * blockDim.x) out[i] = c;
}
#endif
#ifndef DBG_TOL
#define DBG_TOL 0.03f
#endif
extern "C" void kernel_launch(void* const* d_in, const int* in_sizes, int n_in, void* d_out, int out_size, void* d_ws, size_t ws_size, hipStream_t stream) {
    static int grid = 0;
    if (grid == 0) {
        if (n_in != N_IN || in_sizes[0] != MTOK * DM || out_size != MTOK * DM || ws_size < WS_END) { fprintf(stderr, "kernel_launch: unexpected shapes (n_in %d, ws %zu)\n", n_in, ws_size); grid = -1; return; }
        int dev = 0, cus = 0, per_cu = 0;
        if (hipGetDevice(&dev) != hipSuccess || hipDeviceGetAttribute(&cus, hipDeviceAttributeMultiprocessorCount, dev) != hipSuccess) { grid = -1; return; }
        if (hipFuncSetAttribute((const void*)mega_fwd, hipFuncAttributeMaxDynamicSharedMemorySize, LDS_BYTES) != hipSuccess) { fprintf(stderr, "kernel_launch: hipFuncSetAttribute failed\n"); grid = -1; return; }
        if (hipOccupancyMaxActiveBlocksPerMultiprocessor(&per_cu, (const void*)mega_fwd, NWAVES * 64, LDS_BYTES) != hipSuccess || per_cu < 1) fprintf(stderr, "kernel_launch: occupancy query reports %d\n", per_cu);
        (void)hipGetLastError();
        grid = cus;
    }
    if (grid < 0) return;
    (void)hipMemsetAsync((char*)d_ws + WS_CTL, 0, CTL_ZERO_BYTES, stream);
    Args a{};
    for (int i = 0; i < N_IN; ++i) a.in[i] = (const float*)d_in[i];
    a.out = (float*)d_out; a.ws = (unsigned char*)d_ws;
#if MK_N_LAUNCHES == 1
    a.ph_lo = 0; a.ph_hi = N_PHASES;
    hipLaunchKernelGGL(mega_fwd, dim3(grid), dim3(NWAVES * 64), LDS_BYTES, stream, a);
#ifdef DBG_CLOCK
    hipLaunchKernelGGL(clk_report, dim3(1024), dim3(256), 0, stream, (float*)d_out, (unsigned*)d_ws);
#endif
#else
    for (int p = 0; p < N_PHASES; ++p) { a.ph_lo = p; a.ph_hi = p + 1; hipLaunchKernelGGL(mega_fwd, dim3(grid), dim3(NWAVES * 64), LDS_BYTES, stream, a);
#ifdef REP_PHASE
        if (p == REP_PHASE) for (int rep_ = 1; rep_ < REP_COUNT; ++rep_) { Args a2 = a;
#ifdef TIMING_VARIANT
            a2.variant = TIMING_VARIANT;
#endif
            hipLaunchKernelGGL(mega_fwd, dim3(grid), dim3(NWAVES * 64), LDS_BYTES, stream, a2); }
#endif
#ifdef DBG_CLOCK
        if (p == N_PHASES - 1) hipLaunchKernelGGL(clk_report, dim3(1024), dim3(256), 0, stream, (float*)d_out, (unsigned*)d_ws);
#endif
#ifdef DBG_CHECK
        unsigned char* ws = (unsigned char*)d_ws; unsigned* ctl = (unsigned*)ws; const float* const* in = a.in; float* out = (float*)d_out;
        dbg::ProjBufs PB{(h16*)(ws + WS_QA), (h16*)(ws + WS_KA), (h16*)(ws + WS_VAT), (h16*)(ws + WS_QIDX), (h16*)(ws + WS_KIDX), (h16*)(ws + WS_ACAT), (h16*)(ws + WS_QM), (h16*)(ws + WS_GATES), (float*)(ws + WS_WIDX)};
        if (p == 2) { hipLaunchKernelGGL(dbg::chk_ffn, dim3(8), dim3(256), 0, stream, in[I_X], in[I_FFN1_NORM], in[I_FFN1_WIN], in[I_FFN1_WOUT], (const float*)out, ctl, 1);
                      hipLaunchKernelGGL(dbg::chk_memkv, dim3(4), dim3(256), 0, stream, in[I_MEM], in[I_MEM_NORM], in[I_WMKV], in[I_MKG], (const h16*)(ws + WS_MK), (const h16*)(ws + WS_MVT), ctl); }
        if (p == 3) hipLaunchKernelGGL(dbg::chk_proj, dim3(4), dim3(256), 0, stream, (const float*)out, in[I_MIX_NORM], in[I_W_IN], in[I_AQG], in[I_AKG], in[I_MQG], PB, ctl);
        if (p == 4) { hipLaunchKernelGGL(dbg::chk_attn, dim3(8), dim3(256), 0, stream, PB, in[I_RELB], (const h16*)(ws + WS_CBUF), ctl);
                      hipLaunchKernelGGL(dbg::chk_mem, dim3(8), dim3(256), 0, stream, (const h16*)(ws + WS_QM), (const h16*)(ws + WS_MK), (const h16*)(ws + WS_MVT), (const h16*)(ws + WS_CBUF), ctl); }
        if (p == 5) hipLaunchKernelGGL(dbg::chk_s5, dim3(8), dim3(64), 0, stream, (const h16*)(ws + WS_ACAT), in[I_LRE], in[I_LIM], in[I_LOGDT], in[I_BRE], in[I_BIM], in[I_CRE], in[I_CIM], in[I_SSMD], (const h16*)(ws + WS_YS), ctl);
        if (p == 6) hipLaunchKernelGGL(dbg::chk_glu, dim3(4), dim3(256), 0, stream, (const h16*)(ws + WS_YS), in[I_WGLU], (const h16*)(ws + WS_OB), ctl);
        if (p == 7) hipLaunchKernelGGL(dbg::chk_merge, dim3(8), dim3(256), 0, stream, (const h16*)(ws + WS_CBUF), (const h16*)(ws + WS_OB), (const h16*)(ws + WS_GATES), in[I_WOA], in[I_WOM], (const h16*)(ws + WS_ABUF), (const float*)out, in[I_WOUT], ctl);
        if (p == 8) hipLaunchKernelGGL(dbg::chk_x2, dim3(8), dim3(256), 0, stream, (const float*)out, ctl);
        if (p == N_PHASES - 1) hipLaunchKernelGGL(dbg::chk_report, dim3(1024), dim3(256), 0, stream, out, ctl, DBG_TOL);
#endif
    }
#endif
}
```

```cpp
#define MK_N_LAUNCHES 1
#include <hip/hip_runtime.h>
#include <cstdio>
#include <cstdint>

#define GAS __attribute__((address_space(1)))
#define LAS __attribute__((address_space(3)))
typedef _Float16 h16;
typedef _Float16 h16x8 __attribute__((ext_vector_type(8)));
typedef _Float16 h16x4 __attribute__((ext_vector_type(4)));
typedef _Float16 h16x2 __attribute__((ext_vector_type(2)));
typedef float f32x2 __attribute__((ext_vector_type(2)));
typedef float f32x4 __attribute__((ext_vector_type(4)));
typedef float f32x16 __attribute__((ext_vector_type(16)));
typedef unsigned u32x4 __attribute__((ext_vector_type(4)));
typedef unsigned u32x2 __attribute__((ext_vector_type(2)));

constexpr int BATCH = 32, SEQ = 2048, DM = 1024, MTOK = BATCH * SEQ, FFN = 2816;
constexpr int NWIN = 4608;
constexpr int MEMT = 256;
constexpr float NORM_EPS = 1e-6f;
constexpr float LOG2E = 1.4426950408889634f;

__device__ __forceinline__ unsigned pk2h(float lo, float hi) { f32x2 v = {lo, hi}; h16x2 p = __builtin_convertvector(v, h16x2); return __builtin_bit_cast(unsigned, p); }
__device__ __forceinline__ u32x4 pk8h(f32x4 a, f32x4 b) { u32x4 w; w.x = pk2h(a[0], a[1]); w.y = pk2h(a[2], a[3]); w.z = pk2h(b[0], b[1]); w.w = pk2h(b[2], b[3]); return w; }
__device__ __forceinline__ void unpk8h(u32x4 w, f32x4& a, f32x4& b) {
    h16x8 h = __builtin_bit_cast(h16x8, w);
    a = (f32x4){(float)h[0], (float)h[1], (float)h[2], (float)h[3]}; b = (f32x4){(float)h[4], (float)h[5], (float)h[6], (float)h[7]};
}
__device__ __forceinline__ float fast_sigmoid(float x) { return __builtin_amdgcn_rcpf(1.0f + __builtin_amdgcn_exp2f(-x * LOG2E)); }

namespace pg8 {
constexpr int BM = 256, BK = 64, HALF = 128, HTB = HALF * BK * 2  , STAGE_BYTES = 8 * HTB, NXCD = 8, WGM = 8;

__host__ __device__ __forceinline__ int lds_byte(int r, int c) { const int st = (r >> 4) * 2 + (c >> 5), rr = r & 15, cc = c & 31, ob = rr * 64 + cc * 2; return st * 1024 + (ob ^ (((ob >> 9) & 1) << 5)); }
__host__ __device__ __forceinline__ void stage_rc(int b, int& R, int& C) { const int st = b / 1024, sb = b % 1024, swz = sb ^ (((sb >> 9) & 1) << 5); R = (st >> 1) * 16 + swz / 64; C = (st & 1) * 32 + (swz % 64) / 2; }

struct Unit { int pm, pn; };
struct Gemm { const h16* A; const h16* Bt; int K, lda, ldb; };

struct StaticOrder {
    int nM, nN, nwg, G, c;
    __host__ __device__ void init(int M, int N, int G_, int c_) { nM = M / BM; nN = N / BM; nwg = nM * nN; G = G_; c = c_; }
    __host__ __device__ bool next(int i, Unit& u) const {
        const long L = (long)i * G + c; if (L >= nwg) return false;
        int wgid = (int)L; { const int q = nwg / NXCD, r = nwg % NXCD, xcd = wgid % NXCD, off = wgid / NXCD; wgid = (xcd < r ? xcd * (q + 1) : r * (q + 1) + (xcd - r) * q) + off; }
        const int nig = WGM * nN, gid = wgid / nig, fm = gid * WGM, gsz = (nM - fm) < WGM ? (nM - fm) : WGM;
        u.pm = fm + ((wgid % nig) % gsz); u.pn = (wgid % nig) / gsz; return true;
    }
};
struct PairedOrder {
    StaticOrder base;
    __host__ __device__ void init(int M, int Ncons, int G_, int c_) { base.init(M, Ncons, G_, c_); }
    __host__ __device__ bool next(int i, Unit& u) const { Unit t; if (!base.next(i >> 1, t)) return false; u.pm = t.pm; u.pn = 2 * t.pn + (i & 1); return true; }
};
struct DiagOrder {
    int tm, tn, ng, G, c;
    __host__ __device__ void init(int ng_, int tm_, int tn_, int G_, int c_) { ng = ng_; tm = tm_; tn = tn_; G = G_; c = c_; }
    __host__ __device__ bool next(int i, Unit& u) const {
        const long L = (long)i * G + c; if (L >= (long)ng * tm * tn) return false;
        const int per = tm * tn, g = (int)L / per, r = (int)L % per;
        u.pm = g * tm + r / tn; u.pn = g * tn + r % tn; return true;
    }
};

template <class Epi, class Sched, bool ALIGN_EPI = false, bool SP2 = false, bool TWO = false>
__device__ __forceinline__ void gemm_phase(LAS unsigned char* lds, const Gemm g, const Sched& S, const Epi& E, const Gemm g2 = Gemm{nullptr, nullptr, 0, 0, 0}) {
    const int tid = threadIdx.x, wid = __builtin_amdgcn_readfirstlane(tid >> 6), lane = tid & 63, wr = wid >> 2, wc = wid & 3, fr = lane & 15, fq = lane >> 4;
    const int nt0 = g.K / BK, nt1 = TWO ? g2.K / BK : nt0;
    unsigned voffA[2], voffB0[2], voffB1[2];
#pragma unroll
    for (int i = 0; i < 2; ++i) { int R, C; stage_rc(tid * 16 + i * 8192, R, C);
        voffA[i] = (unsigned)(R * g.lda + C) * 2u; voffB0[i] = (unsigned)(R * g.ldb + C) * 2u; voffB1[i] = TWO ? (unsigned)(R * g2.ldb + C) * 2u : voffB0[i]; }
    const size_t kstep = (size_t)(BK * 2);
    const size_t hstepA = (size_t)HALF * g.lda * 2, hstepB0 = (size_t)HALF * g.ldb * 2, hstepB1 = TWO ? (size_t)HALF * g2.ldb * 2 : hstepB0;
    const size_t tstepA = 2 * hstepA;
#define PG8_NEXT(i, u, part) (TWO ? ((part) = (i) & 1, S.next((i) >> 1, (u))) : ((part) = 0, S.next((i), (u))))
#define PG8_ABASE(u, part) ((const char*)((TWO && (part)) ? g2.A : g.A) + (size_t)(u).pm * tstepA)
#define PG8_BBASE(u, part) ((TWO && (part)) ? (const char*)g2.Bt + (size_t)(u).pn * 2 * hstepB1 : (const char*)g.Bt + (size_t)(u).pn * 2 * hstepB0)
    const unsigned ldsw = (unsigned)wid * 1024u;
    const int aoff = lds_byte(wr * 64 + fr, fq * 8), boff = lds_byte(wc * 32 + fr, fq * 8);
#define PG8_SA(b, h) (((b) * 2 + (h)) * HTB)
#define PG8_SB(b, h) ((4 + (b) * 2 + (h)) * HTB)
#define PG8_STAGE(bufoff, gbase, voff) do { _Pragma("unroll") for (int _i = 0; _i < 2; ++_i) \
        __builtin_amdgcn_global_load_lds((const unsigned*)((const char*)(gbase) + (voff)[_i]), (LAS unsigned*)(lds + (bufoff) + ldsw + _i * 8192), 16, 0, 0); } while (0)
#define PG8_LDA(dst, b, h) do { _Pragma("unroll") for (int m = 0; m < 4; ++m) _Pragma("unroll") for (int k = 0; k < 2; ++k) dst[m][k] = *(const LAS h16x8*)(lds + PG8_SA(b, h) + aoff + m * 2048 + k * 1024); } while (0)
#define PG8_LDB(dst, b, h) do { _Pragma("unroll") for (int n = 0; n < 2; ++n) _Pragma("unroll") for (int k = 0; k < 2; ++k) dst[n][k] = *(const LAS h16x8*)(lds + PG8_SB(b, h) + boff + n * 2048 + k * 1024); } while (0)
#define PG8_MMA(ai, bj, At, Bt) do { __builtin_amdgcn_s_setprio(1); _Pragma("unroll") for (int m = 0; m < 4; ++m) _Pragma("unroll") for (int n = 0; n < 2; ++n) _Pragma("unroll") for (int k = 0; k < 2; ++k) \
        acc[ai][bj][m][n] = __builtin_amdgcn_mfma_f32_16x16x32_f16(Bt[n][k], At[m][k], acc[ai][bj][m][n], 0, 0, 0); __builtin_amdgcn_s_setprio(0); } while (0)
#define PG8_WAIT_V(n) asm volatile("s_waitcnt vmcnt(" #n ")" ::: "memory")
#define PG8_WAIT_L(n) asm volatile("s_waitcnt lgkmcnt(" #n ")" ::: "memory")
#define PG8_BAR __builtin_amdgcn_s_barrier()
#define PG8_SCHED __builtin_amdgcn_sched_barrier(0)
    Unit cur, nxt; int ui = 0, pcur = 0, pnxt = 0;
    if (!PG8_NEXT(0, cur, pcur)) return;
    f32x4 acc[2][2][4][2];
#pragma unroll
    for (int a = 0; a < 2; ++a)
#pragma unroll
        for (int b = 0; b < 2; ++b)
#pragma unroll
            for (int m = 0; m < 4; ++m)
#pragma unroll
                for (int n = 0; n < 2; ++n) acc[a][b][m][n] = (f32x4){0.f, 0.f, 0.f, 0.f};
    h16x8 At[4][2], B0[2][2], B1[2][2];
    const char* cA = PG8_ABASE(cur, pcur); const char* cB = PG8_BBASE(cur, pcur);
    unsigned voffB[2] = {voffB0[0], voffB0[1]}; size_t hstepB = hstepB0;
    if constexpr (SP2) {
        PG8_STAGE(PG8_SB(0, 0), cB, voffB); PG8_STAGE(PG8_SB(0, 1), cB + hstepB, voffB); PG8_STAGE(PG8_SA(0, 0), cA, voffA); PG8_STAGE(PG8_SA(0, 1), cA + hstepA, voffA);
        if (wr == 1) PG8_BAR;
        PG8_WAIT_V(2); PG8_BAR;
        PG8_STAGE(PG8_SB(1, 0), cB + kstep, voffB); PG8_STAGE(PG8_SA(1, 0), cA + kstep, voffA); PG8_STAGE(PG8_SB(1, 1), cB + hstepB + kstep, voffB);
        PG8_WAIT_V(6); PG8_BAR;
    } else {
        PG8_STAGE(PG8_SB(0, 0), cB, voffB); PG8_STAGE(PG8_SA(0, 0), cA, voffA); PG8_STAGE(PG8_SB(0, 1), cB + hstepB, voffB); PG8_STAGE(PG8_SA(0, 1), cA + hstepA, voffA);
        if (wr == 1) PG8_BAR;
        PG8_WAIT_V(4); PG8_BAR;
        PG8_STAGE(PG8_SB(1, 0), cB + kstep, voffB); PG8_STAGE(PG8_SA(1, 0), cA + kstep, voffA); PG8_STAGE(PG8_SB(1, 1), cB + hstepB + kstep, voffB);
        PG8_WAIT_V(6); PG8_BAR;
    }
    for (;;) {
        const bool has_next = PG8_NEXT(ui + 1, nxt, pnxt);
        const char* nA = has_next ? PG8_ABASE(nxt, pnxt) : cA; const char* nB = has_next ? PG8_BBASE(nxt, pnxt) : cB;
        const int nt = pcur ? nt1 : nt0;
        const unsigned vBc0 = voffB[0], vBc1 = voffB[1]; const size_t hBc = hstepB;
        const bool np1 = has_next ? (pnxt != 0) : (pcur != 0);
        const unsigned vBn0 = np1 ? voffB1[0] : voffB0[0], vBn1 = np1 ? voffB1[1] : voffB0[1]; const size_t hBn = np1 ? hstepB1 : hstepB0;
#pragma unroll 1
        for (int t = 0; t < nt; t += 2) {
            const bool last = (t == nt - 2);
            const char* a1 = cA + (size_t)(t + 1) * kstep;
            const char* a2 = last ? nA : cA + (size_t)(t + 2) * kstep; const char* b2 = last ? nB : cB + (size_t)(t + 2) * kstep;
            const char* a3 = a2 + kstep; const char* b3 = b2 + kstep;
            if constexpr (TWO) { voffB[0] = last ? vBn0 : vBc0; voffB[1] = last ? vBn1 : vBc1; hstepB = last ? hBn : hBc; }
            if constexpr (SP2) {
            PG8_LDB(B0, 0, 0); PG8_LDB(B1, 0, 1); PG8_SCHED; PG8_LDA(At, 0, 0); PG8_STAGE(PG8_SA(1, 1), a1 + hstepA, voffA);
            PG8_WAIT_V(8); PG8_WAIT_L(0); PG8_BAR; PG8_MMA(0, 0, At, B0); PG8_MMA(0, 1, At, B1); PG8_BAR; PG8_SCHED;
            PG8_LDA(At, 0, 1); PG8_STAGE(PG8_SB(0, 0), b2, voffB); PG8_STAGE(PG8_SB(0, 1), b2 + hstepB, voffB); PG8_STAGE(PG8_SA(0, 0), a2, voffA);
            PG8_WAIT_V(8); PG8_WAIT_L(0); PG8_BAR; PG8_MMA(1, 0, At, B0); PG8_MMA(1, 1, At, B1); PG8_BAR; PG8_SCHED;
            PG8_LDB(B0, 1, 0); PG8_LDB(B1, 1, 1); PG8_SCHED; PG8_LDA(At, 1, 0); PG8_STAGE(PG8_SA(0, 1), a2 + hstepA, voffA);
            PG8_WAIT_V(8); PG8_WAIT_L(0); PG8_BAR; PG8_MMA(0, 0, At, B0); PG8_MMA(0, 1, At, B1); PG8_BAR; PG8_SCHED;
            PG8_LDA(At, 1, 1); PG8_STAGE(PG8_SB(1, 0), b3, voffB); PG8_STAGE(PG8_SB(1, 1), b3 + hstepB, voffB); PG8_STAGE(PG8_SA(1, 0), a3, voffA);
            PG8_WAIT_V(8); PG8_WAIT_L(0); PG8_BAR; PG8_MMA(1, 0, At, B0); PG8_MMA(1, 1, At, B1); PG8_BAR; PG8_SCHED;
            } else {
            PG8_LDB(B0, 0, 0); PG8_SCHED; PG8_LDA(At, 0, 0); PG8_STAGE(PG8_SA(1, 1), a1 + hstepA, voffA);
            PG8_WAIT_L(8); PG8_BAR; PG8_WAIT_L(0); PG8_MMA(0, 0, At, B0); PG8_BAR; PG8_SCHED;
            PG8_LDB(B1, 0, 1); PG8_STAGE(PG8_SB(0, 0), b2, voffB);
            PG8_BAR; PG8_WAIT_L(0); PG8_MMA(0, 1, At, B1); PG8_BAR;
            PG8_LDA(At, 0, 1); PG8_STAGE(PG8_SA(0, 0), a2, voffA);
            PG8_BAR; PG8_WAIT_L(0); PG8_MMA(1, 0, At, B0); PG8_BAR; PG8_SCHED;
            PG8_STAGE(PG8_SB(0, 1), b2 + hstepB, voffB);
            PG8_WAIT_V(6); PG8_BAR; PG8_MMA(1, 1, At, B1); PG8_BAR;
            PG8_LDB(B0, 1, 0); PG8_SCHED; PG8_LDA(At, 1, 0); PG8_STAGE(PG8_SA(0, 1), a2 + hstepA, voffA);
            PG8_WAIT_L(8); PG8_BAR; PG8_WAIT_L(0); PG8_MMA(0, 0, At, B0); PG8_BAR; PG8_SCHED;
            PG8_LDB(B1, 1, 1); PG8_STAGE(PG8_SB(1, 0), b3, voffB);
            PG8_BAR; PG8_WAIT_L(0); PG8_MMA(0, 1, At, B1); PG8_BAR;
            PG8_LDA(At, 1, 1); PG8_STAGE(PG8_SA(1, 0), a3, voffA);
            PG8_BAR; PG8_WAIT_L(0); PG8_MMA(1, 0, At, B0); PG8_BAR; PG8_SCHED;
            PG8_STAGE(PG8_SB(1, 1), b3 + hstepB, voffB);
            PG8_WAIT_V(6); PG8_BAR; PG8_MMA(1, 1, At, B1); PG8_BAR;
            }
        }
        if constexpr (ALIGN_EPI) { if (wr == 0) PG8_BAR; }
        bool zero = true;
        if constexpr (TWO) { if (pcur == 0) { E.mid(acc, cur, wr, wc, fr, fq); zero = false; } else E(acc, cur, wr, wc, fr, fq); }
        else if constexpr (!Epi::AFTER_DRAIN) { E(acc, cur, wr, wc, fr, fq); }
        if (!has_next) break;
        if (zero) {
#pragma unroll
        for (int a = 0; a < 2; ++a)
#pragma unroll
            for (int b = 0; b < 2; ++b)
#pragma unroll
                for (int m = 0; m < 4; ++m)
#pragma unroll
                    for (int n = 0; n < 2; ++n) acc[a][b][m][n] = (f32x4){0.f, 0.f, 0.f, 0.f};
        }
        cur = nxt; pcur = pnxt; cA = nA; cB = nB; ++ui;
        if constexpr (TWO) { voffB[0] = vBn0; voffB[1] = vBn1; hstepB = hBn; }
        if constexpr (ALIGN_EPI) { if (wr == 1) PG8_BAR; }
    }
    PG8_WAIT_V(0);
    if constexpr (!ALIGN_EPI) { if (wr == 0) PG8_BAR; }
    PG8_BAR;
    if constexpr (Epi::AFTER_DRAIN) { E.fused(acc, cur, wr, wc, fr, fq, lds); }
#undef PG8_NEXT
#undef PG8_ABASE
#undef PG8_BBASE
#undef PG8_SA
#undef PG8_SB
#undef PG8_STAGE
#undef PG8_LDA
#undef PG8_LDB
#undef PG8_MMA
#undef PG8_WAIT_V
#undef PG8_WAIT_L
#undef PG8_BAR
#undef PG8_SCHED
}
}
namespace epi {
using pg8::Unit;
typedef f32x4 Acc[2][2][4][2];

__device__ __forceinline__ float quad16(float s) {
    auto a = __builtin_amdgcn_permlane16_swap(__float_as_uint(s), __float_as_uint(s), false, false); s = __uint_as_float(a[0]) + __uint_as_float(a[1]);
    auto b = __builtin_amdgcn_permlane32_swap(__float_as_uint(s), __float_as_uint(s), false, false); return __uint_as_float(b[0]) + __uint_as_float(b[1]);
}

__device__ __forceinline__ float rstd_from_ssq(const float* ssq, int r) {
    const f32x4* p = (const f32x4*)(ssq + (size_t)r * 16); const f32x4 a = p[0], b = p[1], c = p[2], d = p[3];
    const float s = ((a[0] + a[1]) + (a[2] + a[3])) + ((b[0] + b[1]) + (b[2] + b[3])) + ((c[0] + c[1]) + (c[2] + c[3])) + ((d[0] + d[1]) + (d[2] + d[3]));
    return __builtin_amdgcn_rsqf(s * (1.0f / DM) + NORM_EPS);
}
__device__ __forceinline__ float rstd_from_sum(const float* ssum, int r) { return __builtin_amdgcn_rsqf(ssum[r] * (1.0f / DM) + NORM_EPS); }
__device__ __forceinline__ float rstd_from_ssq_q(const float* ssq, int r, int fq) {
    const f32x4 a = ((const f32x4*)(ssq + (size_t)r * 16))[fq];
    const float s = quad16((a[0] + a[1]) + (a[2] + a[3]));
    return __builtin_amdgcn_rsqf(s * (1.0f / DM) + NORM_EPS);
}
template <int SRC  > struct EpiSwiglu {
    static constexpr bool AFTER_DRAIN = false;
    h16* H; const float* rsrc;
    __device__ __forceinline__ void operator()(const Acc& acc, const Unit& u, int wr, int wc, int fr, int fq) const {
        const int row0 = u.pm * 256 + wr * 64 + fr, col = u.pn * 128 + wc * 32 + fq * 8;
#pragma unroll
        for (int ai = 0; ai < 2; ++ai)
#pragma unroll
            for (int m = 0; m < 4; ++m) {
                const int r = row0 + ai * 128 + m * 16; const float rs = SRC == 0 ? rsrc[r] : rstd_from_sum(rsrc, r);
                f32x4 o[2];
#pragma unroll
                for (int n = 0; n < 2; ++n)
#pragma unroll
                    for (int j = 0; j < 4; ++j) { const float g = acc[ai][0][m][n][j] * rs, up = acc[ai][1][m][n][j] * rs; o[n][j] = g * fast_sigmoid(g) * up; }
                *(u32x4*)(H + (size_t)r * FFN + col) = pk8h(o[0], o[1]);
            }
    }
};

template <bool BASEH> struct EpiResid {
    static constexpr bool AFTER_DRAIN = false;
    const void* base; h16* outh; float* ssq; float alpha;
    __device__ __forceinline__ void operator()(const Acc& acc, const Unit& u, int wr, int wc, int fr, int fq) const {
        const int row0 = u.pm * 256 + wr * 64 + fr, col0 = u.pn * 256 + wc * 32 + fq * 8;
#pragma unroll
        for (int ai = 0; ai < 2; ++ai)
#pragma unroll
            for (int m = 0; m < 4; ++m) {
                const int r = row0 + ai * 128 + m * 16; float sq = 0.f;
#pragma unroll
                for (int bj = 0; bj < 2; ++bj) {
                    const size_t off = (size_t)r * DM + col0 + bj * 128;
                    f32x4 b0, b1;
                    if (BASEH) unpk8h(*(const u32x4*)((const h16*)base + off), b0, b1); else { b0 = *(const f32x4*)((const float*)base + off); b1 = *(const f32x4*)((const float*)base + off + 4); }
                    const f32x4 v0 = b0 + alpha * acc[ai][bj][m][0], v1 = b1 + alpha * acc[ai][bj][m][1];
                    *(u32x4*)(outh + off) = pk8h(v0, v1);
                    sq += (v0[0] * v0[0] + v0[1] * v0[1]) + (v0[2] * v0[2] + v0[3] * v0[3]) + (v1[0] * v1[0] + v1[1] * v1[1]) + (v1[2] * v1[2] + v1[3] * v1[3]);
                }
                sq = quad16(sq);
                if (fq == 0) __hip_atomic_fetch_add(ssq + r, sq, __ATOMIC_RELAXED, __HIP_MEMORY_SCOPE_AGENT);
            }
    }
};

struct EpiFinal {
    static constexpr bool AFTER_DRAIN = false;
    const h16* base; float* out; float* ssq; unsigned* cnt; const float* gain; float alpha;
    __device__ __forceinline__ void operator()(Acc& acc, const Unit& u, int wr, int wc, int fr, int fq) const {
        const int row0 = u.pm * 256 + wr * 64 + fr, col0 = u.pn * 256 + wc * 32 + fq * 8;
#pragma unroll
        for (int ai = 0; ai < 2; ++ai)
#pragma unroll
            for (int m = 0; m < 4; ++m) {
                const int r = row0 + ai * 128 + m * 16; float sq = 0.f;
#pragma unroll
                for (int bj = 0; bj < 2; ++bj) {
                    f32x4 b0, b1; unpk8h(*(const u32x4*)(base + (size_t)r * DM + col0 + bj * 128), b0, b1);
                    const f32x4 v0 = b0 + alpha * acc[ai][bj][m][0], v1 = b1 + alpha * acc[ai][bj][m][1];
                    acc[ai][bj][m][0] = v0; acc[ai][bj][m][1] = v1;
                    sq += (v0[0] * v0[0] + v0[1] * v0[1]) + (v0[2] * v0[2] + v0[3] * v0[3]) + (v1[0] * v1[0] + v1[1] * v1[1]) + (v1[2] * v1[2] + v1[3] * v1[3]);
                }
                sq = quad16(sq);
                if (fq == 0) __hip_atomic_fetch_add(ssq + r, sq, __ATOMIC_RELAXED, __HIP_MEMORY_SCOPE_AGENT);
            }
        asm volatile("s_waitcnt vmcnt(0)" ::: "memory");
        unsigned* c = cnt + 64 * u.pm;
        if ((threadIdx.x & 63) == 0) __hip_atomic_fetch_add(c, 1u, __ATOMIC_RELAXED, __HIP_MEMORY_SCOPE_AGENT);
        { unsigned spins = 0;
          while ((unsigned)__builtin_amdgcn_readfirstlane(__hip_atomic_load(c, __ATOMIC_RELAXED, __HIP_MEMORY_SCOPE_AGENT)) < 32u) { __builtin_amdgcn_s_sleep(2); if (++spins > (1u << 22)) break; } }
        f32x4 gv[2][2];
#pragma unroll
        for (int bj = 0; bj < 2; ++bj) { gv[bj][0] = *(const f32x4*)(gain + col0 + bj * 128); gv[bj][1] = *(const f32x4*)(gain + col0 + bj * 128 + 4); }
#pragma unroll
        for (int ai = 0; ai < 2; ++ai)
#pragma unroll
            for (int m = 0; m < 4; ++m) {
                const int r = row0 + ai * 128 + m * 16;
                const float rs = __builtin_amdgcn_rsqf(__hip_atomic_load(ssq + r, __ATOMIC_RELAXED, __HIP_MEMORY_SCOPE_AGENT) * (1.0f / DM) + NORM_EPS);
#pragma unroll
                for (int bj = 0; bj < 2; ++bj) { float* o = out + (size_t)r * DM + col0 + bj * 128;
                    *(f32x4*)o = acc[ai][bj][m][0] * rs * gv[bj][0]; *(f32x4*)(o + 4) = acc[ai][bj][m][1] * rs * gv[bj][1]; }
            }
    }
};

__device__ __forceinline__ void head_norm_store(const Acc& acc, int ai, int m, float rs, const float* gain, float oscale, h16* dst  , int fq) {
    float sq = 0.f;
#pragma unroll
    for (int bj = 0; bj < 2; ++bj)
#pragma unroll
        for (int n = 0; n < 2; ++n)
#pragma unroll
            for (int j = 0; j < 4; ++j) { const float v = acc[ai][bj][m][n][j] * rs; sq += v * v; }
    sq = quad16(sq);
    const float r = oscale * __builtin_amdgcn_rsqf(sq * (1.0f / 64.0f) + NORM_EPS);
#pragma unroll
    for (int bj = 0; bj < 2; ++bj) {
        const f32x4 g0 = *(const f32x4*)(gain + 32 * bj + 8 * fq), g1 = *(const f32x4*)(gain + 32 * bj + 8 * fq + 4);
        const f32x4 v0 = acc[ai][bj][m][0] * (rs * r) * g0, v1 = acc[ai][bj][m][1] * (rs * r) * g1;
        *(u32x4*)(dst + 32 * bj + 8 * fq) = pk8h(v0, v1);
    }
}

struct EpiWin {
    static constexpr bool AFTER_DRAIN = false; static constexpr float GMIN = 5.9604645e-8f;
    const float* ssq;
    const float *gq, *gk, *gmq;
    h16 *qa, *ka, *va, *qidx, *kidx, *acat, *qm, *gates; float* widx;
    __device__ __forceinline__ void operator()(const Acc& acc, const Unit& u, int wr, int wc, int fr, int fq) const {
        const int row0 = u.pm * 256 + wr * 64 + fr; const int pn = u.pn;
        float rs[2][4];
#pragma unroll
        for (int ai = 0; ai < 2; ++ai)
#pragma unroll
            for (int m = 0; m < 4; ++m) rs[ai][m] = rstd_from_sum(ssq, row0 + ai * 128 + m * 16);
        if (pn < 2) {
#pragma unroll
            for (int ai = 0; ai < 2; ++ai)
#pragma unroll
                for (int m = 0; m < 4; ++m) { const int r = row0 + ai * 128 + m * 16;
                    head_norm_store(acc, ai, m, rs[ai][m], gq, 0.125f * LOG2E, qa + (size_t)r * 512 + (4 * pn + wc) * 64, fq); }
        } else if (pn == 2) {
            if (wc == 0) {
#pragma unroll
                for (int ai = 0; ai < 2; ++ai)
#pragma unroll
                    for (int m = 0; m < 4; ++m) { const int r = row0 + ai * 128 + m * 16; head_norm_store(acc, ai, m, rs[ai][m], gk, 1.0f, ka + (size_t)r * 64, fq); }
            } else if (wc == 1) {
#pragma unroll
                for (int ai = 0; ai < 2; ++ai)
#pragma unroll
                    for (int m = 0; m < 4; ++m) { const int r = row0 + ai * 128 + m * 16;
#pragma unroll
                        for (int bj = 0; bj < 2; ++bj) *(u32x4*)(va + (size_t)r * 64 + 32 * bj + 8 * fq) = pk8h(acc[ai][bj][m][0] * rs[ai][m], acc[ai][bj][m][1] * rs[ai][m]); }
            } else if (wc == 2) {
#pragma unroll
                for (int ai = 0; ai < 2; ++ai)
#pragma unroll
                    for (int m = 0; m < 4; ++m) { const int r = row0 + ai * 128 + m * 16;
#pragma unroll
                        for (int bj = 0; bj < 2; ++bj) *(u32x4*)(kidx + (size_t)r * 64 + 32 * bj + 8 * fq) = pk8h(acc[ai][bj][m][0] * rs[ai][m], acc[ai][bj][m][1] * rs[ai][m]); }
            } else {
                if (fq == 0) {
#pragma unroll
                    for (int ai = 0; ai < 2; ++ai)
#pragma unroll
                        for (int m = 0; m < 4; ++m) { const int r = row0 + ai * 128 + m * 16; *(f32x4*)(widx + (size_t)r * 4) = acc[ai][0][m][0] * (rs[ai][m] * 0.0625f); }
                }
            }
        } else if (pn == 3) {
#pragma unroll
            for (int ai = 0; ai < 2; ++ai)
#pragma unroll
                for (int m = 0; m < 4; ++m) { const int r = row0 + ai * 128 + m * 16;
#pragma unroll
                    for (int bj = 0; bj < 2; ++bj) *(u32x4*)(qidx + (size_t)r * 256 + 128 * bj + 32 * wc + 8 * fq) = pk8h(acc[ai][bj][m][0] * rs[ai][m], acc[ai][bj][m][1] * rs[ai][m]); }
        } else if (pn == 4) {
#pragma unroll
            for (int ai = 0; ai < 2; ++ai)
#pragma unroll
                for (int m = 0; m < 4; ++m) { const int r = row0 + ai * 128 + m * 16; const int bc = r >> 6, s = r & 63;
#pragma unroll
                    for (int bj = 0; bj < 2; ++bj) { const int col = 128 * bj + 32 * wc + 8 * fq, g = col >> 4, c0 = col & 15;
                        *(u32x4*)(acat + ((size_t)g * 1024 + bc) * 1280 + 16 * s + c0) = pk8h(acc[ai][bj][m][0] * rs[ai][m], acc[ai][bj][m][1] * rs[ai][m]); } }
        } else if (pn == 5) {
#pragma unroll
            for (int ai = 0; ai < 2; ++ai)
#pragma unroll
                for (int m = 0; m < 4; ++m) { const int r = row0 + ai * 128 + m * 16;
                    head_norm_store(acc, ai, m, rs[ai][m], gmq, 0.125f * LOG2E, qm + (size_t)r * 256 + wc * 64, fq); }
        } else if (pn < 14) {
#pragma unroll
            for (int ai = 0; ai < 2; ++ai)
#pragma unroll
                for (int m = 0; m < 4; ++m) { const int r = row0 + ai * 128 + m * 16; f32x4 q0, q1, c0, c1;
#pragma unroll
                    for (int j = 0; j < 4; ++j) { const float a0 = fast_sigmoid(acc[ai][0][m][0][j] * rs[ai][m]), a1 = fast_sigmoid(acc[ai][0][m][1][j] * rs[ai][m]);
                        c0[j] = fmaxf(fast_sigmoid(acc[ai][1][m][0][j] * rs[ai][m]), GMIN); c1[j] = fmaxf(fast_sigmoid(acc[ai][1][m][1][j] * rs[ai][m]), GMIN);
                        q0[j] = fminf(a0 * __builtin_amdgcn_rcpf(c0[j]), 65504.f); q1[j] = fminf(a1 * __builtin_amdgcn_rcpf(c1[j]), 65504.f); }
                    h16* gp = gates + (size_t)r * 3072 + (pn - 6) * 128 + 32 * wc + 8 * fq;
                    *(u32x4*)gp = pk8h(q0, q1); *(u32x4*)(gp + 2048) = pk8h(c0, c1); }
        } else {
#pragma unroll
            for (int ai = 0; ai < 2; ++ai)
#pragma unroll
                for (int m = 0; m < 4; ++m) { const int r = row0 + ai * 128 + m * 16;
#pragma unroll
                    for (int bj = 0; bj < 2; ++bj) { f32x4 v0 = acc[ai][bj][m][0] * rs[ai][m], v1 = acc[ai][bj][m][1] * rs[ai][m];
#pragma unroll
                        for (int j = 0; j < 4; ++j) { v0[j] = fast_sigmoid(v0[j]); v1[j] = fast_sigmoid(v1[j]); }
                        *(u32x4*)(gates + (size_t)r * 3072 + 1024 + (pn - 14) * 256 + 128 * bj + 32 * wc + 8 * fq) = pk8h(v0, v1); } }
        }
    }
};

struct EpiMemKV {
    static constexpr bool AFTER_DRAIN = false;
    const float* gmk; h16* mk; h16* mvT;
    __device__ __forceinline__ void operator()(const Acc& acc, const Unit& u, int wr, int wc, int fr, int fq) const {
        const int row0 = u.pm * 256 + wr * 64 + fr;
        if (u.pn == 0) {
#pragma unroll
            for (int ai = 0; ai < 2; ++ai)
#pragma unroll
                for (int m = 0; m < 4; ++m) { const int r = row0 + ai * 128 + m * 16; head_norm_store(acc, ai, m, 1.0f, gmk, 1.0f, mk + (size_t)r * 256 + wc * 64, fq); }
        } else {
#pragma unroll
            for (int ai = 0; ai < 2; ++ai)
#pragma unroll
                for (int m = 0; m < 4; ++m) { const int r = row0 + ai * 128 + m * 16; const int b = r >> 8, kv = r & 255;
                    h16* dst = mvT + ((size_t)(b * 4 + wc) * 64) * MEMT + kv;
#pragma unroll
                    for (int bj = 0; bj < 2; ++bj)
#pragma unroll
                        for (int n = 0; n < 2; ++n)
#pragma unroll
                            for (int j = 0; j < 4; ++j) dst[(size_t)(32 * bj + 8 * fq + 4 * n + j) * MEMT] = (h16)acc[ai][bj][m][n][j]; }
        }
    }
};

struct EpiGlu {
    static constexpr bool AFTER_DRAIN = false;
    const h16* gates; h16* ob;
    __device__ __forceinline__ void operator()(const Acc& acc, const Unit& u, int wr, int wc, int fr, int fq) const {
        const int row0 = u.pm * 256 + wr * 64 + fr, col = u.pn * 128 + wc * 32 + fq * 8;
        u32x4 g1[2][4];
#pragma unroll
        for (int ai = 0; ai < 2; ++ai)
#pragma unroll
            for (int m = 0; m < 4; ++m) g1[ai][m] = *(const u32x4*)(gates + (size_t)(row0 + ai * 128 + m * 16) * 3072 + 1024 + col);
#pragma unroll
        for (int ai = 0; ai < 2; ++ai)
#pragma unroll
            for (int m = 0; m < 4; ++m) { const int r = row0 + ai * 128 + m * 16; f32x4 o[2], gg[2]; unpk8h(g1[ai][m], gg[0], gg[1]);
#pragma unroll
                for (int n = 0; n < 2; ++n)
#pragma unroll
                    for (int j = 0; j < 4; ++j) o[n][j] = gg[n][j] * acc[ai][0][m][n][j] * fast_sigmoid(acc[ai][1][m][n][j]);
                *(u32x4*)(ob + (size_t)r * DM + col) = pk8h(o[0], o[1]); }
    }
};

struct EpiMerge2 {
    static constexpr bool AFTER_DRAIN = false;
    const h16* gates; const h16* ob; h16* merged;
    __device__ __forceinline__ void mid(Acc& acc, const Unit& u, int wr, int wc, int fr, int fq) const {
        const int row0 = u.pm * 256 + wr * 64 + fr, col0 = u.pn * 256 + wc * 32 + fq * 8;
#pragma unroll
        for (int ai = 0; ai < 2; ++ai) {
            u32x4 ga[4][2];
#pragma unroll
            for (int m = 0; m < 4; ++m)
#pragma unroll
                for (int bj = 0; bj < 2; ++bj) ga[m][bj] = *(const u32x4*)(gates + (size_t)(row0 + ai * 128 + m * 16) * 3072 + col0 + bj * 128);
#pragma unroll
            for (int m = 0; m < 4; ++m)
#pragma unroll
                for (int bj = 0; bj < 2; ++bj) { f32x4 a0, a1; unpk8h(ga[m][bj], a0, a1); acc[ai][bj][m][0] *= a0; acc[ai][bj][m][1] *= a1; }
        }
    }
    __device__ __forceinline__ void operator()(const Acc& acc, const Unit& u, int wr, int wc, int fr, int fq) const {
        const int row0 = u.pm * 256 + wr * 64 + fr, col0 = u.pn * 256 + wc * 32 + fq * 8;
#pragma unroll
        for (int ai = 0; ai < 2; ++ai)
#pragma unroll
            for (int mh = 0; mh < 2; ++mh) {
                u32x4 gc[2][2], ov[2][2];
#pragma unroll
                for (int mm = 0; mm < 2; ++mm)
#pragma unroll
                    for (int bj = 0; bj < 2; ++bj) { const int r = row0 + ai * 128 + (2 * mh + mm) * 16, col = col0 + bj * 128;
                        gc[mm][bj] = *(const u32x4*)(gates + (size_t)r * 3072 + 2048 + col); ov[mm][bj] = *(const u32x4*)(ob + (size_t)r * DM + col); }
#pragma unroll
                for (int mm = 0; mm < 2; ++mm)
#pragma unroll
                    for (int bj = 0; bj < 2; ++bj) { const int m = 2 * mh + mm, r = row0 + ai * 128 + m * 16, col = col0 + bj * 128; f32x4 c0, c1, o0, o1;
                        unpk8h(gc[mm][bj], c0, c1); unpk8h(ov[mm][bj], o0, o1);
                        *(u32x4*)(merged + (size_t)r * DM + col) = pk8h(c0 * acc[ai][bj][m][0] + o0, c1 * acc[ai][bj][m][1] + o1); }
            }
    }
};

struct EpiS5Main {
    static constexpr bool AFTER_DRAIN = false;
    const float* logdt; h16* ys;
    __device__ __forceinline__ void operator()(const Acc& acc, const Unit& u, int wr, int wc, int fr, int fq) const {
        const int g = u.pm >> 2, pmm = u.pm & 3, pnn = u.pn & 3; const float dt = __expf(logdt[g]);
        const int row0 = pmm * 256 + wr * 64 + fr;
#pragma unroll
        for (int ai = 0; ai < 2; ++ai)
#pragma unroll
            for (int m = 0; m < 4; ++m) { const int bc = row0 + ai * 128 + m * 16;
#pragma unroll
                for (int bj = 0; bj < 2; ++bj) { const int tc = pnn * 256 + 128 * bj + 32 * wc + 8 * fq, t = tc >> 4, c0 = tc & 15;
                    f32x4 v[2];
#pragma unroll
                    for (int n = 0; n < 2; ++n)
#pragma unroll
                        for (int j = 0; j < 4; ++j) { const float y = acc[ai][bj][m][n][j] * dt; const float z = 1.5957691216f * (y + 0.044715f * y * y * y); v[n][j] = y * fast_sigmoid(z); }
                    *(u32x4*)(ys + ((size_t)bc * 64 + t) * 256 + 16 * g + c0) = pk8h(v[0], v[1]); } }
    }
};

struct EpiS5State {
    static constexpr bool AFTER_DRAIN = true;
    const float* logdt; const float* a64;
    h16* acat;
    __device__ __forceinline__ void fused(const Acc& acc, const Unit& u, int wr, int wc, int fr, int fq, LAS unsigned char* lds) const {
        const int g = u.pn, pmm = u.pm & 3; const float dt = __expf(logdt[g]);
        LAS float* sb = (LAS float*)lds;
#pragma unroll
        for (int ai = 0; ai < 2; ++ai)
#pragma unroll
            for (int m = 0; m < 4; ++m) { const int r = ai * 128 + wr * 64 + m * 16 + fr;
                *(LAS f32x4*)(sb + r * 132 + 32 * wc + 8 * fq) = acc[ai][0][m][0] * dt; *(LAS f32x4*)(sb + r * 132 + 32 * wc + 8 * fq + 4) = acc[ai][0][m][1] * dt; }
        __syncthreads();
        const int tid = threadIdx.x, bl = tid >> 6, p = tid & 63;
        const float ar = a64[(g * 64 + p) * 2], ai_ = a64[(g * 64 + p) * 2 + 1];
        float xr = 0.f, xi = 0.f;
        h16* dst = acat + ((size_t)g * 1024 + (size_t)(pmm * 8 + bl) * 32) * 1280;
        for (int ch = 0; ch < 32; ++ch) {
            dst[(size_t)ch * 1280 + 1024 + p] = (h16)xr; dst[(size_t)ch * 1280 + 1088 + p] = (h16)xi;
            dst[(size_t)ch * 1280 + 1152 + p] = (h16)0.f; dst[(size_t)ch * 1280 + 1216 + p] = (h16)0.f;
            const float sr = sb[(bl * 32 + ch) * 132 + p], si = sb[(bl * 32 + ch) * 132 + 64 + p];
            const float nr = ar * xr - ai_ * xi + sr, ni = ar * xi + ai_ * xr + si; xr = nr; xi = ni;
        }
        __syncthreads();
    }
};
}
namespace pro {
#define LDS_WAIT() asm volatile("s_waitcnt lgkmcnt(0)" ::: "memory")

__device__ __forceinline__ float wave_sum(float v) {
#pragma unroll
    for (int o = 1; o < 64; o <<= 1) v += __shfl_xor(v, o);
    return v;
}

__device__ __forceinline__ void tr_item(const float* W, int ldw, int src0, int nvalid, const float* gain, h16* Bt, int K, int row0, int k0, LAS float* scr, int lane) {
    { const int c = lane & 31, kh = lane >> 5; const bool ok = c < nvalid;
      const float* wp = W + (size_t)(k0 + kh) * ldw + src0 + c; const size_t st2 = (size_t)2 * ldw;
#pragma unroll
      for (int hb = 0; hb < 2; ++hb) { float v[16];
#pragma unroll
          for (int i = 0; i < 16; ++i) { v[i] = ok ? *wp : 0.f; wp += st2; }
#pragma unroll
          for (int i = 0; i < 16; ++i) { const int kk = 2 * (16 * hb + i) + kh; scr[kk * 33 + c] = gain ? v[i] * gain[k0 + kk] : v[i]; } } }
    LDS_WAIT(); asm volatile("" ::: "memory");
    const int c8 = lane & 7;
#pragma unroll
    for (int jj = 0; jj < 4; ++jj) { const int q = (lane >> 3) + 8 * jj; const int o = 8 * ((q >> 2) & 3) + 4 * (q >> 4) + (q & 3);
        const LAS float* s = scr + (8 * c8) * 33 + o;
        u32x4 w; w.x = pk2h(s[0 * 33], s[1 * 33]); w.y = pk2h(s[2 * 33], s[3 * 33]); w.z = pk2h(s[4 * 33], s[5 * 33]); w.w = pk2h(s[6 * 33], s[7 * 33]);
        *(u32x4*)(Bt + (size_t)(row0 + q) * K + k0 + 8 * c8) = w; }
    LDS_WAIT(); asm volatile("" ::: "memory");
}

__device__ __forceinline__ int win_src0(int gi, int& nv) {
    const int pn = gi >> 3, bj = (gi >> 2) & 1, wc = gi & 3; nv = 32;
    if (pn < 2) return 64 * (4 * pn + wc) + 32 * bj;
    if (pn == 2) { if (wc == 0) return 512 + 32 * bj; if (wc == 1) return 576 + 32 * bj; if (wc == 2) return 896 + 32 * bj; nv = bj ? 0 : 4; return 960; }
    if (pn == 3) return 640 + 128 * bj + 32 * wc;
    if (pn == 4) return 964 + 128 * bj + 32 * wc;
    if (pn == 5) return 1220 + 64 * wc + 32 * bj;
    if (pn < 14) return 1476 + (bj ? 2048 : 0) + 128 * (pn - 6) + 32 * wc;
    return 1476 + 1024 + 256 * (pn - 14) + 128 * bj + 32 * wc;
}

struct WPtrs { const float *w1a, *w1b, *win, *wmkv, *wglu, *woa, *wom, *wout, *w2a, *w2b, *g1, *gmix, *g2;
               h16 *W1A, *W1B, *WIN, *WMKV, *WGLU, *WOA, *WOM, *WOUT, *W2A, *W2B; };

constexpr int IT_1A = 176 * 16, IT_1B = 32 * 44, IT_IN = 144 * 16, IT_MKV = 16 * 16, IT_GLU = 64 * 4, IT_OA = 32 * 8, IT_OM = 32 * 4, IT_OUT = 32 * 16;
constexpr int IT_TOTAL = 2 * IT_1A + 2 * IT_1B + IT_IN + IT_MKV + IT_GLU + IT_OA + IT_OM + IT_OUT;

__device__ __forceinline__ void weight_item(const WPtrs& P, int it, LAS float* scr, int lane) {
    int r = it;
    if (r < 2 * IT_1A) { const bool second = r >= IT_1A; if (second) r -= IT_1A; const int gi = r >> 4, kb = r & 15; const int pn = gi >> 3, bj = (gi >> 2) & 1, wc = gi & 3;
        tr_item(second ? P.w2a : P.w1a, 2 * FFN, (bj ? FFN : 0) + 128 * pn + 32 * wc, 32, second ? P.g2 : P.g1, second ? P.W2A : P.W1A, 1024, 32 * gi, 64 * kb, scr, lane); return; }
    r -= 2 * IT_1A;
    if (r < 2 * IT_1B) { const bool second = r >= IT_1B; if (second) r -= IT_1B; const int gi = r / 44, kb = r % 44;
        tr_item(second ? P.w2b : P.w1b, DM, 32 * gi, 32, nullptr, second ? P.W2B : P.W1B, FFN, 32 * gi, 64 * kb, scr, lane); return; }
    r -= 2 * IT_1B;
    if (r < IT_IN) { const int gi = r >> 4, kb = r & 15; int nv; const int s0 = win_src0(gi, nv);
        tr_item(P.win, 4548, s0, nv, P.gmix, P.WIN, 1024, 32 * gi, 64 * kb, scr, lane); return; }
    r -= IT_IN;
    if (r < IT_MKV) { const int gi = r >> 4, kb = r & 15; const int pn = gi >> 3, bj = (gi >> 2) & 1, wc = gi & 3;
        tr_item(P.wmkv, 512, 256 * pn + 64 * wc + 32 * bj, 32, nullptr, P.WMKV, 1024, 32 * gi, 64 * kb, scr, lane); return; }
    r -= IT_MKV;
    if (r < IT_GLU) { const int gi = r >> 2, kb = r & 3; const int pn = gi >> 3, bj = (gi >> 2) & 1, wc = gi & 3;
        tr_item(P.wglu, 2048, (bj ? 1024 : 0) + 128 * pn + 32 * wc, 32, nullptr, P.WGLU, 256, 32 * gi, 64 * kb, scr, lane); return; }
    r -= IT_GLU;
    if (r < IT_OA) { const int gi = r >> 3, kb = r & 7; tr_item(P.woa, DM, 32 * gi, 32, nullptr, P.WOA, 512, 32 * gi, 64 * kb, scr, lane); return; }
    r -= IT_OA;
    if (r < IT_OM) { const int gi = r >> 2, kb = r & 3; tr_item(P.wom, DM, 32 * gi, 32, nullptr, P.WOM, 256, 32 * gi, 64 * kb, scr, lane); return; }
    r -= IT_OM;
    { const int gi = r >> 4, kb = r & 15; tr_item(P.wout, DM, 32 * gi, 32, nullptr, P.WOUT, 1024, 32 * gi, 64 * kb, scr, lane); }
}

template <int NR> __device__ __forceinline__ void rows_to_h16(const float* x, h16* o, int m0, int mstep, int mend, const float* gain, float* rstd_out, int lane) {
    f32x4 v[NR][4];
#pragma unroll
    for (int r = 0; r < NR; ++r) { const int m = m0 + r * mstep; if (m < mend) {
#pragma unroll
        for (int j = 0; j < 4; ++j) v[r][j] = ((const f32x4*)(x + (size_t)m * DM))[lane + 64 * j]; } }
#pragma unroll
    for (int r = 0; r < NR; ++r) { const int m = m0 + r * mstep; if (m < mend) {
        float s = 0.f;
#pragma unroll
        for (int j = 0; j < 4; ++j) s += (v[r][j][0] * v[r][j][0] + v[r][j][1] * v[r][j][1]) + (v[r][j][2] * v[r][j][2] + v[r][j][3] * v[r][j][3]);
        const float rstd = 1.0f / sqrtf(wave_sum(s) * (1.0f / DM) + NORM_EPS);
        if (rstd_out && lane == 0) rstd_out[m] = rstd;
        u32x2* o8 = (u32x2*)(o + (size_t)m * DM) + lane;
#pragma unroll
        for (int j = 0; j < 4; ++j) { f32x4 w = v[r][j];
            if (gain) { const f32x4 gv = ((const f32x4*)gain)[lane + 64 * j]; w = w * rstd * gv; }
            u32x2 p; p.x = pk2h(w[0], w[1]); p.y = pk2h(w[2], w[3]); o8[64 * j] = p; } } }
}

struct S5In { const float *lre, *lim, *logdt, *bre, *bim, *cre, *cim, *dd; };
__device__ __forceinline__ int slot_row(int c) { const int o = c & 31; return (c & ~31) + 16 * ((o >> 2) & 1) + 4 * (o >> 3) + (o & 3); }
__device__ __forceinline__ void cpow(float ar, float ai, int n, float& pr, float& pi) {
    pr = 1.f; pi = 0.f;
    for (int i = 0; i < n; ++i) { const float t = pr * ar - pi * ai; pi = pr * ai + pi * ar; pr = t; }
}
__device__ __forceinline__ void s5_item(const S5In& I, int g, int j, h16* tcat, h16* wst, float* a64, LAS float* L, int tid) {
    LAS float* Pj = L;
    LAS float* Pj1 = L + 128;
    LAS float* P63 = L + 256;
    LAS float* Bb = L + 384;
    LAS float* CP = L + 384 + 2048;
    LAS float* Kb = L + 384 + 4096;
    const float dt = __expf(I.logdt[g]); const float sig = 1.0f / dt;
    __syncthreads();
    if (tid < 64) { const int p = tid; const float lr = I.lre[g * 64 + p], li = I.lim[g * 64 + p];
        const float mag = __expf(lr * dt); const float ar = mag * cosf(li * dt), ai = mag * sinf(li * dt);
        const float den = lr * lr + li * li; const float fr = ((ar - 1.0f) * lr + ai * li) / den, fi = (ai * lr - (ar - 1.0f) * li) / den;
        float pr, pi; cpow(ar, ai, j, pr, pi); Pj[2 * p] = pr; Pj[2 * p + 1] = pi;
        { const float t = pr * ar - pi * ai; const float u = pr * ai + pi * ar; Pj1[2 * p] = t; Pj1[2 * p + 1] = u; }
        cpow(ar, ai, 63 - j, pr, pi); P63[2 * p] = pr; P63[2 * p + 1] = pi;
        if (j == 0) { cpow(ar, ai, 64, pr, pi); a64[(g * 64 + p) * 2] = pr; a64[(g * 64 + p) * 2 + 1] = pi; }
#pragma unroll 4
        for (int c = 0; c < 16; ++c) { const float br = I.bre[(g * 64 + p) * 16 + c], bi = I.bim[(g * 64 + p) * 16 + c];
            Bb[(p * 16 + c) * 2] = fr * br - fi * bi; Bb[(p * 16 + c) * 2 + 1] = fr * bi + fi * br; }
    }
    __syncthreads();
    for (int e = tid; e < 1024; e += 512) { const int cp = e >> 6, p = e & 63;
        const float cr = I.cre[(g * 16 + cp) * 64 + p], ci = I.cim[(g * 16 + cp) * 64 + p], pr = Pj[2 * p], pi = Pj[2 * p + 1];
        CP[e * 2] = cr * pr - ci * pi; CP[e * 2 + 1] = cr * pi + ci * pr; }
    __syncthreads();
    if (tid < 256) { const int cp = tid >> 4, c = tid & 15; float s = 0.f;
        for (int p = 0; p < 64; ++p) s += CP[(cp * 64 + p) * 2] * Bb[(p * 16 + c) * 2] - CP[(cp * 64 + p) * 2 + 1] * Bb[(p * 16 + c) * 2 + 1];
        if (j == 0 && cp == c) s += I.dd[g * 16 + c];
        Kb[tid] = s * sig; }
    __syncthreads();
    h16* T = tcat + (size_t)g * 1024 * 1280;
    for (int e = tid; e < (64 - j) * 32; e += 512) { const int d = e >> 5, cp = (e >> 1) & 15, h = e & 1;
        const LAS float* k = Kb + cp * 16 + 8 * h;
        u32x4 w; w.x = pk2h(k[0], k[1]); w.y = pk2h(k[2], k[3]); w.z = pk2h(k[4], k[5]); w.w = pk2h(k[6], k[7]);
        *(u32x4*)(T + (size_t)slot_row((j + d) * 16 + cp) * 1280 + 16 * d + 8 * h) = w;
        if (j > 0) *(u32x4*)(T + (size_t)slot_row(d * 16 + cp) * 1280 + 16 * (j + d) + 8 * h) = (u32x4){0u, 0u, 0u, 0u}; }
    for (int e = tid; e < 1024; e += 512) { const int cp = e >> 6, p = e & 63;
        const float cr = I.cre[(g * 16 + cp) * 64 + p], ci = I.cim[(g * 16 + cp) * 64 + p], pr = Pj1[2 * p], pi = Pj1[2 * p + 1];
        h16* row = T + (size_t)slot_row(j * 16 + cp) * 1280;
        row[1024 + p] = (h16)((cr * pr - ci * pi) * sig); row[1088 + p] = (h16)(-(cr * pi + ci * pr) * sig); row[1152 + p] = (h16)0.f; row[1216 + p] = (h16)0.f; }
    h16* Wg = wst + (size_t)g * 256 * 1024;
    for (int e = tid; e < 1024; e += 512) { const int p = e >> 4, c = e & 15;
        const float pr = P63[2 * p], pi = P63[2 * p + 1], br = Bb[(p * 16 + c) * 2], bi = Bb[(p * 16 + c) * 2 + 1];
        Wg[(size_t)slot_row(p) * 1024 + 16 * j + c] = (h16)((pr * br - pi * bi) * sig); Wg[(size_t)slot_row(64 + p) * 1024 + 16 * j + c] = (h16)((pr * bi + pi * br) * sig); }
    for (int e = tid; e < 128 * 16; e += 512) { const int rr = 128 + (e >> 4), c = e & 15; Wg[(size_t)rr * 1024 + 16 * j + c] = (h16)0.f; }
}
}
namespace att {
constexpr int SC_STRIDE = 2080;
constexpr int L_KS = 0, L_VS = 18432, L_RELB = 36864, L_FBUF = 44032, L_MASK = 133120, L_HIST = 149760, L_QMM = 157952, L_TROW = 158080, L_END = 162176;
constexpr float NEG_INF = -__builtin_inff();
constexpr float THR = 6.0f;

struct P {
    const unsigned char* big; const unsigned char* small; const float* relb;
    h16* out;
    static constexpr size_t MB = 1u << 20;
    __device__ __forceinline__ const h16* qa() const { return (const h16*)big; }
    __device__ __forceinline__ const h16* qidx() const { return (const h16*)(big + 64 * MB); }
    __device__ __forceinline__ const h16* qm() const { return (const h16*)(big + 96 * MB); }
    __device__ __forceinline__ const h16* ka() const { return (const h16*)(big + 128 * MB); }
    __device__ __forceinline__ const h16* va() const { return (const h16*)(big + 136 * MB); }
    __device__ __forceinline__ const h16* kidx() const { return (const h16*)(big + 144 * MB); }
    __device__ __forceinline__ const float* widx() const { return (const float*)(big + 152 * MB); }
    __device__ __forceinline__ const h16* mk() const { return (const h16*)small; }
    __device__ __forceinline__ const h16* mvT() const { return (const h16*)(small + 4 * MB); }
};

__device__ __forceinline__ int crow(int r, int hi) { return (r & 3) + 8 * (r >> 2) + 4 * hi; }
__device__ __forceinline__ unsigned fkey(float f) { const unsigned u = __float_as_uint(f); return u ^ ((unsigned)((int)u >> 31) | 0x80000000u); }
__device__ __forceinline__ float swapmax(float m) { auto rr = __builtin_amdgcn_permlane32_swap(__float_as_uint(m), __float_as_uint(m), false, false); return fmaxf(__uint_as_float(rr[0]), __uint_as_float(rr[1])); }
__device__ __forceinline__ float swapsum(float m) { auto rr = __builtin_amdgcn_permlane32_swap(__float_as_uint(m), __float_as_uint(m), false, false); return __uint_as_float(rr[0]) + __uint_as_float(rr[1]); }
__device__ __forceinline__ float qperm_b1(float v) { return __int_as_float(__builtin_amdgcn_mov_dpp(__float_as_int(v), 0xB1, 0xF, 0xF, true)); }
__device__ __forceinline__ float qperm_4e(float v) { return __int_as_float(__builtin_amdgcn_mov_dpp(__float_as_int(v), 0x4E, 0xF, 0xF, true)); }

__device__ __forceinline__ int t5_bucket(int rel) {
    const int n = rel < 0 ? -rel : rel; int v;
    if (n < 8) v = n; else if (n < 12) v = 8; else if (n < 16) v = 9; else if (n < 23) v = 10; else if (n < 32) v = 11; else if (n < 46) v = 12; else if (n < 64) v = 13; else if (n < 91) v = 14; else v = 15;
    return (rel > 0 ? 16 : 0) + v;
}

typedef short v4i16_t __attribute__((ext_vector_type(4)));
__device__ __forceinline__ h16x4 vtr(const LAS h16* p) { return __builtin_bit_cast(h16x4, __builtin_amdgcn_ds_read_tr16_b64_v4i16((LAS v4i16_t*)p)); }
__device__ __forceinline__ float max3f(float a, float b, float c) { float r; asm("v_max3_f32 %0, %1, %2, %3" : "=v"(r) : "v"(a), "v"(b), "v"(c)); return r; }
__device__ __forceinline__ void softmax_tile(f32x16& s, float& cref, h16x8& qx, bool& started, float& lsum, f32x16& O0, f32x16& O1, LAS float* fb  , int lane, int hi, h16x8& p0, h16x8& p1) {
    float tm = max3f(s[0], s[1], s[2]); tm = max3f(tm, s[3], s[4]); tm = max3f(tm, s[5], s[6]); tm = max3f(tm, s[7], s[8]); tm = max3f(tm, s[9], s[10]); tm = max3f(tm, s[11], s[12]);
    tm = max3f(tm, s[13], s[14]); tm = max3f(tm, s[15], s[15]);
    tm = swapmax(tm);
    const bool live = tm > -__builtin_inff();
    const bool need = tm > THR || (!started && live && tm < -THR);
    if (__any(need)) {
        const float newc = need ? (float)(h16)(cref - tm) : cref; const float d = cref - newc;
        const float f = (need && started) ? __builtin_amdgcn_exp2f(-d) : 1.0f;
        cref = newc; if (hi == 0) qx[0] = (h16)newc;
        lsum *= f;
        if (hi == 0) fb[lane] = f;
        asm volatile("s_waitcnt lgkmcnt(0)" ::: "memory");
#pragma unroll
        for (int g = 0; g < 4; ++g) { const f32x4 fv = *(const LAS f32x4*)(fb + 8 * g + 4 * hi);
#pragma unroll
            for (int i = 0; i < 4; ++i) { O0[4 * g + i] *= fv[i]; O1[4 * g + i] *= fv[i]; } }
        asm volatile("s_waitcnt lgkmcnt(0)" ::: "memory");
#pragma unroll
        for (int r = 0; r < 16; ++r) s[r] -= d;
    }
    started = started || live;
    float ps = 0.f;
#pragma unroll
    for (int r = 0; r < 16; ++r) { s[r] = __builtin_amdgcn_exp2f(s[r]); ps += s[r]; }
    lsum += ps;
    p0 = (h16x8){(h16)s[0], (h16)s[1], (h16)s[2], (h16)s[3], (h16)s[4], (h16)s[5], (h16)s[6], (h16)s[7]};
    p1 = (h16x8){(h16)s[8], (h16)s[9], (h16)s[10], (h16)s[11], (h16)s[12], (h16)s[13], (h16)s[14], (h16)s[15]};
}
__device__ __forceinline__ void softmax_tile2(f32x16 (&s)[2], float (&cref)[2], bool (&started)[2], float (&lsum)[2], f32x16 (&O)[2][2], LAS float* fb  , int lane, int hi, h16x8 (&p0)[2], h16x8 (&p1)[2]) {
    float tm[2];
#pragma unroll
    for (int ct = 0; ct < 2; ++ct) { float t = max3f(s[ct][0], s[ct][1], s[ct][2]); t = max3f(t, s[ct][3], s[ct][4]); t = max3f(t, s[ct][5], s[ct][6]); t = max3f(t, s[ct][7], s[ct][8]);
        t = max3f(t, s[ct][9], s[ct][10]); t = max3f(t, s[ct][11], s[ct][12]); t = max3f(t, s[ct][13], s[ct][14]); tm[ct] = max3f(t, s[ct][15], s[ct][15]); }
    tm[0] = swapmax(tm[0]); tm[1] = swapmax(tm[1]);
    bool live[2], need[2];
#pragma unroll
    for (int ct = 0; ct < 2; ++ct) { live[ct] = tm[ct] > -__builtin_inff(); need[ct] = tm[ct] > THR || (!started[ct] && live[ct] && tm[ct] < -THR); }
    if (__any(need[0] || need[1])) {
        float d[2];
#pragma unroll
        for (int ct = 0; ct < 2; ++ct) { const float newc = need[ct] ? (float)(h16)(cref[ct] - tm[ct]) : cref[ct]; d[ct] = cref[ct] - newc;
            const float f = (need[ct] && started[ct]) ? __builtin_amdgcn_exp2f(-d[ct]) : 1.0f;
            cref[ct] = newc; if (hi == 0) fb[32 * ct + lane] = f;
            lsum[ct] *= f; }
        asm volatile("s_waitcnt lgkmcnt(0)" ::: "memory");
#pragma unroll
        for (int ct = 0; ct < 2; ++ct)
#pragma unroll
            for (int g = 0; g < 4; ++g) { const f32x4 fv = *(const LAS f32x4*)(fb + 32 * ct + 8 * g + 4 * hi);
#pragma unroll
                for (int i = 0; i < 4; ++i) { O[ct][0][4 * g + i] *= fv[i]; O[ct][1][4 * g + i] *= fv[i]; } }
        asm volatile("s_waitcnt lgkmcnt(0)" ::: "memory");
#pragma unroll
        for (int ct = 0; ct < 2; ++ct)
#pragma unroll
            for (int r = 0; r < 16; ++r) s[ct][r] -= d[ct];
    }
#pragma unroll
    for (int ct = 0; ct < 2; ++ct) { started[ct] = started[ct] || live[ct];
        float ps = 0.f;
#pragma unroll
        for (int r = 0; r < 16; ++r) { s[ct][r] = __builtin_amdgcn_exp2f(s[ct][r]); ps += s[ct][r]; }
        lsum[ct] += ps;
        p0[ct] = (h16x8){(h16)s[ct][0], (h16)s[ct][1], (h16)s[ct][2], (h16)s[ct][3], (h16)s[ct][4], (h16)s[ct][5], (h16)s[ct][6], (h16)s[ct][7]};
        p1[ct] = (h16x8){(h16)s[ct][8], (h16)s[ct][9], (h16)s[ct][10], (h16)s[ct][11], (h16)s[ct][12], (h16)s[ct][13], (h16)s[ct][14], (h16)s[ct][15]}; }
}
__device__ __forceinline__ void store_o(const f32x16& O0, const f32x16& O1, float lsum, LAS float* fb, int lane, int hi, h16* out, size_t tok0, int col0) {
    const float lt = swapsum(lsum);
    if (hi == 0) fb[lane] = 1.0f / lt;
    asm volatile("s_waitcnt lgkmcnt(0)" ::: "memory");
#pragma unroll
    for (int g = 0; g < 4; ++g) { const f32x4 fv = *(const LAS f32x4*)(fb + 8 * g + 4 * hi);
#pragma unroll
        for (int i = 0; i < 4; ++i) { const int q = 8 * g + 4 * hi + i; h16* o = out + (tok0 + q) * 768 + col0 + (lane & 31);
            o[0] = (h16)(O0[4 * g + i] * fv[i]); o[32] = (h16)(O1[4 * g + i] * fv[i]); } }
    asm volatile("s_waitcnt lgkmcnt(0)" ::: "memory");
}

#define SEL_LOAD4(dst, rowp, i0) float dst[4]; _Pragma("unroll") for (int k_ = 0; k_ < 4; ++k_) dst[k_] = ((i0) + k_ < nreg) ? (rowp)[64 * ((i0) + k_) + lane] : __builtin_nanf("");
__device__ __forceinline__ float ikey(unsigned k) { return __uint_as_float((k & 0x80000000u) ? (k ^ 0x80000000u) : ~k); }
__device__ __forceinline__ int rank64(unsigned mh, unsigned ml, int n1) {
    int cnt = 0;
#pragma unroll 1
    for (int jx = 0; jx < n1; ++jx) { const unsigned oh = __builtin_amdgcn_readlane(mh, jx), ol = __builtin_amdgcn_readlane(ml, jx); cnt += (oh > mh || (oh == mh && ol > ml)) ? 1 : 0; }
    return cnt;
}
__device__ __forceinline__ void select_slow(const LAS float* row, int nreg, LAS unsigned* hist, LAS unsigned long long* cand, LAS unsigned* mrow, float lo, float hv, int rr, int lane) {
    unsigned T = 0u; int istar = 0;
    for (int level = 0; level < 40; ++level) {
        if (hv == lo) {
            int cnt = 0; T = fkey(lo);
            for (int i0 = 0; i0 < nreg; i0 += 4) { SEL_LOAD4(s4, row, i0);
#pragma unroll
                for (int k = 0; k < 4; ++k) { unsigned long long m = __ballot(s4[k] == lo); const int pc = __popcll(m);
                    if (cnt < rr && cnt + pc >= rr) { for (int z = rr - cnt - 1; z > 0; --z) m &= m - 1ull; istar = 64 * (i0 + k) + __ffsll(m) - 1; }
                    cnt += pc; } }
            break;
        }
        const float scale = 256.0f / (hv - lo);
        *(LAS u32x4*)(hist + 4 * lane) = (u32x4){0u, 0u, 0u, 0u};
        asm volatile("s_waitcnt lgkmcnt(0)" ::: "memory");
        for (int i0 = 0; i0 < nreg; i0 += 4) { SEL_LOAD4(s4, row, i0);
#pragma unroll
            for (int k = 0; k < 4; ++k) if (s4[k] >= lo && s4[k] <= hv) { int bin = (int)((s4[k] - lo) * scale); bin = bin > 255 ? 255 : bin; __hip_atomic_fetch_add(hist + bin, 1u, __ATOMIC_RELAXED, __HIP_MEMORY_SCOPE_WORKGROUP); } }
        asm volatile("s_waitcnt lgkmcnt(0)" ::: "memory");
        const u32x4 cv = *(const LAS u32x4*)(hist + 4 * lane);
        asm volatile("s_waitcnt lgkmcnt(0)" ::: "memory");
        const unsigned tot = cv[0] + cv[1] + cv[2] + cv[3];
        unsigned S = tot;
#pragma unroll
        for (int off = 1; off < 64; off <<= 1) { const unsigned t = __shfl_down(S, off); if (lane + off < 64) S += t; }
        const unsigned above = S - tot; const bool isit = (above < (unsigned)rr) && (S >= (unsigned)rr);
        int bl = -1; unsigned Gl = 0, cum = above;
#pragma unroll
        for (int k = 3; k >= 0; --k) { if (bl < 0) { if (cum + cv[k] >= (unsigned)rr) { bl = 4 * lane + k; Gl = cum; } else cum += cv[k]; } }
        const int src = __ffsll((unsigned long long)__ballot(isit)) - 1;
        const int bstar = __shfl(bl, src); rr -= (int)__shfl(Gl, src);
        int n1 = 0; float clo = __builtin_inff(), chi = -__builtin_inff();
        for (int i0 = 0; i0 < nreg; i0 += 4) { SEL_LOAD4(s4, row, i0);
#pragma unroll
            for (int k = 0; k < 4; ++k) { bool isc = false;
                if (s4[k] >= lo && s4[k] <= hv) { int bin = (int)((s4[k] - lo) * scale); bin = bin > 255 ? 255 : bin; isc = (bin == bstar); }
                const unsigned long long m = __ballot(isc); const int pos = n1 + __builtin_amdgcn_mbcnt_hi((unsigned)(m >> 32), __builtin_amdgcn_mbcnt_lo((unsigned)m, 0u));
                if (isc) { clo = fminf(clo, s4[k]); chi = fmaxf(chi, s4[k]); if (pos < 64) cand[pos] = ((unsigned long long)fkey(s4[k]) << 32) | (unsigned long long)(0xFFFFu - (unsigned)(64 * (i0 + k) + lane)); }
                n1 += __popcll(m); } }
#pragma unroll
        for (int o = 1; o < 64; o <<= 1) { clo = fminf(clo, __shfl_xor(clo, o)); chi = fmaxf(chi, __shfl_xor(chi, o)); }
        if (n1 <= 64 && clo != chi) {
            asm volatile("s_waitcnt lgkmcnt(0)" ::: "memory");
            const unsigned long long mine = lane < n1 ? cand[lane] : 0ull;
            const unsigned mh = (unsigned)(mine >> 32), ml = (unsigned)mine;
            const int cnt = rank64(mh, ml, n1);
            const int src2 = __ffsll((unsigned long long)__ballot(lane < n1 && cnt == rr - 1)) - 1;
            T = __shfl(mh, src2); istar = 0xFFFF - (int)(__shfl(ml, src2) & 0xFFFFu);
            asm volatile("s_waitcnt lgkmcnt(0)" ::: "memory");
            break;
        }
        lo = clo; hv = chi;
    }
    for (int i0 = 0; i0 < nreg; i0 += 4) { SEL_LOAD4(s4, row, i0);
#pragma unroll
        for (int k = 0; k < 4; ++k) { const unsigned kk = fkey(s4[k]); const int idx = 64 * (i0 + k) + lane;
            const unsigned long long m = __ballot(kk > T || (kk == T && idx <= istar));
            if (lane < 2 && i0 + k < nreg) mrow[2 * (i0 + k) + lane] = lane ? (unsigned)(m >> 32) : (unsigned)m; } }
}
__device__ __forceinline__ int zbin(float s, float scn, float scp) {
    const bool neg = s < 0.f; const int b = (int)__builtin_fmaf(s, neg ? scn : scp, neg ? 126.5f : 128.0f);
    return s == 0.f ? 127 : b;
}
__device__ __forceinline__ unsigned wave_prefix_sum(unsigned v) {
    v += (unsigned)__builtin_amdgcn_update_dpp(0, (int)v, 0x111, 0xF, 0xF, false);
    v += (unsigned)__builtin_amdgcn_update_dpp(0, (int)v, 0x112, 0xF, 0xF, false);
    v += (unsigned)__builtin_amdgcn_update_dpp(0, (int)v, 0x114, 0xF, 0xF, false);
    v += (unsigned)__builtin_amdgcn_update_dpp(0, (int)v, 0x118, 0xF, 0xF, false);
    v += (unsigned)__builtin_amdgcn_update_dpp(0, (int)v, 0x142, 0xA, 0xF, false);
    v += (unsigned)__builtin_amdgcn_update_dpp(0, (int)v, 0x143, 0xC, 0xF, false);
    return v;
}
template <bool TIE0, bool TIE1> __device__ __forceinline__ void count_pass(const LAS float* rowA, const LAS float* rowB, int nreg, const float (&scn)[2], const float (&scp)[2], const int (&bstar)[2], const int (&rr)[2],
                                                                           LAS unsigned long long* cand, LAS unsigned* mrowA, LAS unsigned* mrowB, int (&n1)[2], int lane) {
    for (int i0 = 0; i0 < nreg; i0 += 4) { SEL_LOAD4(sa, rowA, i0); SEL_LOAD4(sb, rowB, i0);
        unsigned wv_[2] = {0u, 0u};
#pragma unroll
        for (int k = 0; k < 4; ++k) {
#pragma unroll
            for (int e = 0; e < 2; ++e) { const float s = e ? sb[k] : sa[k]; const bool tie = e ? TIE1 : TIE0;
                const int bin = zbin(s, scn[e], scp[e]); const bool valid = i0 + k < nreg;
                unsigned long long ms = __ballot(valid && bin > bstar[e]); const unsigned long long mc = __ballot(valid && bin == bstar[e]);
                if (mc != 0ull) {
                    const int pos = n1[e] + __builtin_amdgcn_mbcnt_hi((unsigned)(mc >> 32), __builtin_amdgcn_mbcnt_lo((unsigned)mc, 0u)); const bool isc = (mc >> lane) & 1ull;
                    if (tie) ms |= __ballot(isc && pos < rr[e]);
                    else if (isc && pos < 64) cand[64 * e + pos] = ((unsigned long long)fkey(s) << 32) | (unsigned long long)(0xFFFFu - (unsigned)(64 * (i0 + k) + lane));
                    n1[e] += __popcll(mc); }
                { const unsigned mlo_ = (unsigned)ms, mhi_ = (unsigned)(ms >> 32);
                  asm volatile("v_writelane_b32 %0, %1, %2" : "+v"(wv_[e]) : "s"(mlo_), "n"(2 * k)); asm volatile("v_writelane_b32 %0, %1, %2" : "+v"(wv_[e]) : "s"(mhi_), "n"(2 * k + 1)); } } }
        if (lane < 8) { mrowA[2 * i0 + lane] = wv_[0]; mrowB[2 * i0 + lane] = wv_[1]; } }
}
__device__ __attribute__((noinline)) void select2(const LAS float* rowA, const LAS float* rowB, int nreg, LAS unsigned* hist, LAS unsigned* mrowA, LAS unsigned* mrowB, const LAS unsigned* qmm, int lane) {
    LAS unsigned long long* cand = (LAS unsigned long long*)hist;
    const LAS float* row[2] = {rowA, rowB}; LAS unsigned* mrow[2] = {mrowA, mrowB};
    float scn[2], scp[2];
#pragma unroll
    for (int e = 0; e < 2; ++e) { const float lo = ikey(qmm[2 * e]), hv = ikey(qmm[2 * e + 1]); scn[e] = lo < 0.f ? 126.5f / (0.f - lo) : 0.f; scp[e] = hv > 0.f ? 127.5f / hv : 0.f; }
    *(LAS u32x4*)(hist + 4 * lane) = (u32x4){0u, 0u, 0u, 0u};
    asm volatile("s_waitcnt lgkmcnt(0)" ::: "memory");
    for (int i0 = 0; i0 < nreg; i0 += 4) { SEL_LOAD4(sa, rowA, i0); SEL_LOAD4(sb, rowB, i0);
#pragma unroll
        for (int k = 0; k < 4; ++k) if (i0 + k < nreg) {
            __hip_atomic_fetch_add(hist + zbin(sa[k], scn[0], scp[0]), 1u, __ATOMIC_RELAXED, __HIP_MEMORY_SCOPE_WORKGROUP);
            __hip_atomic_fetch_add(hist + zbin(sb[k], scn[1], scp[1]), 0x10000u, __ATOMIC_RELAXED, __HIP_MEMORY_SCOPE_WORKGROUP); } }
    asm volatile("s_waitcnt lgkmcnt(0)" ::: "memory");
    const u32x4 cvp = *(const LAS u32x4*)(hist + 4 * lane);
    asm volatile("s_waitcnt lgkmcnt(0)" ::: "memory");
    int bstar[2], rr[2];
#pragma unroll
    for (int e = 0; e < 2; ++e) { unsigned cv[4];
#pragma unroll
        for (int k = 0; k < 4; ++k) cv[k] = (cvp[k] >> (16 * e)) & 0xFFFFu;
        const unsigned tot = cv[0] + cv[1] + cv[2] + cv[3]; const unsigned pre = wave_prefix_sum(tot);
        const unsigned S = (unsigned)__builtin_amdgcn_readlane((int)pre, 63) - pre + tot;
        const unsigned above = S - tot; const bool isit = (above < 256u) && (S >= 256u);
        int bl = -1; unsigned Gl = 0, cum = above;
#pragma unroll
        for (int k = 3; k >= 0; --k) { if (bl < 0) { if (cum + cv[k] >= 256u) { bl = 4 * lane + k; Gl = cum; } else cum += cv[k]; } }
        const int src = __ffsll((unsigned long long)__ballot(isit)) - 1;
        bstar[e] = __builtin_amdgcn_readlane(bl, src); rr[e] = 256 - __builtin_amdgcn_readlane((int)Gl, src); }
    int n1[2] = {0, 0};
    const bool t0 = bstar[0] == 127, t1 = bstar[1] == 127;
    if (!t0 && !t1) count_pass<false, false>(rowA, rowB, nreg, scn, scp, bstar, rr, cand, mrowA, mrowB, n1, lane);
    else if (t0 && !t1) count_pass<true, false>(rowA, rowB, nreg, scn, scp, bstar, rr, cand, mrowA, mrowB, n1, lane);
    else if (!t0 && t1) count_pass<false, true>(rowA, rowB, nreg, scn, scp, bstar, rr, cand, mrowA, mrowB, n1, lane);
    else count_pass<true, true>(rowA, rowB, nreg, scn, scp, bstar, rr, cand, mrowA, mrowB, n1, lane);
    asm volatile("s_waitcnt lgkmcnt(0)" ::: "memory");
#ifndef SEL_FAST_MAX
#define SEL_FAST_MAX 64
#endif
#pragma unroll
    for (int e = 0; e < 2; ++e) if (bstar[e] != 127 && n1[e] <= SEL_FAST_MAX) {
        const unsigned long long mine = lane < n1[e] ? cand[64 * e + lane] : 0ull; const unsigned mh = (unsigned)(mine >> 32), ml = (unsigned)mine;
        const int cnt = rank64(mh, ml, n1[e]);
        if (lane < n1[e] && cnt < rr[e]) { const unsigned idx = 0xFFFFu - (ml & 0xFFFFu); __hip_atomic_fetch_or(mrow[e] + (idx >> 5), 1u << (idx & 31u), __ATOMIC_RELAXED, __HIP_MEMORY_SCOPE_WORKGROUP); } }
    asm volatile("s_waitcnt lgkmcnt(0)" ::: "memory");
#pragma unroll
    for (int e = 0; e < 2; ++e) if (bstar[e] != 127 && n1[e] > SEL_FAST_MAX) {
        float clo = __builtin_inff(), chi = -__builtin_inff();
        for (int i0 = 0; i0 < nreg; i0 += 4) { SEL_LOAD4(s4, row[e], i0);
#pragma unroll
            for (int k = 0; k < 4; ++k) if (i0 + k < nreg && zbin(s4[k], scn[e], scp[e]) == bstar[e]) { clo = fminf(clo, s4[k]); chi = fmaxf(chi, s4[k]); } }
#pragma unroll
        for (int o = 1; o < 64; o <<= 1) { clo = fminf(clo, __shfl_xor(clo, o)); chi = fmaxf(chi, __shfl_xor(chi, o)); }
        select_slow(row[e], nreg, hist, cand, mrow[e], clo, chi, rr[e], lane); }
}
#undef SEL_LOAD4

__device__ __forceinline__ void build_relb(const float* relb, LAS unsigned char* lds, int tid) {
    LAS float* rb = (LAS float*)(lds + L_RELB);
    for (int e = tid; e < 8 * 224; e += 512) { const int h = e / 224, rel = e % 224 - 160; rb[e] = (relb[t5_bucket(rel) * 8 + h] - relb[15 * 8 + h]) * LOG2E; }
}
#ifdef TIMING_VARIANT
#define TV(bit) (variant & (bit))
#else
#define TV(bit) 0
#endif
__device__ __forceinline__ void attn_unit(const P& A, int b, int c, LAS unsigned char* lds, int tid, int variant) {
    const int lane = tid & 63, wv = __builtin_amdgcn_readfirstlane(tid >> 6), col = lane & 31, hi = lane >> 5;
    const int L = 64 * (c + 1), ntile = L / 32;
    const size_t tokb = (size_t)b * SEQ;
    LAS unsigned* maskw = (LAS unsigned*)(lds + L_MASK);
    LAS float* fb = (LAS float*)(lds + L_FBUF) + wv * 64;
    __syncthreads();
    if (c < 4 || TV(1)) {
        for (int e = tid; e < 64 * ntile; e += 512) { const int q = e / ntile, j = e % ntile; maskw[q * 65 + j] = 0xFFFFFFFFu; }
    } else {
        LAS float* sc = (LAS float*)lds; LAS unsigned* qmm = (LAS unsigned*)(lds + L_QMM);
        const int l15 = lane & 15, l4 = lane >> 4;
        h16x8 af[4][2]; f32x4 w4[4]; h16x8 bf[2][2], bn[2][2];
#define SC_LOAD_Q(rd_) do { _Pragma("unroll") for (int rt = 0; rt < 4; ++rt) { const size_t tqa = tokb + 64 * c + 16 * (rd_) + 4 * rt + (l15 >> 2); \
            _Pragma("unroll") for (int ks = 0; ks < 2; ++ks) af[rt][ks] = *(const h16x8*)(A.qidx() + tqa * 256 + (l15 & 3) * 64 + 32 * ks + 8 * l4); \
            w4[rt] = *(const f32x4*)(A.widx() + (tokb + 64 * c + 16 * (rd_) + 4 * rt + l4) * 4); } \
          { const h16* kp = A.kidx() + (tokb + 32 * wv + l15) * 64 + 8 * l4; \
            _Pragma("unroll") for (int u = 0; u < 2; ++u) _Pragma("unroll") for (int ks = 0; ks < 2; ++ks) bf[u][ks] = *(const h16x8*)(kp + u * 16 * 64 + 32 * ks); } } while (0)
        SC_LOAD_Q(0);
        for (int rd = 0; rd < 4; ++rd) {
            if (tid < 32) qmm[tid] = (tid & 1) ? 0u : 0xFFFFFFFFu;
            __syncthreads();
            float smn[4], smx[4];
#pragma unroll
            for (int rt = 0; rt < 4; ++rt) { smn[rt] = __builtin_inff(); smx[rt] = -__builtin_inff(); }
            for (int j = wv; j < ntile; j += 8) {
                if (j + 8 < ntile) { const h16* kp = A.kidx() + (tokb + 32 * (j + 8) + l15) * 64 + 8 * l4;
#pragma unroll
                    for (int u = 0; u < 2; ++u)
#pragma unroll
                        for (int ks = 0; ks < 2; ++ks) bn[u][ks] = *(const h16x8*)(kp + u * 16 * 64 + 32 * ks); }
#pragma unroll
                for (int u = 0; u < 2; ++u)
#pragma unroll
                    for (int rt = 0; rt < 4; ++rt) {
                        f32x4 acc = {0.f, 0.f, 0.f, 0.f};
                        acc = __builtin_amdgcn_mfma_f32_16x16x32_f16(af[rt][0], bf[u][0], acc, 0, 0, 0);
                        acc = __builtin_amdgcn_mfma_f32_16x16x32_f16(af[rt][1], bf[u][1], acc, 0, 0, 0);
                        float sv = fmaxf(acc[0], 0.f) * w4[rt][0]; sv += fmaxf(acc[1], 0.f) * w4[rt][1]; sv += fmaxf(acc[2], 0.f) * w4[rt][2]; sv += fmaxf(acc[3], 0.f) * w4[rt][3];
                        sv += 0.0f;
                        smn[rt] = fminf(smn[rt], sv); smx[rt] = fmaxf(smx[rt], sv);
                        sc[(4 * rt + l4) * SC_STRIDE + 32 * j + 16 * u + l15] = sv;
                    }
#pragma unroll
                for (int u = 0; u < 2; ++u)
#pragma unroll
                    for (int ks = 0; ks < 2; ++ks) bf[u][ks] = bn[u][ks];
            }
#pragma unroll
            for (int rt = 0; rt < 4; ++rt) { __hip_atomic_fetch_min(qmm + 2 * (4 * rt + l4), fkey(smn[rt]), __ATOMIC_RELAXED, __HIP_MEMORY_SCOPE_WORKGROUP); __hip_atomic_fetch_max(qmm + 2 * (4 * rt + l4) + 1, fkey(smx[rt]), __ATOMIC_RELAXED, __HIP_MEMORY_SCOPE_WORKGROUP); }
            if (rd + 1 < 4) SC_LOAD_Q(rd + 1);
            __syncthreads();
            if (!TV(16))
            select2(sc + (2 * wv) * SC_STRIDE, sc + (2 * wv + 1) * SC_STRIDE, L / 64, (LAS unsigned*)(lds + L_HIST) + wv * 256, maskw + (16 * rd + 2 * wv) * 65, maskw + (16 * rd + 2 * wv + 1) * 65, qmm + 4 * wv, lane);
            __syncthreads();
        }
    }
    if (!TV(2)) {
        const int h = wv;
        LAS h16* Ks = (LAS h16*)(lds + L_KS); LAS h16* Vs = (LAS h16*)(lds + L_VS);
        build_relb(A.relb, lds, tid);
        const LAS float* rb = (const LAS float*)(lds + L_RELB) + h * 224;
        h16x8 qf[2][4];
#pragma unroll
        for (int ct = 0; ct < 2; ++ct)
#pragma unroll
            for (int s = 0; s < 4; ++s) qf[ct][s] = *(const h16x8*)(A.qa() + (tokb + 64 * c + 32 * ct + col) * 512 + h * 64 + 16 * s + 8 * hi);
        f32x16 O[2][2]; float lsum[2], cref[2]; bool started[2] = {false, false};
        const h16 b15h = (h16)(A.relb[15 * 8 + h] * LOG2E);
#pragma unroll
        for (int ct = 0; ct < 2; ++ct) { O[ct][0] = (f32x16){}; O[ct][1] = (f32x16){}; lsum[ct] = 0.f; cref[ct] = (float)b15h; }
        const int srow = tid >> 3, spc = tid & 7;
        const h16* gk = A.ka() + (tokb + srow) * 64 + 8 * spc; const h16* gv = A.va() + (tokb + srow) * 64 + 8 * spc;
        LAS h16* kdst = Ks + srow * 72 + 8 * spc; LAS h16* vdst = Vs + srow * 72 + 8 * spc;
#define ATT_STAGE_K(stage, vk) do { *(LAS u32x4*)(kdst + (stage) * (64 * 72)) = (vk); } while (0)
#define ATT_STAGE_V(stage, vv) do { *(LAS u32x4*)(vdst + (stage) * (64 * 72)) = (vv); } while (0)
        const int nst = ntile / 2;
        u32x4 sreg = *(const u32x4*)gk; ATT_STAGE_K(0, sreg); sreg = *(const u32x4*)gv; ATT_STAGE_V(0, sreg);
        __syncthreads();
        for (int js = 0; js < nst; ++js) {
            const int st = js & 1;
            if (js + 1 < nst) sreg = *(const u32x4*)(gk + (size_t)(js + 1) * (64 * 64));
#pragma unroll 1
            for (int t2 = 0; t2 < 2; ++t2) {
            const int j = 2 * js + t2;
            const LAS h16* kb = Ks + st * (64 * 72) + (32 * t2 + col) * 72 + 8 * hi;
            h16x8 kf[4];
#pragma unroll
            for (int s = 0; s < 4; ++s) kf[s] = *(const LAS h16x8*)(kb + 16 * s);
            const bool far = j <= 2 * c - 4;
            const LAS h16* vb = Vs + st * (64 * 72) + (32 * t2 + 4 * hi + ((lane & 15) >> 2)) * 72 + 16 * ((lane >> 4) & 1) + 4 * (lane & 3);
            f32x16 sa[2];
#pragma unroll
            for (int ct = 0; ct < 2; ++ct) { const h16x8 qxt = {hi == 0 ? (h16)cref[ct] : (h16)0.0f, 0, 0, 0, 0, 0, 0, 0};
                const h16x8 kxt = {hi == 0 ? (h16)1.0f : (h16)0.0f, 0, 0, 0, 0, 0, 0, 0};
                sa[ct] = __builtin_amdgcn_mfma_f32_32x32x16_f16(kxt, qxt, (f32x16){}, 0, 0, 0);
#pragma unroll
                for (int s = 0; s < 4; ++s) sa[ct] = __builtin_amdgcn_mfma_f32_32x32x16_f16(kf[s], qf[ct][s], sa[ct], 0, 0, 0); }
            if (!far) {
#pragma unroll
                for (int ct = 0; ct < 2; ++ct) { const int rel0 = 32 * j - (64 * c + 32 * ct + col) + 160 + 4 * hi;
#pragma unroll
                    for (int r = 0; r < 16; ++r) sa[ct][r] += rb[rel0 + (r & 3) + 8 * (r >> 2)]; } }
#pragma unroll
            for (int ct = 0; ct < 2; ++ct) { const unsigned word = maskw[(32 * ct + col) * 65 + j] >> (4 * hi);
#pragma unroll
                for (int r = 0; r < 16; ++r) { const int neg = __builtin_amdgcn_sbfe((int)word, (r & 3) + 8 * (r >> 2), 1);
                    sa[ct][r] = __int_as_float((neg & __float_as_int(sa[ct][r])) | (~neg & (int)0xFF800000)); } }
            h16x8 p0[2], p1[2];
            if (TV(64)) {
#pragma unroll
                for (int ct = 0; ct < 2; ++ct) { p0[ct] = (h16x8){(h16)sa[ct][0], (h16)sa[ct][1], (h16)sa[ct][2], (h16)sa[ct][3], (h16)sa[ct][4], (h16)sa[ct][5], (h16)sa[ct][6], (h16)sa[ct][7]};
                    p1[ct] = (h16x8){(h16)sa[ct][8], (h16)sa[ct][9], (h16)sa[ct][10], (h16)sa[ct][11], (h16)sa[ct][12], (h16)sa[ct][13], (h16)sa[ct][14], (h16)sa[ct][15]}; } }
            else
            softmax_tile2(sa, cref, started, lsum, O, fb, lane, hi, p0, p1);
#pragma unroll
            for (int db = 0; db < 2; ++db) {
                const LAS h16* vp = vb + 32 * db;
                const h16x4 a0 = vtr(vp), a1 = vtr(vp + 8 * 72), c0 = vtr(vp + 16 * 72), c1 = vtr(vp + 24 * 72);
                const h16x8 v0 = {a0[0], a0[1], a0[2], a0[3], a1[0], a1[1], a1[2], a1[3]}, v1 = {c0[0], c0[1], c0[2], c0[3], c1[0], c1[1], c1[2], c1[3]};
#pragma unroll
                for (int ct = 0; ct < 2; ++ct) { O[ct][db] = __builtin_amdgcn_mfma_f32_32x32x16_f16(p0[ct], v0, O[ct][db], 0, 0, 0); O[ct][db] = __builtin_amdgcn_mfma_f32_32x32x16_f16(p1[ct], v1, O[ct][db], 0, 0, 0); }
            }
            if (js + 1 < nst) { if (t2 == 0) { ATT_STAGE_K(st ^ 1, sreg); sreg = *(const u32x4*)(gv + (size_t)(js + 1) * (64 * 64)); } else ATT_STAGE_V(st ^ 1, sreg); }
            }
            if (!TV(32)) __syncthreads();
#ifdef ATT_SKEW
            if (wv >= 4) __builtin_amdgcn_s_sleep(ATT_SKEW);
#endif
        }
#pragma unroll
        for (int ct = 0; ct < 2; ++ct) store_o(O[ct][0], O[ct][1], lsum[ct], fb + 32 * ct, lane, hi, A.out, tokb + 64 * c + 32 * ct, h * 64);
    }
    if (!TV(4)) {
        const int qg = wv >> 2, hm = wv & 3; const size_t tok0 = tokb + 64 * c + 32 * qg;
        h16x8 qf[4];
#pragma unroll
        for (int s = 0; s < 4; ++s) qf[s] = *(const h16x8*)(A.qm() + (tok0 + col) * 256 + hm * 64 + 16 * s + 8 * hi);
        f32x16 O0 = {}, O1 = {}; float lsum = 0.f, cref = 0.f; h16x8 qx = {0, 0, 0, 0, 0, 0, 0, 0}; bool started = false;
        const h16x8 kx = {hi == 0 ? (h16)1.0f : (h16)0.0f, 0, 0, 0, 0, 0, 0, 0};
        const h16* kbase = A.mk() + ((size_t)b * MEMT + col) * 256 + hm * 64 + 8 * hi;
        const h16* vbase = A.mvT() + (((size_t)b * 4 + hm) * 64 + col) * MEMT + 4 * hi;
        h16x8 kf[4], kn[4]; h16x4 vf[8], vn[8];
#pragma unroll
        for (int s = 0; s < 4; ++s) kf[s] = *(const h16x8*)(kbase + 16 * s);
#pragma unroll
        for (int db = 0; db < 2; ++db)
#pragma unroll
            for (int q4 = 0; q4 < 4; ++q4) vf[4 * db + q4] = *(const h16x4*)(vbase + (size_t)db * 32 * MEMT + 8 * q4);
        for (int j = 0; j < MEMT / 32; ++j) {
            if (j + 1 < MEMT / 32) {
#pragma unroll
                for (int s = 0; s < 4; ++s) kn[s] = *(const h16x8*)(kbase + (size_t)(j + 1) * 32 * 256 + 16 * s);
#pragma unroll
                for (int db = 0; db < 2; ++db)
#pragma unroll
                    for (int q4 = 0; q4 < 4; ++q4) vn[4 * db + q4] = *(const h16x4*)(vbase + (size_t)db * 32 * MEMT + 32 * (j + 1) + 8 * q4); }
            f32x16 sa = __builtin_amdgcn_mfma_f32_32x32x16_f16(kx, qx, (f32x16){}, 0, 0, 0);
#pragma unroll
            for (int s = 0; s < 4; ++s) sa = __builtin_amdgcn_mfma_f32_32x32x16_f16(kf[s], qf[s], sa, 0, 0, 0);
            h16x8 p0, p1;
            softmax_tile(sa, cref, qx, started, lsum, O0, O1, fb, lane, hi, p0, p1);
#pragma unroll
            for (int db = 0; db < 2; ++db) {
                const h16x4 a0 = vf[4 * db], a1 = vf[4 * db + 1], c0 = vf[4 * db + 2], c1 = vf[4 * db + 3];
                const h16x8 v0 = {a0[0], a0[1], a0[2], a0[3], a1[0], a1[1], a1[2], a1[3]}, v1 = {c0[0], c0[1], c0[2], c0[3], c1[0], c1[1], c1[2], c1[3]};
                if (db == 0) { O0 = __builtin_amdgcn_mfma_f32_32x32x16_f16(p0, v0, O0, 0, 0, 0); O0 = __builtin_amdgcn_mfma_f32_32x32x16_f16(p1, v1, O0, 0, 0, 0); }
                else { O1 = __builtin_amdgcn_mfma_f32_32x32x16_f16(p0, v0, O1, 0, 0, 0); O1 = __builtin_amdgcn_mfma_f32_32x32x16_f16(p1, v1, O1, 0, 0, 0); }
            }
#pragma unroll
            for (int s = 0; s < 4; ++s) kf[s] = kn[s];
#pragma unroll
            for (int q8 = 0; q8 < 8; ++q8) vf[q8] = vn[q8];
        }
        store_o(O0, O1, lsum, fb, lane, hi, A.out, tok0, 512 + hm * 64);
    }
}

}
#ifndef GLU_ALIGN
#define GLU_ALIGN true
#endif
#ifndef MK_N_LAUNCHES
#define MK_N_LAUNCHES 1
#endif
constexpr int N_PHASES = 12;
constexpr int NWAVES = 8;
constexpr size_t MiB = 1u << 20;
constexpr size_t WS_CTL = 0, CTL_ZERO_BYTES = 1 * MiB;
constexpr size_t WS_W1A = 1 * MiB, WS_W1B = 12 * MiB, WS_WIN = 18 * MiB, WS_WMKV = 27 * MiB, WS_WGLU = 28 * MiB, WS_WOA = 29 * MiB, WS_WOM = 30 * MiB, WS_WOUT = 31 * MiB,
                 WS_W2A = 33 * MiB, WS_W2B = 44 * MiB, WS_TCAT = 50 * MiB, WS_WST = 90 * MiB;
constexpr size_t WS_RSTD0 = 98 * MiB, WS_SSQ1 = 99 * MiB, WS_SSQ2 = 103 * MiB, WS_SSQ3 = 107 * MiB, WS_MEMH = 111 * MiB, WS_MK = 127 * MiB, WS_MVT = 131 * MiB, WS_A64 = 135 * MiB;
constexpr size_t WS_ABUF = 136 * MiB;
constexpr size_t WS_CBUF = 264 * MiB;
constexpr size_t WS_YS = WS_CBUF + 96 * MiB;
constexpr size_t WS_BIG = 392 * MiB;
constexpr size_t WS_QA = WS_BIG, WS_QIDX = WS_BIG + 64 * MiB, WS_QM = WS_BIG + 96 * MiB, WS_OB = WS_BIG  ,
                 WS_KA = WS_BIG + 128 * MiB, WS_VAT = WS_BIG + 136 * MiB, WS_KIDX = WS_BIG + 144 * MiB, WS_WIDX = WS_BIG + 152 * MiB, WS_ACAT = WS_BIG + 153 * MiB, WS_GATES = WS_BIG + 193 * MiB;
constexpr size_t WS_END = WS_GATES + 384 * MiB;
static_assert(WS_END <= 1024 * MiB, "workspace map");
constexpr int CW_BAR = 4096, CW_FIN = 16384;

constexpr int LDS_BYTES = 163840;
constexpr int MISC_OFF = LDS_BYTES - 256;

#define XB_TMO      128
#define XB_XCNT(j)  (256  + 64 * (j))
#define XB_XSUB(j)  (1280 + 64 * (j))
#define XB_XGEN(j)  (2304 + 64 * (j))
#define XB_TOP      3328
#define XB_TOPGEN   3392
#define XCD_BAR_WORDS 3456
#define XB_SPIN_CAP (1u << 18)
__device__ __forceinline__ unsigned xb_ld(unsigned* p)              { return __hip_atomic_load(p, __ATOMIC_RELAXED, __HIP_MEMORY_SCOPE_AGENT); }
__device__ __forceinline__ unsigned xb_add(unsigned* p, unsigned v) { return __hip_atomic_fetch_add(p, v, __ATOMIC_RELAXED, __HIP_MEMORY_SCOPE_AGENT); }
__device__ __forceinline__ unsigned xb_xcc_id() { return (unsigned)__builtin_amdgcn_s_getreg((3 << 11) | 20) & 0xFu; }
#define XB_SPIN(cond, bar) do { unsigned _sp = 0; while (cond) { __builtin_amdgcn_s_sleep(1); \
    if ((++_sp & 255u) == 0u) { if (xb_ld(&(bar)[XB_TMO])) break; if (_sp > XB_SPIN_CAP) { atomicAdd(&(bar)[XB_TMO], 1u); break; } } } } while (0)
struct XcdBarrier { unsigned* bar; unsigned x; volatile LAS unsigned* st; };
__device__ __forceinline__ XcdBarrier xcd_barrier_post(unsigned* bar, volatile LAS unsigned* st) {
    XcdBarrier b; b.bar = bar; b.x = xb_xcc_id(); b.st = st;
    if (threadIdx.x == 0) (void)xb_add(&bar[XB_XCNT(b.x)], 1u);
    return b;
}
__device__ __forceinline__ void xcd_barrier_complete(unsigned* bar, unsigned x, unsigned& nloc, unsigned& nx) {
    const unsigned G = gridDim.x * gridDim.y * gridDim.z;
    unsigned sum, cnt, mine, sp = 0u;
    for (;;) {
        sum = 0u; cnt = 0u; mine = 0u;
#pragma unroll
        for (unsigned j = 0; j < 16; ++j) { const unsigned c = xb_ld(&bar[XB_XCNT(j)]); sum += c; cnt += (c > 0u) ? 1u : 0u; mine = (j == x) ? c : mine; }
        if (sum == G) break;
        __builtin_amdgcn_s_sleep(1);
        if ((++sp & 255u) == 0u) { if (xb_ld(&bar[XB_TMO])) break; if (sp > XB_SPIN_CAP) { atomicAdd(&bar[XB_TMO], 1u); break; } }
    }
    nloc = mine > 0u ? mine : 1u; nx = cnt > 0u ? cnt : 1u;
}
__device__ __forceinline__ void xcd_barrier(const XcdBarrier& b) {
    asm volatile("s_waitcnt vmcnt(0)" ::: "memory");
    __syncthreads();
    if (threadIdx.x == 0) {
        unsigned* bar = b.bar;
        __builtin_amdgcn_s_waitcnt(0);
        unsigned nloc = b.st[0], nx = b.st[1];
        if (nloc == 0u) { xcd_barrier_complete(bar, b.x, nloc, nx); b.st[0] = nloc; b.st[1] = nx; }
        const unsigned old = xb_add(&bar[XB_XSUB(b.x)], 1u);
        const unsigned gen = old / nloc;
        if (old + 1u == (gen + 1u) * nloc) {
            __builtin_amdgcn_fence(__ATOMIC_RELEASE, "agent");
            asm volatile("s_waitcnt vmcnt(0)" ::: "memory");
            const unsigned og = xb_add(&bar[XB_TOP], 1u);
            const unsigned tg = og / nx;
            if (og + 1u == (tg + 1u) * nx) xb_add(&bar[XB_TOPGEN], 1u);
            else XB_SPIN(xb_ld(&bar[XB_TOPGEN]) == tg, bar);
            __builtin_amdgcn_fence(__ATOMIC_ACQUIRE, "agent");
            xb_add(&bar[XB_XGEN(b.x)], 1u);
            asm volatile("s_waitcnt vmcnt(0)" ::: "memory");
        } else {
            XB_SPIN(xb_ld(&bar[XB_XGEN(b.x)]) == gen, bar);
            __builtin_amdgcn_fence(__ATOMIC_ACQUIRE, "agent");
            asm volatile("s_waitcnt vmcnt(0)" ::: "memory");
        }
    }
    __syncthreads();
}

enum { I_X = 0, I_MEM, I_FFN1_NORM, I_FFN1_WIN, I_FFN1_WOUT, I_MIX_NORM, I_W_IN, I_AQG, I_AKG, I_RELB, I_WOA, I_LRE, I_LIM, I_LOGDT, I_BRE, I_BIM, I_CRE, I_CIM, I_SSMD, I_WGLU,
       I_MEM_NORM, I_WMKV, I_MQG, I_MKG, I_WOM, I_WOUT, I_FFN2_NORM, I_FFN2_WIN, I_FFN2_WOUT, I_FINAL_NORM, N_IN };
struct Args { const float* in[N_IN]; float* out; unsigned char* ws; int ph_lo, ph_hi, variant, pad; };
static_assert(sizeof(Args) == (N_IN + 2) * 8 + 16, "Args has no padding");

__global__ void __launch_bounds__(NWAVES * 64, 2) mega_fwd(Args args) {
    extern __shared__ __attribute__((aligned(16))) unsigned char lds_raw[];
    LAS unsigned char* lds = (LAS unsigned char*)lds_raw;
    volatile LAS unsigned* MISC = (volatile LAS unsigned*)(lds + MISC_OFF);
    const int tid = threadIdx.x, lane = tid & 63, wave = __builtin_amdgcn_readfirstlane(tid >> 6);
    const int G = gridDim.x; const int bx = blockIdx.x; const int vcu = (G % 8 == 0) ? (bx % 8) * (G / 8) + bx / 8 : bx;
    unsigned char* ws = args.ws;
    unsigned* ctl = (unsigned*)(ws + WS_CTL);
    for (int u = tid; u < 64; u += NWAVES * 64) MISC[u] = 0u;
    __syncthreads();
    const int lo = args.ph_lo, hi = args.ph_hi;
    XcdBarrier bar; bar.bar = ctl + CW_BAR; bar.x = 0; bar.st = nullptr;
    if (hi - lo > 1) bar = xcd_barrier_post(ctl + CW_BAR, MISC + 8);
#ifdef ONLY_PHASE
#define IN(k) ((k) == ONLY_PHASE && lo <= (k) && (k) < hi)
#else
#define IN(k) (lo <= (k) && (k) < hi)
#endif
#ifdef DBG_SPIN
#define SEAM(k) do { if (IN(k) && IN((k) + 1)) xcd_barrier(bar); if (bx == 0 && tid == 0) ((unsigned long long*)(ctl + 9100))[(k) + 1] = __builtin_amdgcn_s_memrealtime(); } while (0)
#else
#define SEAM(k) do { if (IN(k) && IN((k) + 1)) xcd_barrier(bar); } while (0)
#endif

    float* const xres = args.out;
#define WSP(T, off) ((T*)(ws + (off)))
#define W1A WSP(h16, WS_W1A)
#define W1B WSP(h16, WS_W1B)
#define WIN WSP(h16, WS_WIN)
#define WMKV WSP(h16, WS_WMKV)
#define WGLU WSP(h16, WS_WGLU)
#define WOA WSP(h16, WS_WOA)
#define WOM WSP(h16, WS_WOM)
#define WOUT WSP(h16, WS_WOUT)
#define W2A WSP(h16, WS_W2A)
#define W2B WSP(h16, WS_W2B)
#define TCAT WSP(h16, WS_TCAT)
#define WST WSP(h16, WS_WST)
#define rstd0 WSP(float, WS_RSTD0)
#define ssq1 WSP(float, WS_SSQ1)
#define ssq2 WSP(float, WS_SSQ2)
#define ssq3 WSP(float, WS_SSQ3)
#define memh WSP(h16, WS_MEMH)
#define mk WSP(h16, WS_MK)
#define mvT WSP(h16, WS_MVT)
#define a64 WSP(float, WS_A64)
#define abuf WSP(h16, WS_ABUF)
#define mergedb ((h16*)args.out)
#define acatt WSP(h16, WS_CBUF)
#define ys WSP(h16, WS_YS)
#define x2h WSP(h16, WS_CBUF)
#define hidden WSP(h16, WS_BIG)
#define qa WSP(h16, WS_QA)
#define qidx WSP(h16, WS_QIDX)
#define qm WSP(h16, WS_QM)
#define ob WSP(h16, WS_OB)
#define ka WSP(h16, WS_KA)
#define va WSP(h16, WS_VAT)
#define kidx WSP(h16, WS_KIDX)
#define widx WSP(float, WS_WIDX)
#define acat WSP(h16, WS_ACAT)
#define gates WSP(h16, WS_GATES)
#ifdef DBG_SPIN
    if (bx == 0 && tid == 0) ((unsigned long long*)(ctl + 9100))[0] = __builtin_amdgcn_s_memrealtime();
#endif
    if (IN(0)) {
        const int gw = vcu * NWAVES + wave, NGW = G * NWAVES;
        LAS float* scr = (LAS float*)(lds + wave * 16384);
        pro::WPtrs WP{args.in[I_FFN1_WIN], args.in[I_FFN1_WOUT], args.in[I_W_IN], args.in[I_WMKV], args.in[I_WGLU], args.in[I_WOA], args.in[I_WOM], args.in[I_WOUT], args.in[I_FFN2_WIN], args.in[I_FFN2_WOUT],
                      args.in[I_FFN1_NORM], args.in[I_MIX_NORM], args.in[I_FFN2_NORM], W1A, W1B, WIN, WMKV, WGLU, WOA, WOM, WOUT, W2A, W2B};
        for (int it = gw; it < pro::IT_TOTAL; it += NGW) pro::weight_item(WP, it, scr, lane);
        for (int m = gw; m < MTOK; m += 4 * NGW) pro::rows_to_h16<4>(args.in[I_X], abuf, m, NGW, MTOK, nullptr, rstd0, lane);
        for (int m = gw; m < BATCH * MEMT; m += 4 * NGW) pro::rows_to_h16<4>(args.in[I_MEM], memh, m, NGW, BATCH * MEMT, args.in[I_MEM_NORM], nullptr, lane);
        for (int i = (vcu * NWAVES + wave) * 64 + lane; i < MTOK; i += G * NWAVES * 64) { ssq1[i] = 0.f; ssq2[i] = 0.f; ssq3[i] = 0.f; }
        pro::S5In SI{args.in[I_LRE], args.in[I_LIM], args.in[I_LOGDT], args.in[I_BRE], args.in[I_BIM], args.in[I_CRE], args.in[I_CIM], args.in[I_SSMD]};
        for (int it = vcu; it < 16 * 64; it += G) pro::s5_item(SI, it >> 6, it & 63, TCAT, WST, a64, (LAS float*)lds, tid);
        __syncthreads();
    }
    SEAM(0);
    if (IN(1)) {
#if defined(DBG_CLOCK)
        unsigned long long t0w_ = __builtin_amdgcn_s_memrealtime();
        if (DBG_CLOCK < 10 && bx == 0 && tid == 0) { ((unsigned long long*)(ctl + 9000))[0] = __builtin_amdgcn_s_memtime(); ((unsigned long long*)(ctl + 9000))[1] = t0w_; }
#endif
        pg8::Gemm g{abuf, W1A, 1024, 1024, 1024}; pg8::StaticOrder S; S.init(MTOK, 2 * FFN, G, bx);
        epi::EpiSwiglu<0> E{hidden, rstd0};
        pg8::gemm_phase<epi::EpiSwiglu<0>, pg8::StaticOrder, true, true>(lds, g, S, E);
#ifdef DBG_CLOCK
        if (tid == 0) { const unsigned d_ = (unsigned)(__builtin_amdgcn_s_memrealtime() - t0w_); atomicMax(ctl + 9016, d_); atomicMin(ctl + 9017, ~0u - d_ == 0 ? 0 : d_ ); atomicMax(ctl + 9018, ~d_); }
        if (DBG_CLOCK < 10 && bx == 0 && tid == 0) { ((unsigned long long*)(ctl + 9000))[2] = __builtin_amdgcn_s_memtime(); ((unsigned long long*)(ctl + 9000))[3] = __builtin_amdgcn_s_memrealtime(); }
#endif
    }
    SEAM(1);
    if (IN(2)) {
        { pg8::Gemm g{hidden, W1B, FFN, FFN, FFN}; pg8::StaticOrder S; S.init(MTOK, DM, G, bx);
          epi::EpiResid<false> E{args.in[I_X], abuf, ssq1, 0.5f};
          pg8::gemm_phase<epi::EpiResid<false>, pg8::StaticOrder, true, true>(lds, g, S, E); }
        { pg8::Gemm g{memh, WMKV, 1024, 1024, 1024}; pg8::StaticOrder S; S.init(BATCH * MEMT, 512, G, bx);
          epi::EpiMemKV E{args.in[I_MKG], mk, mvT};
          pg8::gemm_phase<epi::EpiMemKV, pg8::StaticOrder, true, true>(lds, g, S, E); }
    }
    SEAM(2);
    if (IN(3)) {
        pg8::Gemm g{abuf, WIN, 1024, 1024, 1024}; pg8::StaticOrder S; S.init(MTOK, NWIN, G, bx);
        epi::EpiWin E{ssq1, args.in[I_AQG], args.in[I_AKG], args.in[I_MQG], qa, ka, va, qidx, kidx, acat, qm, gates, widx};
        pg8::gemm_phase<epi::EpiWin, pg8::StaticOrder, true, true>(lds, g, S, E);
    }
    SEAM(3);
    if (IN(4)) {
        const int variant = args.variant;
        if (!TV(8)) { pg8::Gemm g{acat, WST, 1024, 1280, 1024}; pg8::DiagOrder S; S.init(16, 4, 1, G, bx);
          epi::EpiS5State E{args.in[I_LOGDT], a64, acat};
          pg8::gemm_phase<epi::EpiS5State, pg8::DiagOrder, false, true>(lds, g, S, E); }
        __syncthreads();
        static_assert(WS_QIDX == WS_QA + 64 * MiB && WS_QM == WS_QA + 96 * MiB && WS_KA == WS_QA + 128 * MiB && WS_VAT == WS_QA + 136 * MiB && WS_KIDX == WS_QA + 144 * MiB && WS_WIDX == WS_QA + 152 * MiB && WS_MVT == WS_MK + 4 * MiB, "att::P offsets");
        att::P AP{ws + WS_QA, ws + WS_MK, args.in[I_RELB], variant ? mergedb : acatt};
        if (G == 256) {
            const int b = vcu >> 3, s = vcu & 7;
            for (int i = 0; i < 4; ++i) { const int c = i == 0 ? s : i == 1 ? 31 - s : i == 2 ? 8 + s : 23 - s; att::attn_unit(AP, b, c, lds, tid, variant); }
        } else {
            for (int u = vcu; u < BATCH * 32; u += G) att::attn_unit(AP, u >> 5, u & 31, lds, tid, variant);
        }
        __syncthreads();
    }
    SEAM(4);
    if (IN(5)) {
        pg8::Gemm g{acat, TCAT, 1280, 1280, 1280}; pg8::DiagOrder S; S.init(16, 4, 4, G, bx);
        epi::EpiS5Main E{args.in[I_LOGDT], ys};
        pg8::gemm_phase<epi::EpiS5Main, pg8::DiagOrder, true, true>(lds, g, S, E);
    }
    SEAM(5);
    if (IN(6)) {
        pg8::Gemm g{ys, WGLU, 256, 256, 256}; pg8::PairedOrder S; S.init(MTOK, DM, G, bx);
        epi::EpiGlu E{gates, ob};
        pg8::gemm_phase<epi::EpiGlu, pg8::PairedOrder, GLU_ALIGN, true>(lds, g, S, E);
    }
    if (IN(7)) {
#ifdef STAGGER_US
        if (vcu & 1) { const unsigned long long t0 = __builtin_amdgcn_s_memrealtime(); while (__builtin_amdgcn_s_memrealtime() - t0 < (unsigned long long)(STAGGER_US * 100)) __builtin_amdgcn_s_sleep(16); }
#endif
        pg8::Gemm ga{acatt, WOA, 512, 768, 512}, gm{acatt + 512, WOM, 256, 768, 256}; pg8::StaticOrder S; S.init(MTOK, DM, G, bx);
        epi::EpiMerge2 E{gates, ob, mergedb};
        pg8::gemm_phase<epi::EpiMerge2, pg8::StaticOrder, true, true, true>(lds, ga, S, E, gm);
    }
    SEAM(7);
    if (IN(8)) {
        pg8::Gemm g{mergedb, WOUT, 1024, 1024, 1024}; pg8::StaticOrder S; S.init(MTOK, DM, G, bx);
        epi::EpiResid<true> E{abuf, x2h, ssq2, 1.0f};
        pg8::gemm_phase<epi::EpiResid<true>, pg8::StaticOrder, true, true>(lds, g, S, E);
    }
    SEAM(8);
#ifdef DBG_P1AGAIN
    if (IN(9)) {
        pg8::Gemm g{abuf, W1A, 1024, 1024, 1024}; pg8::StaticOrder S; S.init(MTOK, 2 * FFN, G, bx);
        epi::EpiSwiglu<0> E{hidden, rstd0};
        pg8::gemm_phase<epi::EpiSwiglu<0>, pg8::StaticOrder, true, true>(lds, g, S, E);
        if (hi - lo > 1) xcd_barrier(bar);
    }
#endif
    if (IN(9)) {
#if defined(DBG_CLOCK) && DBG_CLOCK >= 10
        if (bx == 0 && tid == 0) { ((unsigned long long*)(ctl + 9000))[0] = __builtin_amdgcn_s_memtime(); ((unsigned long long*)(ctl + 9000))[1] = __builtin_amdgcn_s_memrealtime(); }
#endif
        pg8::Gemm g{x2h, W2A, 1024, 1024, 1024}; pg8::StaticOrder S; S.init(MTOK, 2 * FFN, G, bx);
        epi::EpiSwiglu<1> E{hidden, ssq2};
        pg8::gemm_phase<epi::EpiSwiglu<1>, pg8::StaticOrder, true, true>(lds, g, S, E);
#if defined(DBG_CLOCK) && DBG_CLOCK >= 10
        if (bx == 0 && tid == 0) { ((unsigned long long*)(ctl + 9000))[2] = __builtin_amdgcn_s_memtime(); ((unsigned long long*)(ctl + 9000))[3] = __builtin_amdgcn_s_memrealtime(); }
#endif
    }
    SEAM(9);
    if (IN(10)) {
        pg8::Gemm g{hidden, W2B, FFN, FFN, FFN}; pg8::StaticOrder S; S.init(MTOK, DM, G, bx);
        epi::EpiFinal E{x2h, xres, ssq3, ctl + CW_FIN, args.in[I_FINAL_NORM], 0.5f};
        pg8::gemm_phase<epi::EpiFinal, pg8::StaticOrder, true, true>(lds, g, S, E);
    }
#ifdef DBG_SPIN
    if (bx == 0 && tid == 0) { const unsigned long long te = __builtin_amdgcn_s_memrealtime(); volatile unsigned long long* st = (volatile unsigned long long*)(ctl + 9100);
        const unsigned long long tb = DBG_SPIN == 11 ? te : st[DBG_SPIN + 1]; const unsigned long long d = tb - st[DBG_SPIN];
        while (__builtin_amdgcn_s_memrealtime() - te < 9ull * d) __builtin_amdgcn_s_sleep(32); }
#endif
#undef IN
#undef SEAM
#undef WSP
#undef W1A
#undef W1B
#undef WIN
#undef WMKV
#undef WGLU
#undef WOA
#undef WOM
#undef WOUT
#undef W2A
#undef W2B
#undef TCAT
#undef WST
#undef rstd0
#undef ssq1
#undef ssq2
#undef ssq3
#undef memh
#undef mk
#undef mvT
#undef a64
#undef abuf
#undef mergedb
#undef acatt
#undef ys
#undef x2h
#undef hidden
#undef qa
#undef qidx
#undef qm
#undef ob
#undef ka
#undef va
#undef kidx
#undef widx
#undef acat
#undef gates
}

#ifdef DBG_CLOCK
#ifndef DBG_Q
#define DBG_Q 3.0f
#endif
__global__ void clk_report(float* out, unsigned* ctl) {
    const unsigned long long* t = (const unsigned long long*)(ctl + 9000);
    const double cyc = (double)(t[2] - t[0]), wall = (double)(t[3] - t[1]) * 10.0;
#if DBG_CLOCK == 1
    const float code = (float)(cyc / 352.0 / 100.0);
#elif DBG_CLOCK == 2
    const float code = (float)(wall / 352.0 / 100.0);
#elif DBG_CLOCK == 3 || DBG_CLOCK == 13
    const float code = (float)(cyc / wall * 20.0);
#elif DBG_CLOCK == 4
    const float code = (float)((double)ctl[9016] * 10.0 / 352.0 / 25.0);
#else
    const float code = (float)((double)(~ctl[9018]) * 10.0 / 352.0 / 25.0);
#endif
    const float c = sqrtf(fmaxf(floorf(code / DBG_Q) * DBG_Q - 1.0f, 0.0f));
    for (size_t i = (size_t)blockIdx.x * blockDim.x + threadIdx.x; i < (size_t)MTOK * DM; i += (size_t)gridDim.x * blockDim.x) out[i] = c;
}
#endif
#ifndef DBG_TOL
#define DBG_TOL 0.03f
#endif
extern "C" void kernel_launch(void* const* d_in, const int* in_sizes, int n_in, void* d_out, int out_size, void* d_ws, size_t ws_size, hipStream_t stream) {
    static int grid = 0;
    if (grid == 0) {
        if (n_in != N_IN || in_sizes[0] != MTOK * DM || out_size != MTOK * DM || ws_size < WS_END) { fprintf(stderr, "kernel_launch: unexpected shapes (n_in %d, ws %zu)\n", n_in, ws_size); grid = -1; return; }
        int dev = 0, cus = 0, per_cu = 0;
        if (hipGetDevice(&dev) != hipSuccess || hipDeviceGetAttribute(&cus, hipDeviceAttributeMultiprocessorCount, dev) != hipSuccess) { grid = -1; return; }
        if (hipFuncSetAttribute((const void*)mega_fwd, hipFuncAttributeMaxDynamicSharedMemorySize, LDS_BYTES) != hipSuccess) { fprintf(stderr, "kernel_launch: hipFuncSetAttribute failed\n"); grid = -1; return; }
        if (hipOccupancyMaxActiveBlocksPerMultiprocessor(&per_cu, (const void*)mega_fwd, NWAVES * 64, LDS_BYTES) != hipSuccess || per_cu < 1) fprintf(stderr, "kernel_launch: occupancy query reports %d\n", per_cu);
        (void)hipGetLastError();
        grid = cus;
    }
    if (grid < 0) return;
    (void)hipMemsetAsync((char*)d_ws + WS_CTL, 0, CTL_ZERO_BYTES, stream);
    Args a{};
    for (int i = 0; i < N_IN; ++i) a.in[i] = (const float*)d_in[i];
    a.out = (float*)d_out; a.ws = (unsigned char*)d_ws;
#if MK_N_LAUNCHES == 1
    a.ph_lo = 0; a.ph_hi = N_PHASES;
    hipLaunchKernelGGL(mega_fwd, dim3(grid), dim3(NWAVES * 64), LDS_BYTES, stream, a);
#ifdef DBG_CLOCK
    hipLaunchKernelGGL(clk_report, dim3(1024), dim3(256), 0, stream, (float*)d_out, (unsigned*)d_ws);
#endif
#else
    for (int p = 0; p < N_PHASES; ++p) { a.ph_lo = p; a.ph_hi = p + 1; hipLaunchKernelGGL(mega_fwd, dim3(grid), dim3(NWAVES * 64), LDS_BYTES, stream, a);
#ifdef REP_PHASE
        if (p == REP_PHASE) for (int rep_ = 1; rep_ < REP_COUNT; ++rep_) { Args a2 = a;
#ifdef TIMING_VARIANT
            a2.variant = TIMING_VARIANT;
#endif
            hipLaunchKernelGGL(mega_fwd, dim3(grid), dim3(NWAVES * 64), LDS_BYTES, stream, a2); }
#endif
#ifdef DBG_CLOCK
        if (p == N_PHASES - 1) hipLaunchKernelGGL(clk_report, dim3(1024), dim3(256), 0, stream, (float*)d_out, (unsigned*)d_ws);
#endif
#ifdef DBG_CHECK
        unsigned char* ws = (unsigned char*)d_ws; unsigned* ctl = (unsigned*)ws; const float* const* in = a.in; float* out = (float*)d_out;
        dbg::ProjBufs PB{(h16*)(ws + WS_QA), (h16*)(ws + WS_KA), (h16*)(ws + WS_VAT), (h16*)(ws + WS_QIDX), (h16*)(ws + WS_KIDX), (h16*)(ws + WS_ACAT), (h16*)(ws + WS_QM), (h16*)(ws + WS_GATES), (float*)(ws + WS_WIDX)};
        if (p == 2) { hipLaunchKernelGGL(dbg::chk_ffn, dim3(8), dim3(256), 0, stream, in[I_X], in[I_FFN1_NORM], in[I_FFN1_WIN], in[I_FFN1_WOUT], (const float*)out, ctl, 1);
                      hipLaunchKernelGGL(dbg::chk_memkv, dim3(4), dim3(256), 0, stream, in[I_MEM], in[I_MEM_NORM], in[I_WMKV], in[I_MKG], (const h16*)(ws + WS_MK), (const h16*)(ws + WS_MVT), ctl); }
        if (p == 3) hipLaunchKernelGGL(dbg::chk_proj, dim3(4), dim3(256), 0, stream, (const float*)out, in[I_MIX_NORM], in[I_W_IN], in[I_AQG], in[I_AKG], in[I_MQG], PB, ctl);
        if (p == 4) { hipLaunchKernelGGL(dbg::chk_attn, dim3(8), dim3(256), 0, stream, PB, in[I_RELB], (const h16*)(ws + WS_CBUF), ctl);
                      hipLaunchKernelGGL(dbg::chk_mem, dim3(8), dim3(256), 0, stream, (const h16*)(ws + WS_QM), (const h16*)(ws + WS_MK), (const h16*)(ws + WS_MVT), (const h16*)(ws + WS_CBUF), ctl); }
        if (p == 5) hipLaunchKernelGGL(dbg::chk_s5, dim3(8), dim3(64), 0, stream, (const h16*)(ws + WS_ACAT), in[I_LRE], in[I_LIM], in[I_LOGDT], in[I_BRE], in[I_BIM], in[I_CRE], in[I_CIM], in[I_SSMD], (const h16*)(ws + WS_YS), ctl);
        if (p == 6) hipLaunchKernelGGL(dbg::chk_glu, dim3(4), dim3(256), 0, stream, (const h16*)(ws + WS_YS), in[I_WGLU], (const h16*)(ws + WS_OB), ctl);
        if (p == 7) hipLaunchKernelGGL(dbg::chk_merge, dim3(8), dim3(256), 0, stream, (const h16*)(ws + WS_CBUF), (const h16*)(ws + WS_OB), (const h16*)(ws + WS_GATES), in[I_WOA], in[I_WOM], (const h16*)(ws + WS_ABUF), (const float*)out, in[I_WOUT], ctl);
        if (p == 8) hipLaunchKernelGGL(dbg::chk_x2, dim3(8), dim3(256), 0, stream, (const float*)out, ctl);
        if (p == N_PHASES - 1) hipLaunchKernelGGL(dbg::chk_report, dim3(1024), dim3(256), 0, stream, out, ctl, DBG_TOL);
#endif
    }
#endif
}
```
